# Optimizing an MI355X kernel written in HIP

```python
import math
import jax, jax.numpy as jnp
from jax import lax
import numpy as np

D_MODEL = 1024
BATCH = 1
SEQ = 16384
DEPTH = 1

EPS = 1e-6
GLA_HEADS = 4
GLA_DK = 48
GLA_DV = 96
GLA_QK_WIDTH = GLA_HEADS * GLA_DK
GLA_WIDTH = GLA_HEADS * GLA_DV
GLA_RANK = 16
GLA_GATE_NORM = 16.0
GLA_CHUNK = 64
FOX_HEADS = 6
FOX_DH = 64
FOX_WIDTH = FOX_HEADS * FOX_DH
FOX_BLOCK = 128
MEM_LEN = 256
MEM_HEADS = 4
MEM_DH = 64
MEM_WIDTH = MEM_HEADS * MEM_DH
MIX_WIDTH = GLA_WIDTH + FOX_WIDTH + MEM_WIDTH
IN_SPLITS = (GLA_QK_WIDTH, GLA_QK_WIDTH, GLA_WIDTH, GLA_RANK, GLA_WIDTH,
             FOX_WIDTH, FOX_WIDTH, FOX_WIDTH, FOX_HEADS, FOX_WIDTH,
             MEM_WIDTH, MEM_WIDTH)
IN_COLS = sum(IN_SPLITS)

kernel_name = "hymba_gla_fox_memory_block"


def rmsnorm(x, g):
    xf = x.astype(jnp.float32)
    y = xf * lax.rsqrt(jnp.mean(xf * xf, axis=-1, keepdims=True) + EPS)
    return (y * g.astype(jnp.float32)).astype(x.dtype)


def gla_chunked(q, k, v, log_a):
    B, T, H, K = q.shape
    V = v.shape[-1]
    C = GLA_CHUNK
    N = T // C
    f32 = jnp.float32

    def chunks(a):
        return a.astype(f32).reshape(B, N, C, H, -1).transpose(1, 0, 3, 2, 4)

    qc = chunks(q) * (K ** -0.5)
    kc, vc, gc = chunks(k), chunks(v), chunks(log_a)
    b = jnp.cumsum(gc, axis=3)
    b_last = b[:, :, :, -1:, :]
    q_dec = qc * jnp.exp(b)
    k_dec = kc * jnp.exp(-b)
    k_to_end = kc * jnp.exp(b_last - b)
    causal = jnp.tril(jnp.ones((C, C), f32))
    attn = jnp.einsum('nbhck,nbhsk->nbhcs', q_dec, k_dec) * causal
    o_intra = jnp.einsum('nbhcs,nbhsv->nbhcv', attn, vc)
    kv_chunk = jnp.einsum('nbhsk,nbhsv->nbhkv', k_to_end, vc)
    decay_chunk = jnp.exp(b_last[:, :, :, 0, :])

    def step(S, inp):
        kv_n, dec_n = inp
        return dec_n[..., None] * S + kv_n, S

    _, S_prev = lax.scan(step, jnp.zeros((B, H, K, V), f32), (kv_chunk, decay_chunk))
    o_inter = jnp.einsum('nbhck,nbhkv->nbhcv', q_dec, S_prev)
    o = (o_intra + o_inter).transpose(1, 0, 3, 2, 4).reshape(B, T, H, V)
    return o


def fox_attention(q, k, v, log_f):
    B, T, H, D = q.shape
    nb = T // FOX_BLOCK
    scale = D ** -0.5
    c = jnp.cumsum(log_f.astype(jnp.float32), axis=1).transpose(0, 2, 1)
    kh = k.transpose(0, 2, 1, 3)
    vh = v.transpose(0, 2, 1, 3)
    q_blocks = q.transpose(0, 2, 1, 3).reshape(B, H, nb, FOX_BLOCK, D).transpose(2, 0, 1, 3, 4)
    c_blocks = c.reshape(B, H, nb, FOX_BLOCK).transpose(2, 0, 1, 3)
    starts = jnp.arange(nb, dtype=jnp.int32) * FOX_BLOCK
    key_pos = jnp.arange(T, dtype=jnp.int32)

    def one_block(args):
        qb, cb, start = args
        s = jnp.einsum('bhqd,bhkd->bhqk', qb, kh).astype(jnp.float32) * scale
        s = s + cb[..., :, None] - c[..., None, :]
        q_pos = start + jnp.arange(FOX_BLOCK, dtype=jnp.int32)
        mask = key_pos[None, :] <= q_pos[:, None]
        p = jax.nn.softmax(jnp.where(mask, s, -jnp.inf), axis=-1)
        return jnp.einsum('bhqk,bhkd->bhqd', p.astype(vh.dtype), vh)

    out = lax.map(one_block, (q_blocks, c_blocks, starts))
    return out.transpose(1, 0, 3, 2, 4).reshape(B, T, H * D)


def memory_attention(q, mk, mv):
    B, T, H, D = q.shape
    s = jnp.einsum('bthd,bmhd->bhtm', q, mk).astype(jnp.float32) * (D ** -0.5)
    p = jax.nn.softmax(s, axis=-1)
    o = jnp.einsum('bhtm,bmhd->bthd', p.astype(mv.dtype), mv)
    return o.reshape(B, T, H * D)


def hybrid_layer(x, mem, norm_g, w_in, w_alpha_up, b_alpha, b_forget, gla_norm_g,
                 mem_norm_g, w_mem_kv, w_out):
    B, T, _ = x.shape
    h = rmsnorm(x, norm_g)
    proj = h @ w_in
    idx = [int(i) for i in np.cumsum(IN_SPLITS)[:-1]]
    (g_q, g_k, g_v, g_lr, g_gate, f_q, f_k, f_v, f_fg, f_gate,
     m_q, m_gate) = jnp.split(proj, idx, axis=-1)

    z_alpha = g_lr @ w_alpha_up + b_alpha
    log_a = jax.nn.log_sigmoid(z_alpha.astype(jnp.float32)) / GLA_GATE_NORM
    o_gla = gla_chunked(g_q.reshape(B, T, GLA_HEADS, GLA_DK),
                        g_k.reshape(B, T, GLA_HEADS, GLA_DK),
                        g_v.reshape(B, T, GLA_HEADS, GLA_DV),
                        log_a.reshape(B, T, GLA_HEADS, GLA_DK))
    o_gla = rmsnorm(o_gla, gla_norm_g).reshape(B, T, GLA_WIDTH).astype(x.dtype)
    o_gla = o_gla * jax.nn.silu(g_gate)

    log_f = jax.nn.log_sigmoid((f_fg + b_forget).astype(jnp.float32))
    o_fox = fox_attention(f_q.reshape(B, T, FOX_HEADS, FOX_DH),
                          f_k.reshape(B, T, FOX_HEADS, FOX_DH),
                          f_v.reshape(B, T, FOX_HEADS, FOX_DH), log_f)
    o_fox = o_fox.astype(x.dtype) * jax.nn.silu(f_gate)

    mkv = rmsnorm(mem, mem_norm_g) @ w_mem_kv
    M = mem.shape[1]
    mk, mv = jnp.split(mkv, 2, axis=-1)
    o_mem = memory_attention(m_q.reshape(B, T, MEM_HEADS, MEM_DH),
                             mk.reshape(B, M, MEM_HEADS, MEM_DH),
                             mv.reshape(B, M, MEM_HEADS, MEM_DH))
    o_mem = o_mem.astype(x.dtype) * jax.nn.silu(m_gate)

    mixed = jnp.concatenate([o_gla, o_fox, o_mem], axis=-1)
    return x + mixed @ w_out


def setup_inputs(seed: int = 0) -> dict:
    key = jax.random.key(seed)
    ks = jax.random.split(key, 14)
    f32 = jnp.float32
    nrm = lambda k, s: jax.random.normal(k, s, f32)
    return {
        "x": nrm(ks[0], (BATCH, SEQ, D_MODEL)),
        "mem": nrm(ks[1], (BATCH, MEM_LEN, D_MODEL)),
        "norm_g": 1.0 + 0.02 * nrm(ks[2], (DEPTH, D_MODEL)),
        "w_in": nrm(ks[3], (DEPTH, D_MODEL, IN_COLS)) * D_MODEL ** -0.5,
        "w_alpha_up": nrm(ks[4], (DEPTH, GLA_RANK, GLA_QK_WIDTH)) * GLA_RANK ** -0.5,
        "b_alpha": 0.1 * nrm(ks[5], (DEPTH, GLA_QK_WIDTH)),
        "b_forget": 2.0 + 0.5 * nrm(ks[6], (DEPTH, FOX_HEADS)),
        "gla_norm_g": 1.0 + 0.02 * nrm(ks[7], (DEPTH, GLA_DV)),
        "mem_norm_g": 1.0 + 0.02 * nrm(ks[8], (DEPTH, D_MODEL)),
        "w_mem_kv": nrm(ks[9], (DEPTH, D_MODEL, 2 * MEM_WIDTH)) * D_MODEL ** -0.5,
        "w_out": nrm(ks[10], (DEPTH, MIX_WIDTH, D_MODEL)) * MIX_WIDTH ** -0.5,
        "final_norm_g": 1.0 + 0.02 * nrm(ks[11], (D_MODEL,)),
    }


def reference(x, mem, norm_g, w_in, w_alpha_up, b_alpha, b_forget, gla_norm_g,
              mem_norm_g, w_mem_kv, w_out, final_norm_g):
    h = x
    for layer in range(DEPTH):
        h = hybrid_layer(h, mem, norm_g[layer], w_in[layer], w_alpha_up[layer],
                         b_alpha[layer], b_forget[layer], gla_norm_g[layer],
                         mem_norm_g[layer], w_mem_kv[layer], w_out[layer])
    return rmsnorm(h, final_norm_g)
```

```cpp
#include <hip/hip_runtime.h>
#include <cstdio>
#include <cstdint>
namespace pg8 {
#define PG8_LAS __attribute__((address_space(3)))
typedef unsigned short bf16_t;
typedef short bf16x8 __attribute__((ext_vector_type(8)));
typedef float f32x4 __attribute__((ext_vector_type(4)));
typedef unsigned u32x4 __attribute__((ext_vector_type(4)));
constexpr int BM = 256, BK = 64, HALF = 128, HTB = HALF * BK * 2  , STAGE_BYTES = 8 * HTB, NXCD = 8, WGM = 8;

__host__ __device__ __forceinline__ int lds_byte(int r, int c) { const int st = (r >> 4) * 2 + (c >> 5), rr = r & 15, cc = c & 31, ob = rr * 64 + cc * 2; return st * 1024 + (ob ^ (((ob >> 9) & 1) << 5)); }
__host__ __device__ __forceinline__ void stage_rc(int b, int& R, int& C) { const int st = b / 1024, sb = b % 1024, swz = sb ^ (((sb >> 9) & 1) << 5); R = (st >> 1) * 16 + swz / 64; C = (st & 1) * 32 + (swz % 64) / 2; }
__host__ __device__ __forceinline__ int perm32(int rho) { const int n = rho >> 4, i = rho & 15; return 8 * (i >> 2) + 4 * n + (i & 3); }

struct Unit { int pm, pn; };
struct Gemm { const bf16_t* A; const bf16_t* Bt; int M, N, K; };

struct StaticOrder {
    int nM, nN, nwg, G, c;
    __host__ __device__ void init(int M, int N, int G_, int c_) { nM = M / BM; nN = N / BM; nwg = nM * nN; G = G_; c = c_; }
    __host__ __device__ bool next(int i, Unit& u) const {
        const long L = (long)i * G + c; if (L >= nwg) return false;
        int wgid = (int)L; { const int q = nwg / NXCD, r = nwg % NXCD, xcd = wgid % NXCD, off = wgid / NXCD; wgid = (xcd < r ? xcd * (q + 1) : r * (q + 1) + (xcd - r) * q) + off; }
        const int nig = WGM * nN, gid = wgid / nig, fm = gid * WGM, gsz = (nM - fm) < WGM ? (nM - fm) : WGM;
        u.pm = fm + ((wgid % nig) % gsz); u.pn = (wgid % nig) / gsz; return true;
    }
    __device__ __forceinline__ void a_ready(const Unit&) const {}
    __device__ __forceinline__ void done(const Unit&) const {}
};


__device__ __forceinline__ unsigned cvt_pk_bf16(float lo, float hi) { unsigned r; asm volatile("v_cvt_pk_bf16_f32 %0, %1, %2" : "=v"(r) : "v"(lo), "v"(hi)); return r; }
typedef float f32x2 __attribute__((ext_vector_type(2)));

struct EpiBf16 {
    static constexpr bool PERM = true, AFTER_DRAIN = false;
    bf16_t* O; int ldc; int split_cols; size_t split_stride;
    __device__ __forceinline__ void operator()(const f32x4 (&acc)[2][2][4][2], const Unit& u, int wr, int wc, int fr, int fq) const {
        const int row0 = u.pm * BM + wr * 64 + fr; int colt = u.pn * BM; bf16_t* base = O;
        if (split_cols) { const int t = colt / split_cols; base += (size_t)t * split_stride; colt -= t * split_cols; }
        const int col0 = colt + wc * 32 + 8 * fq;
#pragma unroll
        for (int ai = 0; ai < 2; ++ai)
#pragma unroll
            for (int m = 0; m < 4; ++m) { bf16_t* rowp = base + (size_t)(row0 + ai * HALF + m * 16) * ldc + col0;
#pragma unroll
                for (int bj = 0; bj < 2; ++bj) { const f32x4 v0 = acc[ai][bj][m][0], v1 = acc[ai][bj][m][1];
                    u32x4 w; w.x = cvt_pk_bf16(v0[0], v0[1]); w.y = cvt_pk_bf16(v0[2], v0[3]); w.z = cvt_pk_bf16(v1[0], v1[1]); w.w = cvt_pk_bf16(v1[2], v1[3]);
                    *(u32x4*)(rowp + bj * HALF) = w; } }
    }
};

struct RouteTab { unsigned char* ws; };
struct Route { bf16_t* base; int pitch, col, mode; };
struct EpiRoute {
    static constexpr bool PERM = true, AFTER_DRAIN = false;
    unsigned char* ws; float qscale;
    __device__ __forceinline__ Route route(int g32) const;
    __device__ __forceinline__ void operator()(const f32x4 (&acc)[2][2][4][2], const Unit& u, int wr, int wc, int fr, int fq) const {
        const int row0 = u.pm * BM + wr * 64 + fr;
#pragma unroll
        for (int bj = 0; bj < 2; ++bj) {
            const Route R = route(8 * u.pn + 4 * bj + wc);
            if (R.mode == 4) continue;
            if (R.mode == 3) {
                float* glr = (float*)R.base; float* ffg = glr + (size_t)16384 * 16;
#pragma unroll
                for (int ai = 0; ai < 2; ++ai)
#pragma unroll
                    for (int m = 0; m < 4; ++m) { const size_t row = (size_t)(row0 + ai * HALF + m * 16);
                        const f32x4 v0 = acc[ai][bj][m][0], v1 = acc[ai][bj][m][1];
                        if (fq < 2) { *(f32x4*)(glr + row * 16 + 8 * fq) = v0; *(f32x4*)(glr + row * 16 + 8 * fq + 4) = v1; }
                        else if (fq == 2) { *(f32x4*)(ffg + row * 8) = v0; *(f32x4*)(ffg + row * 8 + 4) = v1; } }
                continue;
            }
            const float sc = R.mode == 1 ? qscale : 1.f;
#pragma unroll
            for (int ai = 0; ai < 2; ++ai)
#pragma unroll
                for (int m = 0; m < 4; ++m) { bf16_t* rowp = R.base + (size_t)(row0 + ai * HALF + m * 16) * R.pitch + R.col + 8 * fq;
                    f32x4 v0 = acc[ai][bj][m][0], v1 = acc[ai][bj][m][1];
                    if (R.mode == 2) {
#pragma unroll
                        for (int e = 0; e < 4; ++e) { v0[e] = v0[e] * __builtin_amdgcn_rcpf(1.f + __builtin_amdgcn_exp2f(-1.4426950408889634f * v0[e])); v1[e] = v1[e] * __builtin_amdgcn_rcpf(1.f + __builtin_amdgcn_exp2f(-1.4426950408889634f * v1[e])); }
                    } else { v0 = v0 * sc; v1 = v1 * sc; }
                    u32x4 w; w.x = cvt_pk_bf16(v0[0], v0[1]); w.y = cvt_pk_bf16(v0[2], v0[3]); w.z = cvt_pk_bf16(v1[0], v1[1]); w.w = cvt_pk_bf16(v1[2], v1[3]);
                    *(u32x4*)rowp = w; }
        }
    }
};

struct PanelSumSq {
    unsigned* xbuf;
    unsigned* cnt;
    unsigned* tmo;
    float eps; unsigned code;
    __device__ __forceinline__ bool run(const f32x4 (&v)[2][2][4][2], const Unit& u, int wr, int wc, int fr, int fq, PG8_LAS unsigned char* lds, int wid, int lane) const {
        PG8_LAS float* P = (PG8_LAS float*)lds;
        PG8_LAS float* S = (PG8_LAS float*)(lds + 8192);
        PG8_LAS unsigned* flag = (PG8_LAS unsigned*)(lds + 8192 + 2048);
#pragma unroll
        for (int ai = 0; ai < 2; ++ai)
#pragma unroll
            for (int m = 0; m < 4; ++m) {
                float q = 0.f;
#pragma unroll
                for (int bj = 0; bj < 2; ++bj)
#pragma unroll
                    for (int n = 0; n < 2; ++n) { const f32x4 d = v[ai][bj][m][n]; q += (d[0] * d[0] + d[1] * d[1]) + (d[2] * d[2] + d[3] * d[3]); }
                q += __shfl_xor(q, 16); q += __shfl_xor(q, 32);
                if (fq == 0) P[(ai * HALF + wr * 64 + m * 16 + fr) * 4 + wc] = q;
            }
        asm volatile("s_waitcnt lgkmcnt(0)" ::: "memory"); __builtin_amdgcn_s_barrier(); asm volatile("" ::: "memory");
        const int row = wid * 32 + (lane & 31);
        if (lane < 32) {
            const float q = (P[row * 4 + 0] + P[row * 4 + 1]) + (P[row * 4 + 2] + P[row * 4 + 3]);
            unsigned* slot = xbuf + ((size_t)(u.pm * BM + row) * 4 + u.pn);
            __hip_atomic_store(slot, __float_as_uint(q), __ATOMIC_RELAXED, __HIP_MEMORY_SCOPE_AGENT);
        }
        asm volatile("s_waitcnt vmcnt(0)" ::: "memory");
        if (lane == 0) __hip_atomic_fetch_add(cnt + 64 * u.pm, 1u, __ATOMIC_RELAXED, __HIP_MEMORY_SCOPE_AGENT);
        if (wid == 0) {
            bool dead = false; const unsigned long long t0 = __builtin_amdgcn_s_memrealtime(); const unsigned want = 8u * 4u;
            for (;;) {
                if ((unsigned)__builtin_amdgcn_readfirstlane(__hip_atomic_load(cnt + 64 * u.pm, __ATOMIC_RELAXED, __HIP_MEMORY_SCOPE_AGENT)) >= want) break;
                if (__builtin_amdgcn_s_memrealtime() - t0 > 2000000ull) {
                    if (lane == 0) { unsigned expect = 0u; __hip_atomic_compare_exchange_strong(tmo + 1, &expect, code | (unsigned)(u.pm & 0xff), __ATOMIC_RELAXED, __ATOMIC_RELAXED, __HIP_MEMORY_SCOPE_AGENT);
                                     __hip_atomic_store(tmo, 1u, __ATOMIC_RELAXED, __HIP_MEMORY_SCOPE_AGENT); }
                    dead = true; break; }
                __builtin_amdgcn_s_sleep(2);
            }
            __builtin_amdgcn_fence(__ATOMIC_ACQUIRE, "agent");
            if (lane == 0) flag[0] = dead ? 1u : 0u;
        }
        asm volatile("s_waitcnt vmcnt(0) lgkmcnt(0)" ::: "memory"); __builtin_amdgcn_s_barrier(); asm volatile("" ::: "memory");
        const bool bad = flag[0] != 0u;
        if (lane < 32) {
            const unsigned* slot = xbuf + (size_t)(u.pm * BM + row) * 4; float q = 0.f;
#pragma unroll
            for (int t = 0; t < 4; ++t) q += __uint_as_float(__hip_atomic_load(slot + t, __ATOMIC_RELAXED, __HIP_MEMORY_SCOPE_AGENT));
            S[row] = 1.0f / sqrtf(q * (1.0f / 1024.0f) + eps);
        }
        asm volatile("s_waitcnt lgkmcnt(0)" ::: "memory"); __builtin_amdgcn_s_barrier(); asm volatile("" ::: "memory");
        return bad;
    }
};
struct EpiNormRes {
    static constexpr bool PERM = false, AFTER_DRAIN = true;
    const float* base; float* out; int ldc; const float* gain; PanelSumSq st; unsigned poison;
    __device__ __forceinline__ void fused(f32x4 (&acc)[2][2][4][2], const Unit& u, int wr, int wc, int fr, int fq, PG8_LAS unsigned char* lds, int wid, int lane) const {
        const PG8_LAS float* S = (const PG8_LAS float*)(lds + 8192);
        const int col0 = u.pn * BM + wc * 32 + 4 * fq;
#pragma unroll
        for (int ai = 0; ai < 2; ++ai)
#pragma unroll
            for (int m = 0; m < 4; ++m) { const size_t off = (size_t)(u.pm * BM + ai * HALF + wr * 64 + m * 16 + fr) * ldc + col0;
#pragma unroll
                for (int bj = 0; bj < 2; ++bj)
#pragma unroll
                    for (int n = 0; n < 2; ++n) acc[ai][bj][m][n] += *(const f32x4*)(base + off + bj * HALF + n * 16);
                asm volatile("" : "+v"(acc[ai][0][m][0]), "+v"(acc[ai][0][m][1]), "+v"(acc[ai][1][m][0]), "+v"(acc[ai][1][m][1]));
                if (m & 1) asm volatile("" ::: "memory"); }
        const bool bad = st.run(acc, u, wr, wc, fr, fq, lds, wid, lane) || poison != 0u;
        const float qnan = __builtin_nanf("");
        f32x4 gv[2][2];
#pragma unroll
        for (int bj = 0; bj < 2; ++bj)
#pragma unroll
            for (int n = 0; n < 2; ++n) gv[bj][n] = *(const f32x4*)(gain + col0 + bj * HALF + n * 16);
#pragma unroll
        for (int ai = 0; ai < 2; ++ai)
#pragma unroll
            for (int m = 0; m < 4; ++m) { const int r = ai * HALF + wr * 64 + m * 16 + fr; const float sr = S[r]; const size_t off = (size_t)(u.pm * BM + r) * ldc + col0;
#pragma unroll
                for (int bj = 0; bj < 2; ++bj)
#pragma unroll
                    for (int n = 0; n < 2; ++n) { f32x4 o = acc[ai][bj][m][n] * sr * gv[bj][n];
                        if (bad) o = (f32x4){qnan, qnan, qnan, qnan}; *(f32x4*)(out + off + bj * HALF + n * 16) = o; } }
    }
};

template <class Epi, class Sched, bool ALIGN_EPI = false, bool SP2 = false>
__device__ __forceinline__ void gemm_phase(PG8_LAS unsigned char* lds, const Gemm g, const Sched& S, const Epi& E) {
    const int tid = threadIdx.x, wid = __builtin_amdgcn_readfirstlane(tid >> 6), lane = tid & 63, wr = wid >> 2, wc = wid & 3, fr = lane & 15, fq = lane >> 4;
    const int K = g.K, nt = K / BK;
    unsigned voffA[2], voffB[2];
#pragma unroll
    for (int i = 0; i < 2; ++i) { int R, C; stage_rc(tid * 16 + i * 8192, R, C); const int Rb = Epi::PERM ? ((R & ~31) + perm32(R & 31)) : R;
        voffA[i] = (unsigned)(R * K + C) * 2u; voffB[i] = (unsigned)(Rb * K + C) * 2u; }
    const size_t kstep = (size_t)(BK * 2);
    const size_t hstep = (size_t)HALF * K * 2;
    const size_t tstep = 2 * hstep;
    const unsigned ldsw = (unsigned)wid * 1024u;
    const int aoff = lds_byte(wr * 64 + fr, fq * 8), boff = lds_byte(wc * 32 + fr, fq * 8);
#define PG8_SA(b, h) (((b) * 2 + (h)) * HTB)
#define PG8_SB(b, h) ((4 + (b) * 2 + (h)) * HTB)
#define PG8_STAGE(bufoff, gbase, voff) do { _Pragma("unroll") for (int _i = 0; _i < 2; ++_i) \
        __builtin_amdgcn_global_load_lds((const unsigned*)((const char*)(gbase) + (voff)[_i]), (PG8_LAS unsigned*)(lds + (bufoff) + ldsw + _i * 8192), 16, 0, 0); } while (0)
#define PG8_LDA(dst, b, h) do { _Pragma("unroll") for (int m = 0; m < 4; ++m) _Pragma("unroll") for (int k = 0; k < 2; ++k) dst[m][k] = *(const PG8_LAS bf16x8*)(lds + PG8_SA(b, h) + aoff + m * 2048 + k * 1024); } while (0)
#define PG8_LDB(dst, b, h) do { _Pragma("unroll") for (int n = 0; n < 2; ++n) _Pragma("unroll") for (int k = 0; k < 2; ++k) dst[n][k] = *(const PG8_LAS bf16x8*)(lds + PG8_SB(b, h) + boff + n * 2048 + k * 1024); } while (0)
#define PG8_MMA(ai, bj, At, Bt) do { __builtin_amdgcn_s_setprio(1); _Pragma("unroll") for (int m = 0; m < 4; ++m) _Pragma("unroll") for (int n = 0; n < 2; ++n) _Pragma("unroll") for (int k = 0; k < 2; ++k) \
        acc[ai][bj][m][n] = __builtin_amdgcn_mfma_f32_16x16x32_bf16(Bt[n][k], At[m][k], acc[ai][bj][m][n], 0, 0, 0); __builtin_amdgcn_s_setprio(0); } while (0)
#define PG8_WAIT_V(n) asm volatile("s_waitcnt vmcnt(" #n ")" ::: "memory")
#define PG8_WAIT_L(n) asm volatile("s_waitcnt lgkmcnt(" #n ")" ::: "memory")
#define PG8_BAR __builtin_amdgcn_s_barrier()
#define PG8_SCHED __builtin_amdgcn_sched_barrier(0)
    Unit cur, nxt; int ui = 0;
    if (!S.next(0, cur)) return;
    f32x4 acc[2][2][4][2];
#pragma unroll
    for (int a = 0; a < 2; ++a)
#pragma unroll
        for (int b = 0; b < 2; ++b)
#pragma unroll
            for (int m = 0; m < 4; ++m)
#pragma unroll
                for (int n = 0; n < 2; ++n) acc[a][b][m][n] = (f32x4){0.f, 0.f, 0.f, 0.f};
    bf16x8 At[4][2], B0[2][2], B1[2][2];
    const char* cA = (const char*)g.A + (size_t)cur.pm * tstep; const char* cB = (const char*)g.Bt + (size_t)cur.pn * tstep;
    S.a_ready(cur);
    if constexpr (SP2) {
        PG8_STAGE(PG8_SB(0, 0), cB, voffB); PG8_STAGE(PG8_SB(0, 1), cB + hstep, voffB); PG8_STAGE(PG8_SA(0, 0), cA, voffA); PG8_STAGE(PG8_SA(0, 1), cA + hstep, voffA);
        if (wr == 1) PG8_BAR;
        PG8_WAIT_V(2); PG8_BAR;
        PG8_STAGE(PG8_SB(1, 0), cB + kstep, voffB); PG8_STAGE(PG8_SA(1, 0), cA + kstep, voffA); PG8_STAGE(PG8_SB(1, 1), cB + hstep + kstep, voffB);
        PG8_WAIT_V(6); PG8_BAR;
    } else {
        PG8_STAGE(PG8_SB(0, 0), cB, voffB); PG8_STAGE(PG8_SA(0, 0), cA, voffA); PG8_STAGE(PG8_SB(0, 1), cB + hstep, voffB); PG8_STAGE(PG8_SA(0, 1), cA + hstep, voffA);
        if (wr == 1) PG8_BAR;
        PG8_WAIT_V(4); PG8_BAR;
        PG8_STAGE(PG8_SB(1, 0), cB + kstep, voffB); PG8_STAGE(PG8_SA(1, 0), cA + kstep, voffA); PG8_STAGE(PG8_SB(1, 1), cB + hstep + kstep, voffB);
        PG8_WAIT_V(6); PG8_BAR;
    }
    for (;;) {
        const bool has_next = S.next(ui + 1, nxt);
        const char* nA = has_next ? (const char*)g.A + (size_t)nxt.pm * tstep : cA; const char* nB = has_next ? (const char*)g.Bt + (size_t)nxt.pn * tstep : cB;
        for (int t = 0; t < nt; t += 2) {
            const bool last = (t == nt - 2);
            const char* a1 = cA + (size_t)(t + 1) * kstep;
            const char* a2 = last ? nA : cA + (size_t)(t + 2) * kstep; const char* b2 = last ? nB : cB + (size_t)(t + 2) * kstep;
            const char* a3 = a2 + kstep; const char* b3 = b2 + kstep;
            if (last && has_next) S.a_ready(nxt);
            if constexpr (SP2) {
            PG8_LDB(B0, 0, 0); PG8_LDB(B1, 0, 1); PG8_SCHED; PG8_LDA(At, 0, 0); PG8_STAGE(PG8_SA(1, 1), a1 + hstep, voffA);
            PG8_WAIT_V(8); PG8_WAIT_L(0); PG8_BAR; PG8_MMA(0, 0, At, B0); PG8_MMA(0, 1, At, B1); PG8_BAR; PG8_SCHED;
            PG8_LDA(At, 0, 1); PG8_STAGE(PG8_SB(0, 0), b2, voffB); PG8_STAGE(PG8_SB(0, 1), b2 + hstep, voffB); PG8_STAGE(PG8_SA(0, 0), a2, voffA);
            PG8_WAIT_V(8); PG8_WAIT_L(0); PG8_BAR; PG8_MMA(1, 0, At, B0); PG8_MMA(1, 1, At, B1); PG8_BAR; PG8_SCHED;
            PG8_LDB(B0, 1, 0); PG8_LDB(B1, 1, 1); PG8_SCHED; PG8_LDA(At, 1, 0); PG8_STAGE(PG8_SA(0, 1), a2 + hstep, voffA);
            PG8_WAIT_V(8); PG8_WAIT_L(0); PG8_BAR; PG8_MMA(0, 0, At, B0); PG8_MMA(0, 1, At, B1); PG8_BAR; PG8_SCHED;
            PG8_LDA(At, 1, 1); PG8_STAGE(PG8_SB(1, 0), b3, voffB); PG8_STAGE(PG8_SB(1, 1), b3 + hstep, voffB); PG8_STAGE(PG8_SA(1, 0), a3, voffA);
            PG8_WAIT_V(8); PG8_WAIT_L(0); PG8_BAR; PG8_MMA(1, 0, At, B0); PG8_MMA(1, 1, At, B1); PG8_BAR; PG8_SCHED;
            } else {
            PG8_LDB(B0, 0, 0); PG8_SCHED; PG8_LDA(At, 0, 0); PG8_STAGE(PG8_SA(1, 1), a1 + hstep, voffA);
            PG8_WAIT_L(8); PG8_BAR; PG8_WAIT_L(0); PG8_MMA(0, 0, At, B0); PG8_BAR; PG8_SCHED;
            PG8_LDB(B1, 0, 1); PG8_STAGE(PG8_SB(0, 0), b2, voffB);
            PG8_BAR; PG8_WAIT_L(0); PG8_MMA(0, 1, At, B1); PG8_BAR;
            PG8_LDA(At, 0, 1); PG8_STAGE(PG8_SA(0, 0), a2, voffA);
            PG8_BAR; PG8_WAIT_L(0); PG8_MMA(1, 0, At, B0); PG8_BAR; PG8_SCHED;
            PG8_STAGE(PG8_SB(0, 1), b2 + hstep, voffB);
            PG8_WAIT_V(6); PG8_BAR; PG8_MMA(1, 1, At, B1); PG8_BAR;
            PG8_LDB(B0, 1, 0); PG8_SCHED; PG8_LDA(At, 1, 0); PG8_STAGE(PG8_SA(0, 1), a2 + hstep, voffA);
            PG8_WAIT_L(8); PG8_BAR; PG8_WAIT_L(0); PG8_MMA(0, 0, At, B0); PG8_BAR; PG8_SCHED;
            PG8_LDB(B1, 1, 1); PG8_STAGE(PG8_SB(1, 0), b3, voffB);
            PG8_BAR; PG8_WAIT_L(0); PG8_MMA(0, 1, At, B1); PG8_BAR;
            PG8_LDA(At, 1, 1); PG8_STAGE(PG8_SA(1, 0), a3, voffA);
            PG8_BAR; PG8_WAIT_L(0); PG8_MMA(1, 0, At, B0); PG8_BAR; PG8_SCHED;
            PG8_STAGE(PG8_SB(1, 1), b3 + hstep, voffB);
            PG8_WAIT_V(6); PG8_BAR; PG8_MMA(1, 1, At, B1); PG8_BAR;
            }
        }
        if constexpr (ALIGN_EPI) { if (wr == 0) PG8_BAR; }
        if constexpr (!Epi::AFTER_DRAIN) { E(acc, cur, wr, wc, fr, fq); S.done(cur); }
        if (!has_next) break;
#pragma unroll
        for (int a = 0; a < 2; ++a)
#pragma unroll
            for (int b = 0; b < 2; ++b)
#pragma unroll
                for (int m = 0; m < 4; ++m)
#pragma unroll
                    for (int n = 0; n < 2; ++n) acc[a][b][m][n] = (f32x4){0.f, 0.f, 0.f, 0.f};
        cur = nxt; cA = nA; cB = nB; ++ui;
        if constexpr (ALIGN_EPI) { if (wr == 1) PG8_BAR; }
    }
    PG8_WAIT_V(0);
    if constexpr (!ALIGN_EPI) { if (wr == 0) PG8_BAR; }
    PG8_BAR;
    if constexpr (Epi::AFTER_DRAIN) { E.fused(acc, cur, wr, wc, fr, fq, lds, wid, lane); S.done(cur); }
#undef PG8_SA
#undef PG8_SB
#undef PG8_STAGE
#undef PG8_LDA
#undef PG8_LDB
#undef PG8_MMA
#undef PG8_WAIT_V
#undef PG8_WAIT_L
#undef PG8_BAR
#undef PG8_SCHED
}
}

#include <hip/hip_bf16.h>
#include <cmath>
namespace attn_body {
using bf16=__hip_bfloat16;
using bf16x8=__attribute__((ext_vector_type(8)))short;
using s16x4=__attribute__((ext_vector_type(4)))short;
using f32x16=__attribute__((ext_vector_type(16)))float;
using u32x4=__attribute__((ext_vector_type(4)))unsigned;
using f32x4_t=__attribute__((ext_vector_type(4)))float;
constexpr int D=64;
constexpr int NW=8,QBLK=32,QB=QBLK*NW,KVBLK=64;
constexpr int ATTN_UNIT_ROWS=QB;
__device__ __forceinline__ int crow(int r,int hi){return (r&3)+8*(r>>2)+4*hi;}
#define SBAR() __builtin_amdgcn_sched_barrier(0)
__device__ __forceinline__ void cmask(f32x16&p0,f32x16&p1,int jb,int qrel,int hi){
  const float NEG=-INFINITY; int kb=64*jb+4*hi;
  #pragma unroll
  for(int r=0;r<16;++r){int kv=kb+(r&3)+8*(r>>2); if(kv>qrel)p0[r]=NEG; if(kv+32>qrel)p1[r]=NEG;}
}

constexpr int NSLOT=3, SLOTB=8192;
constexpr int LDS_K=0, LDS_V=NSLOT*SLOTB, LDS_WS=2*NSLOT*SLOTB, LDS_OST=LDS_WS+NW*64*4, LDS_BIAS=LDS_OST+NW*4096, MAXKEYS=16384, LDS_BYTES=LDS_BIAS+MAXKEYS*4;
constexpr float C2=0.125f*1.4426950408889634f;
__device__ __forceinline__ void glds16(const void*gsrc,unsigned lds_dst){unsigned keep;
  asm volatile("s_mov_b32 %0, m0\n\ts_mov_b32 m0, %2\n\ts_nop 0\n\tglobal_load_lds_dwordx4 %1, off\n\ts_mov_b32 m0, %0":"=&s"(keep):"v"(gsrc),"s"(lds_dst):"memory");}
__device__ __forceinline__ float max3f(float a,float b,float c){float r;asm("v_max3_f32 %0, %1, %2, %3":"=v"(r):"v"(a),"v"(b),"v"(c));return r;}
__device__ __forceinline__ float max2f(float a,float b){float r;asm("v_max_f32_e32 %0, %1, %2":"=v"(r):"v"(a),"v"(b));return r;}
__device__ __forceinline__ float fadd_s(float a,float b){float r;asm("v_add_f32_e32 %0, %1, %2":"=v"(r):"v"(a),"v"(b));return r;}
__device__ __forceinline__ float fsub_s(float a,float b){float r;asm("v_sub_f32_e32 %0, %1, %2":"=v"(r):"v"(a),"v"(b));return r;}
typedef float f32x2_t __attribute__((ext_vector_type(2))); typedef __bf16 bf16x2_t __attribute__((ext_vector_type(2)));
__device__ __forceinline__ unsigned cvtpk_s(float lo,float hi){f32x2_t v={lo,hi};bf16x2_t b=__builtin_convertvector(v,bf16x2_t);return __builtin_bit_cast(unsigned,b);}
#define WAIT_BAR(N) asm volatile("s_waitcnt vmcnt(" #N ") lgkmcnt(0)\n\ts_barrier":::"memory")

__device__ __forceinline__ void qkt(f32x16&p0,f32x16&p1,const char*Kslot,const bf16x8*qr,const f32x16&negm,int r32,int hi){
  const char*kb=Kslot+hi*1024+r32*16;
  #pragma unroll
  for(int d0=0;d0<4;++d0){
    const bf16x8 b0=*reinterpret_cast<const bf16x8*>(kb+d0*2048);
    const bf16x8 b1=*reinterpret_cast<const bf16x8*>(kb+d0*2048+512);
    if(d0==0){p0=__builtin_amdgcn_mfma_f32_32x32x16_bf16(b0,qr[0],negm,0,0,0);p1=__builtin_amdgcn_mfma_f32_32x32x16_bf16(b1,qr[0],negm,0,0,0);}
    else{p0=__builtin_amdgcn_mfma_f32_32x32x16_bf16(b0,qr[d0],p0,0,0,0);p1=__builtin_amdgcn_mfma_f32_32x32x16_bf16(b1,qr[d0],p1,0,0,0);}}
}
typedef __attribute__((address_space(3))) const char* lds_cptr;
typedef short v4i16_t __attribute__((ext_vector_type(4)));
__device__ __forceinline__ void kload8(bf16x8*kf,lds_cptr kp){
  kf[0]=*(const __attribute__((address_space(3))) bf16x8*)(kp);      kf[1]=*(const __attribute__((address_space(3))) bf16x8*)(kp+512);
  kf[2]=*(const __attribute__((address_space(3))) bf16x8*)(kp+2048); kf[3]=*(const __attribute__((address_space(3))) bf16x8*)(kp+2560);
  kf[4]=*(const __attribute__((address_space(3))) bf16x8*)(kp+4096); kf[5]=*(const __attribute__((address_space(3))) bf16x8*)(kp+4608);
  kf[6]=*(const __attribute__((address_space(3))) bf16x8*)(kp+6144); kf[7]=*(const __attribute__((address_space(3))) bf16x8*)(kp+6656);
}
__device__ __forceinline__ void kload2(bf16x8*kf,lds_cptr kp,int j){ kf[2*j]=*(const __attribute__((address_space(3))) bf16x8*)(kp+j*2048); kf[2*j+1]=*(const __attribute__((address_space(3))) bf16x8*)(kp+j*2048+512); }
__device__ __forceinline__ s16x4 vtr(lds_cptr p){ return __builtin_bit_cast(s16x4,__builtin_amdgcn_ds_read_tr16_b64_v4i16((__attribute__((address_space(3))) v4i16_t*)p)); }
__device__ __forceinline__ float rowmax(const f32x16&p0,const f32x16&p1){
  float a=max3f(p0[0],p0[1],p1[0]),b=max3f(p0[2],p0[3],p1[1]);a=max3f(a,p1[2],p1[3]);
  #pragma unroll
  for(int r=4;r<16;r+=4){a=max3f(a,p0[r],p0[r+1]);b=max3f(b,p0[r+2],p0[r+3]);a=max3f(a,p1[r],p1[r+1]);b=max3f(b,p1[r+2],p1[r+3]);}
  const float m=max2f(a,b);
  auto rr=__builtin_amdgcn_permlane32_swap(__float_as_uint(m),__float_as_uint(m),false,false);
  return max2f(__uint_as_float(rr[0]),__uint_as_float(rr[1]));
}
__device__ __forceinline__ void pv(f32x16*o,int vb,bf16x8 pa0,bf16x8 pa1,bf16x8 pa2,bf16x8 pa3){
  #pragma unroll
  for(int d0=0;d0<2;++d0){s16x4 lo[4],hi[4];
    #pragma unroll
    for(int ks=0;ks<4;++ks){
      asm volatile("ds_read_b64_tr_b16 %0,%1 offset:%c2":"=&v"(lo[ks]):"v"(vb),"i"(d0*4096+ks*1024):"memory");
      asm volatile("ds_read_b64_tr_b16 %0,%1 offset:%c2":"=&v"(hi[ks]):"v"(vb),"i"(d0*4096+ks*1024+512):"memory");}
    asm volatile("s_waitcnt lgkmcnt(0)":::"memory");SBAR();
    #define PK(k) (bf16x8){lo[k][0],lo[k][1],lo[k][2],lo[k][3],hi[k][0],hi[k][1],hi[k][2],hi[k][3]}
    o[d0]=__builtin_amdgcn_mfma_f32_32x32x16_bf16(pa0,PK(0),o[d0],0,0,0);
    o[d0]=__builtin_amdgcn_mfma_f32_32x32x16_bf16(pa1,PK(1),o[d0],0,0,0);
    o[d0]=__builtin_amdgcn_mfma_f32_32x32x16_bf16(pa2,PK(2),o[d0],0,0,0);
    o[d0]=__builtin_amdgcn_mfma_f32_32x32x16_bf16(pa3,PK(3),o[d0],0,0,0);
    #undef PK
  }
}

#ifndef ATTN_STORE16
#define ATTN_STORE16(p,v) (*(u32x4*)(p)=(v))
#endif
template<int THRL,int PO,bool MASK,bool BIAS> __device__ __forceinline__ void attn_unit(int q0,int NT,int qoff,int PQ,int PKV,int PG,const bf16*Qh,const bf16*__restrict__ Kh,const bf16*__restrict__ Vh,const bf16*__restrict__ Gh,bf16*Oh,const float*__restrict__ cfl,const __attribute__((address_space(3))) float* offp,float cref,char*shm){
  int tid=threadIdx.x; asm volatile("":"+v"(tid)); const int lane=tid&63,r32=lane&31,hi=lane>>5; const int wid=__builtin_amdgcn_readfirstlane(tid>>6);
  const bf16*Qw=Qh+(long)(q0+wid*QBLK)*PQ;
  const unsigned lds0=(unsigned)(uintptr_t)shm;
  float*wsf=(float*)(shm+LDS_WS)+wid*64;
  const bf16*ksrc=Kh+(long)lane*PKV+wid*8;
  const bf16*vsrc=Vh+(long)(16*(wid&3)+(lane>>2))*PKV+(wid>>2)*32+(lane&3)*8;
  const unsigned kdst=lds0+LDS_K+wid*1024, vdst=lds0+LDS_V+wid*1024;
  #define DMA_K(t,slot) glds16(ksrc+(long)(t)*KVBLK*PKV,(unsigned)__builtin_amdgcn_readfirstlane(kdst+(slot)))
  #define DMA_V(t,slot) glds16(vsrc+(long)(t)*KVBLK*PKV,(unsigned)__builtin_amdgcn_readfirstlane(vdst+(slot)))
  const int vb0=(int)(lds0+LDS_V)+((lane>>4)&1)*32+(lane&3)*8+(4*hi+((lane&15)>>2))*64;
  const char*Kbase=shm+LDS_K; bf16x8 kf[8];
  const lds_cptr shm3=(lds_cptr)shm; const lds_cptr kp0=shm3+LDS_K+hi*1024+r32*16; const lds_cptr vp0=shm3+LDS_V+((lane>>4)&1)*32+(lane&3)*8+(4*hi+((lane&15)>>2))*64;
  typedef __attribute__((address_space(3))) const f32x4_t* lds_f4p; const lds_f4p biasp=(lds_f4p)(shm3+LDS_BIAS+16*hi);
  if(BIAS){ __attribute__((address_space(3))) float* bw=(__attribute__((address_space(3))) float*)(shm3+LDS_BIAS); for(int i=tid;i<NT*KVBLK;i+=NW*64) bw[i]=cref-(cfl[i]+offp[i>>6]); }
  DMA_K(0,0);DMA_V(0,0);DMA_K(1,SLOTB);
  bf16x8 qr[4];
  #pragma unroll
  for(int d0=0;d0<4;++d0)qr[d0]=*reinterpret_cast<const bf16x8*>(&Qw[(long)r32*PQ+d0*16+hi*8]);
  float mhat=0.f,l_reg=0.f;f32x16 o[2];o[0]=f32x16{};o[1]=f32x16{};const f32x16 zero16=f32x16{};
  const int qrel=wid*QBLK+r32+qoff;
  #define CMASK(P0,P1,t) do{ if(MASK){int jb_=(t)-(NT-4); if(jb_>=0)cmask(P0,P1,jb_,qrel,hi);} }while(0)
  #define ADDB(P0,P1,t) do{ if(BIAS){ _Pragma("unroll") for(int g_=0;g_<4;++g_){ const f32x4_t b0_=biasp[(t)*16+2*g_], b1_=biasp[(t)*16+8+2*g_]; \
      P0[4*g_]+=b0_[0];P0[4*g_+1]+=b0_[1];P0[4*g_+2]+=b0_[2];P0[4*g_+3]+=b0_[3]; P1[4*g_]+=b1_[0];P1[4*g_+1]+=b1_[1];P1[4*g_+2]+=b1_[2];P1[4*g_+3]+=b1_[3]; SBAR(); } } }while(0)
  bool resc=false;
  #define START(P0,P1) do{ const float rm=rowmax(P0,P1); resc=false; \
    { const float dl=rm; mhat=fadd_s(mhat,dl); \
      _Pragma("unroll") for(int r=0;r<16;++r){P0[r]=fsub_s(P0[r],dl);P1[r]=fsub_s(P1[r],dl);} } \
    _Pragma("unroll") for(int r=0;r<16;++r)P0[r]=__builtin_amdgcn_exp2f(P0[r]); }while(0)
  #define RESC() do{ if(resc){ asm volatile("s_waitcnt lgkmcnt(0)":::"memory"); \
      _Pragma("unroll") for(int d_=0;d_<2;++d_) _Pragma("unroll") for(int r=0;r<16;++r)o[d_][r]*=wsf[crow(r,hi)]; } }while(0)
  f32x16 pA0,pA1,pB0,pB1;
  int sl_prev=0,sl_cur=0,sl_next=SLOTB;
  #define ROT() do{sl_prev=sl_cur;sl_cur=sl_next;sl_next=(sl_next==(NSLOT-1)*SLOTB)?0:sl_next+SLOTB;}while(0)
  DMA_K(2,2*SLOTB);
  WAIT_BAR(3);
  qkt(pA0,pA1,Kbase,qr,zero16,r32,hi);asm volatile("s_nop 15\n\ts_nop 7":"+v"(pA0),"+v"(pA1));CMASK(pA0,pA1,0);ADDB(pA0,pA1,0);
  START(pA0,pA1);
  _Pragma("unroll") for(int r=0;r<16;++r)pA1[r]=__builtin_amdgcn_exp2f(pA1[r]);
  WAIT_BAR(0);
  DMA_K(3,0);DMA_V(1,SLOTB);
  ROT();
  kload8(kf,kp0+sl_cur);
  WAIT_BAR(2);
  s16x4 vlo[8],vhi[8]; u32x4 pw0,pw1,pw2,pw3;
  #define PKW(P,B) cvtpk_s(P[B],P[B+1])
  #define PAF(k) __builtin_bit_cast(bf16x8,pw##k)
  #define VFR(i) (bf16x8){vlo[i][0],vlo[i][1],vlo[i][2],vlo[i][3],vhi[i][0],vhi[i][1],vhi[i][2],vhi[i][3]}
  #define PIN(x) asm volatile("":"+v"(x))
  #define MX3(a,b,c) __builtin_fmaxf(__builtin_fmaxf((a),(b)),(c))
  #define GAPA(MF,A0,A1,A2,A3,W0,W1,PW) do{ MF; sacc+=A0; sacc+=A1; sacc+=A2; sacc+=A3; PIN(sacc); W0; W1; PIN(PW); SBAR(); }while(0)
  #define EX(v) __builtin_amdgcn_exp2f(v)
  #define GAPB(MF,X,B) do{ MF; X[B]=EX(X[B]); X[B+1]=EX(X[B+1]); X[B+2]=EX(X[B+2]); X[B+3]=EX(X[B+3]); PIN(X); SBAR(); }while(0)
  #define VRD(i) do{ vlo[i]=vtr(vp_+(((i)>>2)*4096+((i)&3)*1024)); vhi[i]=vtr(vp_+(((i)>>2)*4096+((i)&3)*1024+512)); }while(0)
  #define KRD(G,j) do{ if(G){ kload2(kf,kp0+sl_next,j); SBAR(); } }while(0)
  #define STEP(C0,C1,P0,P1,t,GK,GV,GL) do{ SBAR(); \
    const lds_cptr vp_=vp0+sl_prev; \
    VRD(0); SBAR(); float sacc=(P0[0]+P0[1]); \
    GAPA(C0=__builtin_amdgcn_mfma_f32_32x32x16_bf16(kf[0],qr[0],zero16,0,0,0), P0[2],P0[3],P0[4],P0[5],     pw0[0]=PKW(P0,0), pw0[1]=PKW(P0,2), pw0); \
    VRD(4); SBAR(); GAPA(C1=__builtin_amdgcn_mfma_f32_32x32x16_bf16(kf[1],qr[0],zero16,0,0,0), P0[6],P0[7],P0[8],P0[9],     pw0[2]=PKW(P0,4), pw0[3]=PKW(P0,6), pw0); \
    VRD(1); SBAR(); GAPA(C0=__builtin_amdgcn_mfma_f32_32x32x16_bf16(kf[2],qr[1],C0,0,0,0),   P0[10],P0[11],P0[12],P0[13], pw1[0]=PKW(P0,8), pw1[1]=PKW(P0,10), pw1); \
    VRD(5); SBAR(); GAPA(C1=__builtin_amdgcn_mfma_f32_32x32x16_bf16(kf[3],qr[1],C1,0,0,0),   P0[14],P0[15],P1[0],P1[1],   pw1[2]=PKW(P0,12),pw1[3]=PKW(P0,14), pw1); \
    VRD(2); SBAR(); GAPA(C0=__builtin_amdgcn_mfma_f32_32x32x16_bf16(kf[4],qr[2],C0,0,0,0),   P1[2],P1[3],P1[4],P1[5],     pw2[0]=PKW(P1,0), pw2[1]=PKW(P1,2), pw2); \
    VRD(6); SBAR(); GAPA(C1=__builtin_amdgcn_mfma_f32_32x32x16_bf16(kf[5],qr[2],C1,0,0,0),   P1[6],P1[7],P1[8],P1[9],     pw2[2]=PKW(P1,4), pw2[3]=PKW(P1,6), pw2); \
    VRD(3); SBAR(); GAPA(C0=__builtin_amdgcn_mfma_f32_32x32x16_bf16(kf[6],qr[3],C0,0,0,0),   P1[10],P1[11],P1[12],P1[13], pw3[0]=PKW(P1,8), pw3[1]=PKW(P1,10), pw3); \
    VRD(7); SBAR(); GAPA(C1=__builtin_amdgcn_mfma_f32_32x32x16_bf16(kf[7],qr[3],C1,0,0,0),   P1[14],P1[15],0.f,0.f,       pw3[2]=PKW(P1,12),pw3[3]=PKW(P1,14), pw3); \
    l_reg+=sacc; \
    if(GK){DMA_K((t)+3,sl_cur);} if(GV){DMA_V((t)+1,sl_next);} \
    CMASK(C0,C1,t); ADDB(C0,C1,t); \
    { float a=MX3(C0[0],C0[1],C1[0]),b=MX3(C0[2],C0[3],C1[1]); a=MX3(a,C1[2],C1[3]); \
      _Pragma("unroll") for(int r=4;r<16;r+=4){a=MX3(a,C0[r],C0[r+1]);b=MX3(b,C0[r+2],C0[r+3]);a=MX3(a,C1[r],C1[r+1]);b=MX3(b,C1[r+2],C1[r+3]);} \
      float rm=__builtin_fmaxf(a,b); { auto rr=__builtin_amdgcn_permlane32_swap(__float_as_uint(rm),__float_as_uint(rm),false,false); rm=__builtin_fmaxf(__uint_as_float(rr[0]),__uint_as_float(rr[1])); } \
      resc=false; rm-=mhat; \
      if(__builtin_expect(__any(rm>(float)THRL),0)){ const float dl=__builtin_fmaxf(rm,0.f); mhat+=dl; \
        const float f=__builtin_amdgcn_exp2f(-dl); l_reg*=f; if(hi==0)wsf[r32]=f; resc=true; } \
      _Pragma("unroll") for(int r=0;r<16;++r){C0[r]-=mhat;C1[r]-=mhat;} } \
    SBAR(); \
    GAPB(o[0]=__builtin_amdgcn_mfma_f32_32x32x16_bf16(PAF(0),VFR(0),o[0],0,0,0), C0,0); \
    GAPB(o[1]=__builtin_amdgcn_mfma_f32_32x32x16_bf16(PAF(0),VFR(4),o[1],0,0,0), C0,4); \
    KRD(GL,0); GAPB(o[0]=__builtin_amdgcn_mfma_f32_32x32x16_bf16(PAF(1),VFR(1),o[0],0,0,0), C0,8); \
    KRD(GL,1); GAPB(o[1]=__builtin_amdgcn_mfma_f32_32x32x16_bf16(PAF(1),VFR(5),o[1],0,0,0), C0,12); \
    KRD(GL,2); GAPB(o[0]=__builtin_amdgcn_mfma_f32_32x32x16_bf16(PAF(2),VFR(2),o[0],0,0,0), C1,0); \
    KRD(GL,3); GAPB(o[1]=__builtin_amdgcn_mfma_f32_32x32x16_bf16(PAF(2),VFR(6),o[1],0,0,0), C1,4); \
    GAPB(o[0]=__builtin_amdgcn_mfma_f32_32x32x16_bf16(PAF(3),VFR(3),o[0],0,0,0), C1,8); \
    GAPB(o[1]=__builtin_amdgcn_mfma_f32_32x32x16_bf16(PAF(3),VFR(7),o[1],0,0,0), C1,12); \
    }while(0)
  int t=1;
  #undef CMASK
  #define CMASK(P0,P1,t) do{}while(0)
  for(;t+5<NT;t+=2){
    STEP(pB0,pB1,pA0,pA1,t,true,true,true);     WAIT_BAR(2); RESC(); ROT();
    STEP(pA0,pA1,pB0,pB1,t+1,true,true,true);   WAIT_BAR(2); RESC(); ROT();
  }
  #undef CMASK
  #define CMASK(P0,P1,t) do{ if(MASK){int jb_=(t)-(NT-4); if(jb_>=0)cmask(P0,P1,jb_,qrel,hi);} }while(0)
  #define ENDW(tt) do{ if((tt)+3<NT){WAIT_BAR(2);} else if((tt)+2<NT){WAIT_BAR(1);} else {WAIT_BAR(0);} }while(0)
  for(;t+1<NT;t+=2){
    STEP(pB0,pB1,pA0,pA1,t,(t+3<NT),(t+1<NT),(t+1<NT));       ENDW(t);   RESC(); ROT();
    STEP(pA0,pA1,pB0,pB1,t+1,(t+4<NT),(t+2<NT),(t+2<NT));     ENDW(t+1); RESC(); ROT();
  }
  STEP(pB0,pB1,pA0,pA1,NT-1,false,false,false); RESC();
  { float sacc=pB0[0]+pB0[1]; _Pragma("unroll") for(int r=2;r<16;++r)sacc+=pB0[r]; _Pragma("unroll") for(int r=0;r<16;++r)sacc+=pB1[r]; l_reg+=sacc;
    pw0=(u32x4){PKW(pB0,0),PKW(pB0,2),PKW(pB0,4),PKW(pB0,6)};pw1=(u32x4){PKW(pB0,8),PKW(pB0,10),PKW(pB0,12),PKW(pB0,14)};pw2=(u32x4){PKW(pB1,0),PKW(pB1,2),PKW(pB1,4),PKW(pB1,6)};pw3=(u32x4){PKW(pB1,8),PKW(pB1,10),PKW(pB1,12),PKW(pB1,14)};
    SBAR(); pv(o,vb0+sl_cur,PAF(0),PAF(1),PAF(2),PAF(3)); }
  #undef PKW
  #undef PAF
  #undef VFR
  #undef PIN
  #undef MX3
  #undef GAPA
  #undef GAPB
  #undef EX
  #undef VRD
  #undef KRD
  #undef STEP
  #undef ENDW
  {auto rr=__builtin_amdgcn_permlane32_swap(__float_as_uint(l_reg),__float_as_uint(l_reg),false,false);l_reg=__uint_as_float(rr[0])+__uint_as_float(rr[1]);}
  if(hi==0)wsf[32+r32]=l_reg;asm volatile("s_waitcnt lgkmcnt(0)":::"memory");
  float rli[16];
  #pragma unroll
  for(int r=0;r<16;++r)rli[r]=__builtin_amdgcn_rcpf(wsf[32+crow(r,hi)]);
  bf16*Ow=Oh+(long)(q0+wid*QBLK)*PO; const bf16*Gw=Gh+(long)(q0+wid*QBLK)*PG;
  u32x4 gt[4];
  #pragma unroll
  for(int i=0;i<4;++i)gt[i]=*(const u32x4*)(Gw+(long)(i*8+(lane>>3))*PG+(lane&7)*8);
  { bf16*stg=(bf16*)(shm+LDS_OST)+wid*2048;
    #pragma unroll
    for(int r=0;r<16;++r){const int orow=crow(r,hi);
      #pragma unroll
      for(int d0=0;d0<2;++d0)stg[orow*64+d0*32+r32]=__float2bfloat16(o[d0][r]*rli[r]);}
    asm volatile("s_waitcnt lgkmcnt(0)":::"memory");
    #pragma unroll
    for(int i=0;i<4;++i){const int row=i*8+(lane>>3),ch=lane&7; const u32x4 v=*(const u32x4*)(stg+row*64+ch*8); u32x4 w;
      #pragma unroll
      for(int e=0;e<4;++e){ const float a0=__uint_as_float(v[e]<<16)*__uint_as_float(gt[i][e]<<16), a1=__uint_as_float(v[e]&0xffff0000u)*__uint_as_float(gt[i][e]&0xffff0000u); w[e]=cvtpk_s(a0,a1); }
      ATTN_STORE16(Ow+(long)row*PO+ch*8,w);} }
  asm volatile("s_waitcnt lgkmcnt(0)\n\ts_barrier":::"memory");
  #undef DMA_K
  #undef DMA_V
  #undef CMASK
  #undef START
  #undef RESC
  #undef ADDB
  #undef ROT
}
constexpr int ATTN_LDS_BYTES=LDS_BYTES;
#undef SBAR
#undef WAIT_BAR
}

constexpr int NWAVES = 8;
#ifndef MK_N_LAUNCHES
#define MK_N_LAUNCHES 1
#endif
#ifndef PROBE_DUP
#define PROBE_DUP -1
#endif
#define NREP(k) ((PROBE_DUP == (k)) ? 2 : 1)
constexpr int PER_PHASE = 5;
constexpr int N_LAUNCHES = MK_N_LAUNCHES;

constexpr int M = 16384, D = 1024;
constexpr int IN_COLS = 3222, NP = 3072;
constexpr int MEM_LEN = 256;
constexpr float EPS = 1e-6f;
constexpr float LOG2E = 1.4426950408889634f;
constexpr size_t MiB = 1u << 20;
constexpr size_t WS_CTL = 0, CTL_ZERO_BYTES = 1 * MiB;
constexpr size_t WS_ZERO = 512 * 1024;
constexpr size_t WS_WIN = 2 * MiB;
constexpr size_t WS_WOUTF = 9 * MiB;
constexpr size_t WS_WSF = 11 * MiB;
constexpr size_t WS_MK = 12 * MiB + 512 * 1024, WS_MV = WS_MK + 128 * 1024;
constexpr size_t WS_X = 13 * MiB;
constexpr size_t WS_XN = 16 * MiB;
constexpr size_t WS_FQ = 48 * MiB, WS_FK = 60 * MiB, WS_FV = 72 * MiB, WS_FG = 84 * MiB;
constexpr size_t WS_MQ = 96 * MiB, WS_MG = 104 * MiB;
constexpr size_t WS_GQ = 112 * MiB, WS_GK = 118 * MiB;
constexpr size_t WS_GV = 124 * MiB, WS_GG = 136 * MiB;
constexpr size_t WS_GLR = 148 * MiB;
constexpr size_t WS_FFG = 149 * MiB;
constexpr size_t WS_CFL = 149 * MiB + 512 * 1024;
constexpr size_t WS_TOT = 149 * MiB + 512 * 1024 + 6 * 16384 * 4;
constexpr size_t WS_KVT = 150 * MiB;
constexpr size_t WS_DEC = 168 * MiB;
constexpr size_t WS_ST = 169 * MiB;
constexpr size_t WS_MIX = 192 * MiB;
constexpr size_t WS_GB = 224 * MiB;
constexpr size_t WS_END = 240 * MiB;
static_assert(WS_GLR + (size_t)M * 16 * 4 == WS_FFG, "g_lr | f_fg adjacency (EpiRoute mode 3)");
constexpr int CW_TMO = 0, CW_CODE = 1;
constexpr int CW_Q3 = 64;
constexpr int CW_NMAX = 128;
constexpr float ACP_THRESH = 50.f;
constexpr int CW_BAR = 4096;
constexpr int CW_SEAM = 16384;
static_assert((CW_SEAM + 2 * 64 * 64) * 4 <= (int)CTL_ZERO_BYTES, "CTL words inside the memset region");
constexpr int RING_OFF = 0, RING_BYTES = 151552;
constexpr int LDSCTL_OFF = RING_BYTES, MISC_OFF = LDSCTL_OFF + 320;
constexpr int OFFT_OFF = 153600, OFFT_ROW = 257;
constexpr int LDS_BYTES = 153600 + 8 * 1024;
static_assert(MISC_OFF + 128 <= OFFT_OFF && LDS_BYTES <= 163840 && attn_body::ATTN_LDS_BYTES <= RING_BYTES && pg8::STAGE_BYTES <= RING_BYTES, "LDS map");

#define GAS __attribute__((address_space(1)))
#define LAS __attribute__((address_space(3)))
typedef unsigned short bf16;
typedef unsigned v4u __attribute__((ext_vector_type(4)));
typedef float f32x4 __attribute__((ext_vector_type(4)));
typedef short bf16x8 __attribute__((ext_vector_type(8)));
typedef GAS unsigned gu32;
typedef GAS unsigned long long gu64;
#define RLX_AGENT __ATOMIC_RELAXED, __HIP_MEMORY_SCOPE_AGENT
#define LDS_WAIT() asm volatile("s_waitcnt lgkmcnt(0)" ::: "memory")
#define VM_WAIT() asm volatile("s_waitcnt vmcnt(0)" ::: "memory")
__device__ __forceinline__ unsigned long long rt() { return __builtin_amdgcn_s_memrealtime(); }
__device__ __forceinline__ unsigned f2bf(float f) { unsigned u = __builtin_bit_cast(unsigned, f); return (u + 0x7fffu + ((u >> 16) & 1u)) >> 16; }
__device__ __forceinline__ unsigned pk2(float lo, float hi) { return f2bf(lo) | (f2bf(hi) << 16); }

#define XB_TMO      128
#define XB_XCNT(j)  (256  + 64 * (j))
#define XB_XSUB(j)  (1280 + 64 * (j))
#define XB_XGEN(j)  (2304 + 64 * (j))
#define XB_TOP      3328
#define XB_TOPGEN   3392
#define XCD_BAR_WORDS 3456
#define XB_SPIN_CAP (1u << 18)

__device__ __forceinline__ unsigned xb_ld(unsigned* p)              { return __hip_atomic_load(p, __ATOMIC_RELAXED, __HIP_MEMORY_SCOPE_AGENT); }
__device__ __forceinline__ unsigned xb_add(unsigned* p, unsigned v) { return __hip_atomic_fetch_add(p, v, __ATOMIC_RELAXED, __HIP_MEMORY_SCOPE_AGENT); }
__device__ __forceinline__ unsigned xb_xcc_id() { return (unsigned)__builtin_amdgcn_s_getreg((3 << 11) | 20) & 0xFu; }
#define XB_SPIN(cond, bar) do { unsigned _sp = 0; while (cond) { __builtin_amdgcn_s_sleep(1); \
    if ((++_sp & 255u) == 0u) { if (xb_ld(&(bar)[XB_TMO])) break; if (_sp > XB_SPIN_CAP) { atomicAdd(&(bar)[XB_TMO], 1u); break; } } } } while (0)

struct XcdBarrier {
    unsigned* bar; unsigned x;
    volatile LAS unsigned* st;
};

__device__ __forceinline__ XcdBarrier xcd_barrier_post(unsigned* bar, volatile LAS unsigned* st) {
    XcdBarrier b; b.bar = bar; b.x = xb_xcc_id(); b.st = st;
    if (threadIdx.x == 0) (void)xb_add(&bar[XB_XCNT(b.x)], 1u);
    return b;
}
__device__ __forceinline__ void xcd_barrier_complete(unsigned* bar, unsigned x, unsigned& nloc, unsigned& nx) {
    const unsigned G = gridDim.x * gridDim.y * gridDim.z;
    unsigned sum, cnt, mine, sp = 0u;
    for (;;) {
        sum = 0u; cnt = 0u; mine = 0u;
#pragma unroll
        for (unsigned j = 0; j < 16; ++j) { const unsigned c = xb_ld(&bar[XB_XCNT(j)]); sum += c; cnt += (c > 0u) ? 1u : 0u; mine = (j == x) ? c : mine; }
        if (sum == G) break;
        __builtin_amdgcn_s_sleep(1);
        if ((++sp & 255u) == 0u) { if (xb_ld(&bar[XB_TMO])) break; if (sp > XB_SPIN_CAP) { atomicAdd(&bar[XB_TMO], 1u); break; } }
    }
    nloc = mine > 0u ? mine : 1u; nx = cnt > 0u ? cnt : 1u;
}

__device__ __forceinline__ void xcd_barrier(const XcdBarrier& b) {
    asm volatile("s_waitcnt vmcnt(0)" ::: "memory");
    __syncthreads();
    if (threadIdx.x == 0) {
        unsigned* bar = b.bar;
        __builtin_amdgcn_s_waitcnt(0);
        unsigned nloc = b.st[0], nx = b.st[1];
        if (nloc == 0u) { xcd_barrier_complete(bar, b.x, nloc, nx); b.st[0] = nloc; b.st[1] = nx; }
        const unsigned old = xb_add(&bar[XB_XSUB(b.x)], 1u);
        const unsigned gen = old / nloc;
        if (old + 1u == (gen + 1u) * nloc) {
            __builtin_amdgcn_fence(__ATOMIC_RELEASE, "agent");
            asm volatile("s_waitcnt vmcnt(0)" ::: "memory");
            const unsigned og = xb_add(&bar[XB_TOP], 1u);
            const unsigned tg = og / nx;
            if (og + 1u == (tg + 1u) * nx) xb_add(&bar[XB_TOPGEN], 1u);
            else XB_SPIN(xb_ld(&bar[XB_TOPGEN]) == tg, bar);
            __builtin_amdgcn_fence(__ATOMIC_ACQUIRE, "agent");
            xb_add(&bar[XB_XGEN(b.x)], 1u);
            asm volatile("s_waitcnt vmcnt(0)" ::: "memory");
        } else {
            XB_SPIN(xb_ld(&bar[XB_XGEN(b.x)]) == gen, bar);
            __builtin_amdgcn_fence(__ATOMIC_ACQUIRE, "agent");
            asm volatile("s_waitcnt vmcnt(0)" ::: "memory");
        }
    }
    __syncthreads();
}


__device__ __forceinline__ pg8::Route pg8::EpiRoute::route(int g32) const {
    Route R; R.mode = 0; R.col = 0; R.pitch = 384; size_t off;
    if (g32 < 12) { off = WS_FQ; R.col = g32 * 32; R.mode = 1; }
    else if (g32 < 24) { off = WS_FK; R.col = (g32 - 12) * 32; }
    else if (g32 < 36) { off = WS_FV; R.col = (g32 - 24) * 32; }
    else if (g32 < 48) { off = WS_FG; R.col = (g32 - 36) * 32; R.mode = 2; }
    else if (g32 < 56) { off = WS_MQ; R.col = (g32 - 48) * 32; R.pitch = 256; R.mode = 1; }
    else if (g32 < 64) { off = WS_MG; R.col = (g32 - 56) * 32; R.pitch = 256; R.mode = 2; }
    else if (g32 < 70) { off = WS_GQ; R.col = (g32 - 64) * 32; R.pitch = 192; }
    else if (g32 < 76) { off = WS_GK; R.col = (g32 - 70) * 32; R.pitch = 192; }
    else if (g32 < 88) { off = WS_GV; R.col = (g32 - 76) * 32; }
    else { off = WS_GG; R.col = (g32 - 88) * 32; R.mode = 2; }
    R.base = (bf16_t*)(ws + off); return R;
}

__device__ __forceinline__ float wave_sum(float v) {
#pragma unroll
    for (int o = 1; o < 64; o <<= 1) v += __shfl_xor(v, o);
    return v;
}
__device__ __forceinline__ void p0_transpose_item(const float* W, int K, int N, bf16* WT, int n0, int nv, int drow0, int k0, LAS float* scr, int lane) {
#pragma unroll 8
    for (int i = 0; i < 32; ++i) { const int kk = 2 * i + (lane >> 5), nn = lane & 31; scr[kk * 33 + nn] = nn < nv ? W[(size_t)(k0 + kk) * N + n0 + nn] : 0.f; }
    LDS_WAIT(); asm volatile("" ::: "memory");
    const int c = lane & 7;
#pragma unroll
    for (int j = 0; j < 4; ++j) { const int n = (lane >> 3) + 8 * j; const LAS float* s = scr + (8 * c) * 33 + n;
        v4u o; o.x = pk2(s[0 * 33], s[1 * 33]); o.y = pk2(s[2 * 33], s[3 * 33]); o.z = pk2(s[4 * 33], s[5 * 33]); o.w = pk2(s[6 * 33], s[7 * 33]);
        if (n < nv) *(GAS v4u*)(WT + (size_t)(drow0 + n) * K + k0 + 8 * c) = o; }
    LDS_WAIT(); asm volatile("" ::: "memory");
}
__device__ __forceinline__ void rms_row_to_bf16(const float* xrow, const float* g, bf16* orow, int lane) {
    const GAS f32x4* xr = (const GAS f32x4*)xrow + lane; const GAS f32x4* gr = (const GAS f32x4*)g + lane;
    f32x4 v[4]; float s = 0.f;
#pragma unroll
    for (int j = 0; j < 4; ++j) { v[j] = xr[64 * j]; s += (v[j].x * v[j].x + v[j].y * v[j].y) + (v[j].z * v[j].z + v[j].w * v[j].w); }
    const float rstd = 1.f / sqrtf(wave_sum(s) * (1.f / D) + EPS);
    GAS unsigned long long* o8 = (GAS unsigned long long*)orow + lane;
#pragma unroll
    for (int j = 0; j < 4; ++j) { const f32x4 gg = gr[64 * j]; o8[64 * j] = (unsigned long long)pk2(v[j].x * rstd * gg.x, v[j].y * rstd * gg.y) | ((unsigned long long)pk2(v[j].z * rstd * gg.z, v[j].w * rstd * gg.w) << 32); }
}
__device__ __forceinline__ void p0_mem_kv(LAS unsigned char* lds, int b, int tid, int wave, int lane, const float* mem, const float* g, const float* w, unsigned char* ws) {
    const int rg = b >> 3, cg = b & 7, c = tid & 63, col = 64 * cg + c;
    LAS float* ML = (LAS float*)lds;
    LAS float* red = ML + 8 * 1024; LAS float* sq = red + 8 * 8 * 64;
    { float ss = 0.f;
#pragma unroll
      for (int i = 0; i < 4; ++i) { const f32x4 m = *(const GAS f32x4*)(mem + (size_t)(8 * rg + wave) * D + 256 * i + 4 * lane); const f32x4 gg = *(const GAS f32x4*)(g + 256 * i + 4 * lane);
          ss += (m.x * m.x + m.y * m.y) + (m.z * m.z + m.w * m.w); *(LAS f32x4*)(ML + wave * 1024 + 256 * i + 4 * lane) = m * gg; }
      ss = wave_sum(ss); if (lane == 0) sq[wave] = ss; }
    __syncthreads();
    float acc[8];
#pragma unroll
    for (int r = 0; r < 8; ++r) acc[r] = 0.f;
    const float* wp = w + (size_t)(128 * wave) * 512 + col;
#pragma unroll 8
    for (int k4 = 0; k4 < 32; ++k4) { float wv[4];
#pragma unroll
        for (int j = 0; j < 4; ++j) wv[j] = wp[(size_t)(4 * k4 + j) * 512];
#pragma unroll
        for (int r = 0; r < 8; ++r) { const f32x4 m = *(const LAS f32x4*)(ML + r * 1024 + 128 * wave + 4 * k4); acc[r] += (m.x * wv[0] + m.y * wv[1]) + (m.z * wv[2] + m.w * wv[3]); } }
#pragma unroll
    for (int r = 0; r < 8; ++r) red[(wave * 8 + r) * 64 + c] = acc[r];
    __syncthreads();
    { const int r = tid >> 6; float a = 0.f;
#pragma unroll
      for (int wv = 0; wv < 8; ++wv) a += red[(wv * 8 + r) * 64 + c];
      const float o = a / sqrtf(sq[r] * (1.f / D) + EPS);
      bf16* dst = (bf16*)(ws + (col < 256 ? WS_MK : WS_MV)) + (size_t)(8 * rg + r) * 256 + (col & 255);
      *dst = (bf16)f2bf(o); }
    __syncthreads();
}
__device__ __forceinline__ void p0_prologue(LAS unsigned char* lds, int vcu, int G, int tid, int wave, int lane, const float* x, const float* mem, const float* norm_g, const float* w_in, const float* mem_norm_g,
                                            const float* w_mem_kv, const float* w_out, unsigned char* ws) {
    LAS float* scr = (LAS float*)(lds + RING_OFF + wave * 16384);
    const int gw = vcu * NWAVES + wave, NGW = G * NWAVES;
    constexpr int NB_IN = 96, I_IN = NB_IN * 16, I_OUT = 32 * 16, I_SK = 5 * 16, NITEMS = I_IN + I_OUT + I_SK;
    for (int it = gw; it < NITEMS; it += NGW) {
        if (it < I_IN) {
            const int nb = it >> 4, kb = it & 15; int src, width, dst, b = nb;
            if (b < 6) { src = 0; width = 192; dst = 2048; }
            else if ((b -= 6) < 6) { src = 192; width = 192; dst = 2240; }
            else if ((b -= 6) < 12) { src = 384; width = 384; dst = 2432; }
            else if ((b -= 12) < 8) { src = 784; width = 256; dst = 2816; }
            else if ((b -= 8) < 12) { src = 1168; width = 384; dst = 0; }
            else if ((b -= 12) < 12) { src = 1552; width = 384; dst = 384; }
            else if ((b -= 12) < 12) { src = 1936; width = 384; dst = 768; }
            else if ((b -= 12) < 12) { src = 2326; width = 384; dst = 1152; }
            else if ((b -= 12) < 8) { src = 2710; width = 256; dst = 1536; }
            else { b -= 8; src = 2966; width = 256; dst = 1792; }
            const int nv = (width - 32 * b) < 32 ? (width - 32 * b) : 32;
            p0_transpose_item(w_in, D, IN_COLS, (bf16*)(ws + WS_WIN), src + 32 * b, nv, dst + 32 * b, 64 * kb, scr, lane);
        } else if (it < I_IN + I_OUT) { const int r = it - I_IN, nt = r >> 4, kq = r & 15;
#pragma unroll
            for (int u = 0; u < 4; ++u) { const int ks = 4 * kq + u; const float* src = w_out + (size_t)(16 * ks + 8 * (lane >> 5)) * D + 32 * nt + (lane & 31);
                v4u o; o.x = pk2(src[0 * D], src[1 * D]); o.y = pk2(src[2 * D], src[3 * D]); o.z = pk2(src[4 * D], src[5 * D]); o.w = pk2(src[6 * D], src[7 * D]);
                *((GAS v4u*)(ws + WS_WOUTF) + (size_t)(nt * 64 + ks) * 64 + lane) = o; }
        } else { const int r = it - I_IN - I_OUT, ct = r >> 4, kq = r & 15; const int r32 = lane & 31;
            int col = -1; if (ct < 4) col = 784 + 256 + 32 * ct + r32; else if (r32 < 16) col = 768 + r32; else if (r32 < 22) col = 2320 + (r32 - 16);
#pragma unroll
            for (int u = 0; u < 4; ++u) { const int ks = 4 * kq + u; const float* src = w_in + (size_t)(16 * ks + 8 * (lane >> 5)) * IN_COLS + (col < 0 ? 0 : col);
                v4u o; o.x = pk2(src[0 * IN_COLS], src[1 * IN_COLS]); o.y = pk2(src[2 * IN_COLS], src[3 * IN_COLS]); o.z = pk2(src[4 * IN_COLS], src[5 * IN_COLS]); o.w = pk2(src[6 * IN_COLS], src[7 * IN_COLS]);
                if (col < 0) o = (v4u){0u, 0u, 0u, 0u};
                *((GAS v4u*)(ws + WS_WSF) + (size_t)(ct * 64 + ks) * 64 + lane) = o; } }
    }
    for (int m = gw; m < M; m += NGW) rms_row_to_bf16(x + (size_t)m * D, norm_g, (bf16*)(ws + WS_XN) + (size_t)m * D, lane);
    for (int b = vcu; b < 256; b += G) p0_mem_kv(lds, b, tid, wave, lane, mem, mem_norm_g, w_mem_kv, ws);
}
__device__ __forceinline__ void nan_rows_f32(int vcu, int G, int wave, int lane, float* out) {
    const int gw = vcu * NWAVES + wave, NGW = G * NWAVES; const float q = __builtin_nanf("");
    for (int m = gw; m < M; m += NGW) { GAS f32x4* o = (GAS f32x4*)(out + (size_t)m * D) + lane;
#pragma unroll
        for (int j = 0; j < 4; ++j) o[64 * j] = (f32x4){q, q, q, q}; }
}
__device__ __forceinline__ void glds16(const void* gsrc, unsigned lds_dst) { unsigned keep;
    asm volatile("s_mov_b32 %0, m0\n\ts_mov_b32 m0, %2\n\ts_nop 0\n\tglobal_load_lds_dwordx4 %1, off\n\ts_mov_b32 m0, %0" : "=&s"(keep) : "v"(gsrc), "s"(lds_dst) : "memory"); }
__device__ __forceinline__ float log_sigmoid(float z) { return fminf(z, 0.f) - log1pf(__expf(-fabsf(z))); }
__device__ __forceinline__ float bf_lo(unsigned u) { return __uint_as_float(u << 16); }
__device__ __forceinline__ float bf_hi(unsigned u) { return __uint_as_float(u & 0xffff0000u); }
__device__ __forceinline__ void gla_cum_decay(float (&b)[24], const float* glr_row, const LAS float* w_up, const LAS float* b_alpha, int w, int lane) {
    f32x4 g4[4];
#pragma unroll
    for (int i = 0; i < 4; ++i) g4[i] = *(const f32x4*)(glr_row + 4 * i);
#pragma unroll
    for (int jj = 0; jj < 24; ++jj) { const int j = 24 * w + jj; float z = b_alpha[j];
#pragma unroll
        for (int r = 0; r < 16; ++r) z += g4[r >> 2][r & 3] * w_up[r * 192 + j];
        float v = log_sigmoid(z) * (1.f / 16.f);
#pragma unroll
        for (int d = 1; d < 64; d <<= 1) { const float o = __shfl_up(v, d); if (lane >= d) v += o; }
        b[jj] = v; }
}
constexpr int GL_VT = 0, GL_VT_PITCH = 72, GL_VT_BYTES = 384 * GL_VT_PITCH * 2;
constexpr int GL_KT = GL_VT_BYTES, GL_KT_PITCH = 72, GL_KT_BYTES = 192 * GL_KT_PITCH * 2;
constexpr int GL_QD = GL_VT_BYTES, GL_QD_PITCH = 200, GL_QD_BYTES = 64 * GL_QD_PITCH * 2;
constexpr int GL_KD = GL_QD + GL_QD_BYTES;
constexpr int GL_AT = GL_QD, GL_AT_PITCH = 72, GL_AT_WAVE = 32 * GL_AT_PITCH * 2;
constexpr int GL_W = 112 * 1024, GL_BA = GL_W + 16 * 192 * 4;
static_assert(GL_KD + GL_QD_BYTES <= GL_W && GL_KT + GL_KT_BYTES <= GL_W && GL_BA + 192 * 4 <= RING_BYTES && GL_AT + 8 * GL_AT_WAVE <= GL_KD + GL_QD_BYTES + 65536 && GL_AT + 8 * GL_AT_WAVE <= RING_BYTES, "GLA LDS map");
__device__ __forceinline__ void gla_stage_vt(LAS unsigned char* lds, const bf16* GV, int t0, int tid, const float* w_up, const float* b_alpha) {
    for (int i = tid; i < 16 * 192 / 4; i += 512) ((LAS f32x4*)(lds + GL_W))[i] = ((const GAS f32x4*)w_up)[i];
    if (tid < 48) ((LAS f32x4*)(lds + GL_BA))[tid] = ((const GAS f32x4*)b_alpha)[tid];
#pragma unroll
    for (int i = 0; i < 6; ++i) { const int q = tid + 512 * i, c = q & 63, cc = q >> 6;
        const v4u d = *(const GAS v4u*)(GV + (size_t)(t0 + c) * 384 + 8 * cc);
        LAS unsigned short* p = (LAS unsigned short*)(lds + GL_VT) + (8 * cc) * GL_VT_PITCH + c;
        p[0 * GL_VT_PITCH] = (unsigned short)(d.x & 0xffffu); p[1 * GL_VT_PITCH] = (unsigned short)(d.x >> 16); p[2 * GL_VT_PITCH] = (unsigned short)(d.y & 0xffffu); p[3 * GL_VT_PITCH] = (unsigned short)(d.y >> 16);
        p[4 * GL_VT_PITCH] = (unsigned short)(d.z & 0xffffu); p[5 * GL_VT_PITCH] = (unsigned short)(d.z >> 16); p[6 * GL_VT_PITCH] = (unsigned short)(d.w & 0xffffu); p[7 * GL_VT_PITCH] = (unsigned short)(d.w >> 16); }
}
constexpr int P2_VT = 0, P2_KT = GL_VT_BYTES, P2_BL = P2_KT + GL_KT_BYTES, P2_BL_PITCH = 193;
constexpr int P2_GLR = 133 * 1024, P2_LF = P2_GLR + 4096, P2_NRM = P2_LF + 1536;
static_assert(P2_BL + 64 * P2_BL_PITCH * 4 <= P2_GLR && P2_NRM + 64 <= RING_BYTES, "P2 LDS map");
__device__ __forceinline__ float log_sigmoid_fast(float z) { const float t = __builtin_amdgcn_exp2f(-LOG2E * fabsf(z)); return fminf(z, 0.f) - 0.6931471805599453f * __builtin_amdgcn_logf(1.f + t); }
__device__ __forceinline__ void p2_chunk_item(LAS unsigned char* lds, int n, int tid, int wave, int lane, unsigned char* ws, gu32* ctl, const float* w_up, const float* b_alpha, const float* b_forget) {
    typedef float f32x16 __attribute__((ext_vector_type(16)));
    asm volatile("" : "+v"(tid), "+v"(lane), "+s"(wave));
    const int t0 = 64 * n, r32 = lane & 31, hi = lane >> 5;
    { const unsigned lds0 = (unsigned)(uintptr_t)(lds); const bf16* xn = (const bf16*)(ws + WS_XN) + (size_t)t0 * 1024;
#pragma unroll
      for (int i = 0; i < 16; ++i) { const int p = 16 * wave + i, row = p >> 1, half = p & 1; const int kc = 64 * half + (lane ^ (row & 15));
          glds16(xn + (size_t)row * 1024 + 8 * kc, (unsigned)__builtin_amdgcn_readfirstlane(lds0 + row * 2048 + half * 1024)); } }
    if (tid < 12) ((LAS unsigned*)(lds + P2_NRM))[tid] = 0u;
    v4u vreg[6];
#pragma unroll
    for (int i = 0; i < 6; ++i) { const int q = tid + 512 * i, c = q & 63, cc = q >> 6; vreg[i] = *(const GAS v4u*)((const bf16*)(ws + WS_GV) + (size_t)(t0 + c) * 384 + 8 * cc); }
    v4u kk[3];
#pragma unroll
    for (int i = 0; i < 3; ++i) kk[i] = *(const GAS v4u*)((const bf16*)(ws + WS_GK) + (size_t)(t0 + lane) * 192 + 24 * wave + 8 * i);
    const int jc = tid < 192 ? tid : tid - 192;
    float wc[16]; float ba = 0.f;
    if (tid < 384) { ba = b_alpha[jc];
#pragma unroll
        for (int r = 0; r < 16; ++r) wc[r] = w_up[r * 192 + jc]; }
    LAS float* GLRL = (LAS float*)(lds + P2_GLR); LAS float* LF = (LAS float*)(lds + P2_LF);
    if (wave < 5) {
        f32x16 c[2] = {f32x16{}, f32x16{}};
        const GAS bf16x8* bp = (const GAS bf16x8*)(ws + WS_WSF) + (size_t)(wave * 64) * 64 + lane;
        bf16x8 bq[16];
#pragma unroll
        for (int u = 0; u < 16; ++u) bq[u] = bp[u * 64];
        asm volatile("s_waitcnt vmcnt(0)" ::: "memory"); __syncthreads();
        const int sw = r32 & 15;
#pragma unroll 1
        for (int ks0 = 0; ks0 < 64; ks0 += 16) {
#pragma unroll
            for (int u = 0; u < 16; ++u) { const int ks = ks0 + u; const int off = r32 * 2048 + (((2 * ks + hi) ^ sw) * 16);
                const bf16x8 a0 = *(const LAS bf16x8*)(lds + off), a1 = *(const LAS bf16x8*)(lds + off + 32 * 2048);
                c[0] = __builtin_amdgcn_mfma_f32_32x32x16_bf16(a0, bq[u], c[0], 0, 0, 0); c[1] = __builtin_amdgcn_mfma_f32_32x32x16_bf16(a1, bq[u], c[1], 0, 0, 0);
                if (ks + 16 < 64) bq[u] = bp[(ks + 16) * 64]; } }
        if (wave < 4) {
#pragma unroll
            for (int rt = 0; rt < 2; ++rt)
#pragma unroll
                for (int r = 0; r < 16; ++r) { const float v = c[rt][r]; const int row = 32 * rt + (r & 3) + 8 * (r >> 2) + 4 * hi;
                    ((bf16*)(ws + WS_GG))[(size_t)(t0 + row) * 384 + 256 + 32 * wave + r32] = (bf16)f2bf(v * __builtin_amdgcn_rcpf(1.f + __builtin_amdgcn_exp2f(-LOG2E * v))); }
        } else {
            const float bf = r32 >= 16 && r32 < 22 ? b_forget[r32 - 16] : 0.f;
#pragma unroll
            for (int rt = 0; rt < 2; ++rt)
#pragma unroll
                for (int r = 0; r < 16; ++r) { const float v = c[rt][r]; const int row = 32 * rt + (r & 3) + 8 * (r >> 2) + 4 * hi;
                    if (r32 < 16) GLRL[row * 16 + r32] = v;
                    else if (r32 < 22) LF[(r32 - 16) * 64 + row] = LOG2E * log_sigmoid(v + bf); }
        }
    } else {
        asm volatile("s_waitcnt vmcnt(0)" ::: "memory"); __syncthreads();
        const int t = tid - 320;
#pragma unroll
        for (int pp = 0; pp < 2; ++pp) { const int p = t + 192 * pp, row = p / 6, h = p % 6;
#pragma unroll
            for (int which = 0; which < 2; ++which) { const bf16* src = (const bf16*)(ws + (which ? WS_FK : WS_FQ)) + (size_t)(t0 + row) * 384 + h * 64; float sacc = 0.f;
#pragma unroll
                for (int i = 0; i < 8; ++i) { const v4u a = *(const GAS v4u*)(src + 8 * i);
#pragma unroll
                    for (int e = 0; e < 4; ++e) { const float lo = bf_lo(a[e]), hh = bf_hi(a[e]); sacc += lo * lo + hh * hh; } }
                __hip_atomic_fetch_max((LAS unsigned*)(lds + P2_NRM) + which * 6 + h, __float_as_uint(sacc), __ATOMIC_RELAXED, __HIP_MEMORY_SCOPE_WORKGROUP); } }
    }
    __syncthreads();
    if (tid < 12) __hip_atomic_fetch_max((unsigned*)(ctl + CW_NMAX + tid), ((LAS unsigned*)(lds + P2_NRM))[tid], RLX_AGENT);
#pragma unroll
    for (int i = 0; i < 6; ++i) { const int q = tid + 512 * i, c = q & 63, cc = q >> 6; const v4u d = vreg[i];
        LAS unsigned short* p = (LAS unsigned short*)(lds + P2_VT) + (8 * cc) * GL_VT_PITCH + c;
        p[0 * GL_VT_PITCH] = (unsigned short)(d.x & 0xffffu); p[1 * GL_VT_PITCH] = (unsigned short)(d.x >> 16); p[2 * GL_VT_PITCH] = (unsigned short)(d.y & 0xffffu); p[3 * GL_VT_PITCH] = (unsigned short)(d.y >> 16);
        p[4 * GL_VT_PITCH] = (unsigned short)(d.z & 0xffffu); p[5 * GL_VT_PITCH] = (unsigned short)(d.z >> 16); p[6 * GL_VT_PITCH] = (unsigned short)(d.w & 0xffffu); p[7 * GL_VT_PITCH] = (unsigned short)(d.w >> 16); }
    LAS float* BL = (LAS float*)(lds + P2_BL);
    if (tid < 384) { const int c0 = tid < 192 ? 0 : 32; float run = 0.f;
#pragma unroll 4
        for (int c = 0; c < 32; ++c) { const LAS f32x4* g4 = (const LAS f32x4*)(GLRL + (c0 + c) * 16); float z = ba;
#pragma unroll
            for (int q = 0; q < 4; ++q) { const f32x4 g = g4[q]; z += (g.x * wc[4 * q] + g.y * wc[4 * q + 1]) + (g.z * wc[4 * q + 2] + g.w * wc[4 * q + 3]); }
            run += log_sigmoid_fast(z) * (1.f / 16.f); BL[(c0 + c) * P2_BL_PITCH + jc] = run; } }
    else if (wave == 6 || wave == 7) {
#pragma unroll
        for (int hh = 0; hh < 3; ++hh) { const int h = 3 * (wave - 6) + hh; float v = LF[h * 64 + lane];
#pragma unroll
            for (int d = 1; d < 64; d <<= 1) { const float o = __shfl_up(v, d); if (lane >= d) v += o; }
            ((float*)(ws + WS_CFL))[(size_t)h * M + t0 + lane] = v; if (lane == 63) ((float*)(ws + WS_TOT))[h * 256 + n] = v; } }
    __syncthreads();
    { LAS unsigned short* kt = (LAS unsigned short*)(lds + P2_KT); float* dec = (float*)(ws + WS_DEC) + (size_t)n * 192; float b[24];
#pragma unroll
      for (int jj = 0; jj < 24; ++jj) { const int j = 24 * wave + jj; const float half = BL[31 * P2_BL_PITCH + j]; const float bl = BL[63 * P2_BL_PITCH + j] + half;
          const float bv = BL[lane * P2_BL_PITCH + j] + (lane >= 32 ? half : 0.f); b[jj] = bv;
          const unsigned u = kk[jj >> 3][(jj & 7) >> 1]; const float kv = (jj & 1) ? bf_hi(u) : bf_lo(u);
          kt[j * GL_KT_PITCH + lane] = (unsigned short)f2bf(kv * __expf(bl - bv));
          if (lane == 63) dec[j] = __expf(bl); }
      float* gb = (float*)(ws + WS_GB) + (size_t)(t0 + lane) * 192 + 24 * wave;
#pragma unroll
      for (int i = 0; i < 6; ++i) *(f32x4*)(gb + 4 * i) = (f32x4){b[4 * i], b[4 * i + 1], b[4 * i + 2], b[4 * i + 3]}; }
    __syncthreads();
    { const int r16 = lane & 15, q4 = lane >> 4;
      float* kvt = (float*)(ws + WS_KVT) + (size_t)n * 18432;
      for (int ti = wave; ti < 72; ti += 8) { const int h = ti / 18, rem = ti % 18, vt = rem / 3, kt3 = rem % 3;
          pg8::f32x4 acc = {0.f, 0.f, 0.f, 0.f};
#pragma unroll
          for (int ks = 0; ks < 2; ++ks) {
              const bf16x8 a = *(const LAS bf16x8*)(lds + P2_VT + ((h * 96 + vt * 16 + r16) * GL_VT_PITCH + ks * 32 + 8 * q4) * 2);
              const bf16x8 bb = *(const LAS bf16x8*)(lds + P2_KT + ((h * 48 + kt3 * 16 + r16) * GL_KT_PITCH + ks * 32 + 8 * q4) * 2);
              acc = __builtin_amdgcn_mfma_f32_16x16x32_bf16(a, bb, acc, 0, 0, 0); }
#pragma unroll
          for (int r = 0; r < 4; ++r) kvt[(size_t)(h * 96 + vt * 16 + q4 * 4 + r) * 48 + kt3 * 16 + r16] = acc[r]; } }
    __syncthreads();
}
__device__ __forceinline__ void gla_scan_item(int item, int tid, unsigned char* ws) {
    const int e = item * 512 + tid, h = e / 4608, k = e % 48;
    const float* kvt = (const float*)(ws + WS_KVT) + e; const float* dec = (const float*)(ws + WS_DEC) + h * 48 + k; bf16* st = (bf16*)(ws + WS_ST) + e;
    float S = 0.f;
    for (int n0 = 0; n0 < 256; n0 += 16) { float kv[16], dc[16];
#pragma unroll
        for (int i = 0; i < 16; ++i) { kv[i] = kvt[(size_t)(n0 + i) * 18432]; dc[i] = dec[(size_t)(n0 + i) * 192]; }
#pragma unroll
        for (int i = 0; i < 16; ++i) { st[(size_t)(n0 + i) * 18432] = (bf16)f2bf(S); S = dc[i] * S + kv[i]; } }
}
constexpr int FO_AMG = 0;
constexpr int FO_VT = 49152;
constexpr int FO_QD = 98304, FO_KD = FO_QD + 24576;
constexpr int FO_AT = FO_QD;
constexpr int FO_AR1 = 49152;
constexpr int FO_AR2 = FO_AR1 + 65536;
constexpr int FO_TR = 0, FO_TR_WAVE = 32 * 528;
constexpr int FO_RED = 8 * FO_TR_WAVE, FO_RS = FO_RED + 2048;
static_assert(FO_AR2 + 16384 <= RING_BYTES && FO_KD + 24576 <= RING_BYTES && FO_RS + 256 <= RING_BYTES, "fused out-projection LDS map");
template <int CTRL> __device__ __forceinline__ float dppf(float x) { return __builtin_bit_cast(float, __builtin_amdgcn_mov_dpp(__builtin_bit_cast(int, x), CTRL, 0xf, 0xf, true)); }
__device__ __forceinline__ float half_sum(float v) {
    v += dppf<0xB1>(v); v += dppf<0x4E>(v); v += dppf<0x141>(v); v += dppf<0x140>(v);
    auto s = __builtin_amdgcn_permlane16_swap(__float_as_uint(v), __float_as_uint(v), false, false);
    return __uint_as_float(s[0]) + __uint_as_float(s[1]);
}
__device__ __forceinline__ void fused_out_item(LAS unsigned char* lds, int n, int tid, int wave, int lane, unsigned char* ws, const float* x, const float* gng, const float* fng, float* out) {
    typedef float f32x16 __attribute__((ext_vector_type(16)));
    asm volatile("" : "+v"(tid), "+v"(lane), "+s"(wave));
    const int t0 = 64 * n; const int r32 = lane & 31, hi = lane >> 5;
    for (int rpa = 0; rpa < NREP(40); ++rpa) {
#pragma unroll
    for (int i = 0; i < 6; ++i) { const int q = tid + 512 * i, c = q & 63, cc = q >> 6;
        const v4u d = *(const GAS v4u*)((const bf16*)(ws + WS_GV) + (size_t)(t0 + c) * 384 + 8 * cc);
        LAS unsigned char* p = lds + FO_VT + (c & 7) * 2; const int kc = c >> 3;
#pragma unroll
        for (int e = 0; e < 8; ++e) { const int v = 8 * cc + e; const unsigned w = d[e >> 1]; const unsigned short val = (e & 1) ? (unsigned short)(w >> 16) : (unsigned short)(w & 0xffffu);
            *(LAS unsigned short*)(p + v * 128 + ((kc ^ ((v >> 1) & 7)) * 16)) = val; } }
    { const size_t row = (size_t)(t0 + lane);
      v4u qq[3], kk[3]; f32x4 bb[6];
#pragma unroll
      for (int i = 0; i < 3; ++i) { qq[i] = *(const GAS v4u*)((const bf16*)(ws + WS_GQ) + row * 192 + 24 * wave + 8 * i); kk[i] = *(const GAS v4u*)((const bf16*)(ws + WS_GK) + row * 192 + 24 * wave + 8 * i); }
#pragma unroll
      for (int i = 0; i < 6; ++i) bb[i] = *(const GAS f32x4*)((const float*)(ws + WS_GB) + row * 192 + 24 * wave + 4 * i);
      const float qs = 0.14433756729740643f;
      const int sw = (lane >> 1) & 7;
#pragma unroll
      for (int i = 0; i < 3; ++i) { v4u oq, ok;
#pragma unroll
          for (int e = 0; e < 4; ++e) { const float b0 = bb[2 * i + (e >> 1)][(2 * e) & 3], b1 = bb[2 * i + (e >> 1)][((2 * e) & 3) + 1];
              oq[e] = pk2(bf_lo(qq[i][e]) * qs * __expf(b0), bf_hi(qq[i][e]) * qs * __expf(b1)); ok[e] = pk2(bf_lo(kk[i][e]) * __expf(-b0), bf_hi(kk[i][e]) * __expf(-b1)); }
          const int ch = 3 * wave + i, chs = (ch & ~7) | ((ch & 7) ^ sw);
          *(LAS v4u*)(lds + FO_QD + lane * 384 + chs * 16) = oq; *(LAS v4u*)(lds + FO_KD + lane * 384 + chs * 16) = ok; } }
    __syncthreads();
    const int h = wave >> 1, rh = wave & 1;
    {
      f32x16 at[2] = {f32x16{}, f32x16{}}, o[3] = {f32x16{}, f32x16{}, f32x16{}};
      bf16x8 qa[3];
      { const int row = 32 * rh + r32, sw = (row >> 1) & 7;
#pragma unroll
        for (int ks = 0; ks < 3; ++ks) { const int ch = 6 * h + 2 * ks + hi; qa[ks] = *(const LAS bf16x8*)(lds + FO_QD + row * 384 + ((ch & ~7) | ((ch & 7) ^ sw)) * 16); } }
#pragma unroll
      for (int st = 0; st < 2; ++st) if (st <= rh) { const int row = 32 * st + r32, sw = (row >> 1) & 7;
#pragma unroll
          for (int ks = 0; ks < 3; ++ks) { const int ch = 6 * h + 2 * ks + hi; const bf16x8 kb = *(const LAS bf16x8*)(lds + FO_KD + row * 384 + ((ch & ~7) | ((ch & 7) ^ sw)) * 16);
              at[st] = __builtin_amdgcn_mfma_f32_32x32x16_bf16(qa[ks], kb, at[st], 0, 0, 0); } }
      const bf16* stn = (const bf16*)(ws + WS_ST) + (size_t)n * 18432 + (size_t)h * 4608;
#pragma unroll
      for (int vt = 0; vt < 3; ++vt)
#pragma unroll
          for (int ks = 0; ks < 3; ++ks) { const bf16x8 sb = *(const GAS bf16x8*)(stn + (32 * vt + r32) * 48 + 16 * ks + 8 * hi);
              o[vt] = __builtin_amdgcn_mfma_f32_32x32x16_bf16(qa[ks], sb, o[vt], 0, 0, 0); }
      __syncthreads();
      LAS unsigned char* atw = lds + FO_AT + wave * 4096;
#pragma unroll
      for (int st = 0; st < 2; ++st) if (st <= rh) {
#pragma unroll
          for (int r = 0; r < 16; ++r) { const int cl = (r & 3) + 8 * (r >> 2) + 4 * hi, c = 32 * rh + cl, s = 32 * st + r32;
              *(LAS unsigned short*)(atw + cl * 128 + (((s >> 3) ^ ((cl >> 1) & 7)) * 16) + (s & 7) * 2) = (unsigned short)f2bf(s <= c ? at[st][r] : 0.f); } }
      LDS_WAIT(); asm volatile("" ::: "memory");
#pragma unroll
      for (int ks = 0; ks < 4; ++ks) if (ks < 2 * rh + 2) { const bf16x8 aa = *(const LAS bf16x8*)(atw + r32 * 128 + (((2 * ks + hi) ^ ((r32 >> 1) & 7)) * 16));
#pragma unroll
          for (int vt = 0; vt < 3; ++vt) { const int v = h * 96 + 32 * vt + r32; const bf16x8 vb = *(const LAS bf16x8*)(lds + FO_VT + v * 128 + (((2 * ks + hi) ^ ((v >> 1) & 7)) * 16));
              o[vt] = __builtin_amdgcn_mfma_f32_32x32x16_bf16(aa, vb, o[vt], 0, 0, 0); } }
      const bf16* gg = (const bf16*)(ws + WS_GG);
      float gn[3];
#pragma unroll
      for (int vt = 0; vt < 3; ++vt) gn[vt] = gng[32 * vt + r32];
#pragma unroll
      for (int r = 0; r < 16; ++r) { const float ss = half_sum(o[0][r] * o[0][r] + o[1][r] * o[1][r] + o[2][r] * o[2][r]);
          const float rstd = 1.f / sqrtf(ss * (1.f / 96.f) + EPS);
          const int rl = 32 * rh + (r & 3) + 8 * (r >> 2) + 4 * hi; const size_t row = (size_t)(t0 + rl);
#pragma unroll
          for (int vt = 0; vt < 3; ++vt) { const int col = h * 96 + 32 * vt + r32; const float g = __uint_as_float((unsigned)gg[row * 384 + col] << 16);
              *(LAS unsigned short*)(lds + FO_AMG + rl * 768 + (((col >> 3) ^ (rl & 15)) * 16) + (col & 7) * 2) = (unsigned short)f2bf(o[vt][r] * rstd * gn[vt] * g); } }
    }
    __syncthreads();
    }
    { const unsigned lds0 = (unsigned)(uintptr_t)(lds); const bf16* mix = (const bf16*)(ws + WS_MIX) + (size_t)t0 * 1024;
#pragma unroll
      for (int i = 0; i < 8; ++i) { const int row = 8 * wave + i; const int kc = lane ^ (row & 15);
          glds16(mix + (size_t)row * 1024 + 384 + 8 * kc, (unsigned)__builtin_amdgcn_readfirstlane(lds0 + FO_AR1 + row * 1024)); }
#pragma unroll
      for (int i = 0; i < 2; ++i) { const int q = 2 * wave + i, row = 4 * q + (lane >> 4); const int kc = (lane & 15) ^ (row & 15);
          glds16(mix + (size_t)row * 1024 + 896 + 8 * kc, (unsigned)__builtin_amdgcn_readfirstlane(lds0 + FO_AR2 + q * 1024)); } }
    f32x16 acc[2][4];
#pragma unroll
    for (int rt = 0; rt < 2; ++rt)
#pragma unroll
        for (int ct = 0; ct < 4; ++ct) acc[rt][ct] = f32x16{};
    for (int rpb = 0; rpb < NREP(41); ++rpb) {
    const GAS bf16x8* wf = (const GAS bf16x8*)(ws + WS_WOUTF) + (size_t)(4 * wave) * 64 * 64 + lane;
    bf16x8 bq[4][4];
#pragma unroll
    for (int u = 0; u < 4; ++u)
#pragma unroll
        for (int ct = 0; ct < 4; ++ct) bq[u][ct] = wf[(ct * 64 + u) * 64];
    const int sw15 = r32 & 15;
#pragma unroll 1
    for (int ks0 = 0; ks0 < 64; ks0 += 4) {
        if (ks0 == 24) { asm volatile("s_waitcnt vmcnt(0)" ::: "memory"); __syncthreads(); }
#pragma unroll
        for (int u = 0; u < 4; ++u) { const int ks = ks0 + u, kc = 2 * ks + hi;
            int a_off;
            if (ks0 < 24) a_off = FO_AMG + r32 * 768 + ((kc ^ sw15) * 16);
            else if (ks0 < 56) a_off = FO_AR1 + r32 * 1024 + (((kc - 48) ^ sw15) * 16);
            else a_off = FO_AR2 + r32 * 256 + (((kc - 112) ^ sw15) * 16);
            const int rstep = ks0 < 24 ? 32 * 768 : (ks0 < 56 ? 32 * 1024 : 32 * 256);
            const bf16x8 a0 = *(const LAS bf16x8*)(lds + a_off), a1 = *(const LAS bf16x8*)(lds + a_off + rstep);
#pragma unroll
            for (int ct = 0; ct < 4; ++ct) { acc[0][ct] = __builtin_amdgcn_mfma_f32_32x32x16_bf16(a0, bq[u][ct], acc[0][ct], 0, 0, 0); acc[1][ct] = __builtin_amdgcn_mfma_f32_32x32x16_bf16(a1, bq[u][ct], acc[1][ct], 0, 0, 0); }
            if (ks + 4 < 64) {
#pragma unroll
                for (int ct = 0; ct < 4; ++ct) bq[u][ct] = wf[(ct * 64 + ks + 4) * 64]; }
        }
    }
    }
    if (NREP(41) == 2) {
#pragma unroll
    for (int rt = 0; rt < 2; ++rt)
#pragma unroll
        for (int ct = 0; ct < 4; ++ct) acc[rt][ct] *= 0.5f; }
    __syncthreads();
    LAS float* tr = (LAS float*)(lds + FO_TR + wave * FO_TR_WAVE);
    LAS float* red = (LAS float*)(lds + FO_RED);
    f32x4 v[2][16];
    const int c4 = lane & 31, rsel = lane >> 5;
#pragma unroll
    for (int rt = 0; rt < 2; ++rt) {
#pragma unroll
        for (int ct = 0; ct < 4; ++ct)
#pragma unroll
            for (int r = 0; r < 16; ++r) tr[((r & 3) + 8 * (r >> 2) + 4 * hi) * 132 + 32 * ct + r32] = acc[rt][ct][r];
        LDS_WAIT(); asm volatile("" ::: "memory");
#pragma unroll
        for (int i = 0; i < 16; ++i) { const int rl = 2 * i + rsel; const size_t row = (size_t)(t0 + 32 * rt + rl);
            const f32x4 xv = *(const GAS f32x4*)(x + row * 1024 + 128 * wave + 4 * c4);
            f32x4 t = *(const LAS f32x4*)(tr + rl * 132 + 4 * c4); t += xv; v[rt][i] = t;
            const float ss = half_sum((t[0] * t[0] + t[1] * t[1]) + (t[2] * t[2] + t[3] * t[3]));
            if (c4 == 0) red[(32 * rt + rl) * 8 + wave] = ss; }
        LDS_WAIT(); asm volatile("" ::: "memory");
    }
    __syncthreads();
    if (tid < 64) { float q = 0.f;
#pragma unroll
        for (int w = 0; w < 8; ++w) q += red[tid * 8 + w];
        ((LAS float*)(lds + FO_RS))[tid] = 1.0f / sqrtf(q * (1.0f / 1024.0f) + EPS); }
    __syncthreads();
    const f32x4 gv = *(const GAS f32x4*)(fng + 128 * wave + 4 * c4);
#pragma unroll
    for (int rt = 0; rt < 2; ++rt)
#pragma unroll
        for (int i = 0; i < 16; ++i) { const int rl = 32 * rt + 2 * i + rsel; const float rs = ((const LAS float*)(lds + FO_RS))[rl];
            *(GAS f32x4*)(out + (size_t)(t0 + rl) * 1024 + 128 * wave + 4 * c4) = v[rt][i] * rs * gv; }
    __syncthreads();
}


struct Args { const float* in[12]; float* out; unsigned char* ws; int ph_lo, ph_hi, li, pad; };
__global__ void __launch_bounds__(NWAVES * 64, 2) hymba_fwd(Args args) {
    extern __shared__ __attribute__((aligned(16))) unsigned char lds_raw[];
    LAS unsigned char* lds = (LAS unsigned char*)lds_raw;
    volatile LAS unsigned* MISC = (volatile LAS unsigned*)(lds + MISC_OFF);
    const int tid = threadIdx.x, lane = tid & 63, wave = __builtin_amdgcn_readfirstlane(tid >> 6);
    const int G = gridDim.x; const int bx = blockIdx.x; const int vcu = (G % 8 == 0) ? (bx % 8) * (G / 8) + bx / 8 : bx;
    unsigned char* ws = args.ws; gu32* ctl = (gu32*)(ws + WS_CTL);
    const float* x = args.in[0]; const float* mem = args.in[1]; const float* norm_g = args.in[2]; const float* w_in = args.in[3]; const float* w_up = args.in[4]; const float* b_alpha = args.in[5];
    const float* b_forget = args.in[6]; const float* gla_norm_g = args.in[7]; const float* mem_norm_g = args.in[8]; const float* w_mem_kv = args.in[9]; const float* w_out = args.in[10]; const float* final_norm_g = args.in[11];
    for (int u = tid; u < (LDS_BYTES - LDSCTL_OFF) / 4; u += NWAVES * 64) ((LAS unsigned*)(lds + LDSCTL_OFF))[u] = 0u;
    __syncthreads();
    XcdBarrier bar; bar.bar = (unsigned*)(ctl + CW_BAR); bar.x = 0; bar.st = nullptr;
    if (N_LAUNCHES != PER_PHASE) bar = xcd_barrier_post((unsigned*)(ctl + CW_BAR), MISC + 8);
#define GRID_BAR(seam) do { if (N_LAUNCHES == PER_PHASE) { if (tid == 0) __hip_atomic_store(ctl + CW_TMO, 0xBADBA0u | (unsigned)(seam), RLX_AGENT); } else { xcd_barrier(bar); } } while (0)
    const int lo = args.ph_lo, hi = args.ph_hi;
#define IN(k) (lo <= (k) && (k) < hi)
#define BOTH(k) (IN(k) && IN((k) + 1))

    if (IN(0)) { for (int rp = 0; rp < NREP(0); ++rp) p0_prologue(lds, vcu, G, tid, wave, lane, x, mem, norm_g, w_in, mem_norm_g, w_mem_kv, w_out, ws); if (BOTH(0)) GRID_BAR(0); }

    if (IN(1)) {
        for (int rp = 0; rp < NREP(1); ++rp) {
        { pg8::Gemm g{(const pg8::bf16_t*)(ws + WS_XN), (const pg8::bf16_t*)(ws + WS_WIN), M, NP, D}; pg8::StaticOrder S; S.init(M, NP, G, (int)blockIdx.x);
          pg8::EpiRoute E{ws, attn_body::C2};
          pg8::gemm_phase<pg8::EpiRoute, pg8::StaticOrder, true, true>(lds + RING_OFF, g, S, E); }
        }
        if (BOTH(1)) GRID_BAR(1);
    }

    if (IN(2)) {
        for (int rp = 0; rp < NREP(2); ++rp) {
        for (int n = vcu; n < 256; n += G) p2_chunk_item(lds, n, tid, wave, lane, ws, ctl, w_up, b_alpha, b_forget);
        }
        if (BOTH(2)) GRID_BAR(2);
    }

    if (IN(3)) {
        {
          LAS float* offt = (LAS float*)(lds + OFFT_OFF);
          float v[6];
          if (tid < 256) {
#pragma unroll
              for (int h = 0; h < 6; ++h) v[h] = ((const float*)(ws + WS_TOT))[h * 256 + tid];
#pragma unroll
              for (int d = 1; d < 64; d <<= 1) {
#pragma unroll
                  for (int h = 0; h < 6; ++h) { const float o = __shfl_up(v[h], d); if (lane >= d) v[h] += o; } }
              if (lane == 63) {
#pragma unroll
                  for (int h = 0; h < 6; ++h) ((LAS float*)(lds + RING_OFF))[h * 4 + wave] = v[h]; } }
          __syncthreads();
          if (tid < 256) {
#pragma unroll
              for (int h = 0; h < 6; ++h) { float add = 0.f; for (int w = 0; w < wave; ++w) add += ((LAS float*)(lds + RING_OFF))[h * 4 + w]; offt[h * OFFT_ROW + tid + 1] = v[h] + add; }
              offt[6 * OFFT_ROW + tid] = 0.f; if (tid < 7) offt[tid * OFFT_ROW + (tid == 6 ? 256 : 0)] = 0.f; }
          __syncthreads(); }
        for (int rp = 0; rp < NREP(3); ++rp)
        for (;;) {
            __syncthreads();
            if (tid == 0) { MISC[16] = __hip_atomic_fetch_add(ctl + CW_Q3 + 32 * rp, 1u, RLX_AGENT); MISC[17] = 0xffffu; }
            __syncthreads();
            const int it = (int)MISC[16];
            if (it >= 36 + 384 + 256) break;
            if (it < 36) { gla_scan_item(it, tid, ws); continue; }
            int q0, NT, qoff, pitch; size_t oq, ok, ov, og; int ocol; const float* cfl; float cref; const LAS float* offp;
            if (it < 36 + 384) { const int i = it - 36, qb = 63 - i / 6, h = i % 6; q0 = 256 * qb; NT = 4 * qb + 4; qoff = 0; pitch = 384;
                oq = WS_FQ + h * 128; ok = WS_FK + h * 128; ov = WS_FV + h * 128; og = WS_FG + h * 128; ocol = 384 + h * 64; cfl = (const float*)(ws + WS_CFL) + (size_t)h * M;
                const LAS float* offt = (const LAS float*)(lds + OFFT_OFF) + h * OFFT_ROW;
                cref = cfl[q0] + offt[4 * qb];
                const float b2 = 2.f * sqrtf(__uint_as_float(ctl[CW_NMAX + h]) * __uint_as_float(ctl[CW_NMAX + 6 + h])) + 1.0f;
                int cand = NT - 4; if (tid < NT - 4 && b2 + cref - offt[tid + 1] >= -ACP_THRESH) cand = tid;
#pragma unroll
                for (int o = 1; o < 64; o <<= 1) { const int t = __shfl_xor(cand, o); cand = t < cand ? t : cand; }
                if (lane == 0) __hip_atomic_fetch_min((LAS unsigned*)(lds + MISC_OFF) + 17, (unsigned)cand, __ATOMIC_RELAXED, __HIP_MEMORY_SCOPE_WORKGROUP);
                __syncthreads();
                const int t_lo = (int)MISC[17] & ~1;
                NT -= t_lo; ok += (size_t)t_lo * 64 * 384 * 2; ov += (size_t)t_lo * 64 * 384 * 2; cfl += t_lo * 64; offp = offt + t_lo; }
            else { const int i = it - 36 - 384, qb = i >> 2, h = i & 3; q0 = 256 * qb; NT = 4; qoff = 1 << 24; pitch = 256;
                oq = WS_MQ + h * 128; ok = WS_MK + h * 128; ov = WS_MV + h * 128; og = WS_MG + h * 128; ocol = 768 + h * 64; cfl = (const float*)(ws + WS_ZERO); cref = 0.f; offp = (const LAS float*)(lds + OFFT_OFF) + 6 * OFFT_ROW; }
            attn_body::attn_unit<8, 1024, true, true>(q0, NT, qoff, pitch, pitch, pitch, (const attn_body::bf16*)(ws + oq), (const attn_body::bf16*)(ws + ok), (const attn_body::bf16*)(ws + ov),
                (const attn_body::bf16*)(ws + og), (attn_body::bf16*)(ws + WS_MIX) + ocol, cfl, offp, cref, (char*)lds_raw + RING_OFF);
        }
        if (BOTH(3)) GRID_BAR(3);
    }

    if (IN(4)) {
        for (int rp = 0; rp < NREP(4); ++rp)
        for (int n = vcu; n < 256; n += G) fused_out_item(lds, n, tid, wave, lane, ws, x, gla_norm_g, final_norm_g, args.out);
    }
#undef IN
#undef BOTH
}

extern "C" void kernel_launch(void* const* d_in, const int* in_sizes, int n_in, void* d_out, int out_size, void* d_ws, size_t ws_size, hipStream_t stream) {
    static int grid = 0;
    if (grid == 0) {
        if (n_in != 12 || in_sizes[0] != M * D || out_size != M * D || ws_size < WS_END) { fprintf(stderr, "kernel_launch: unexpected shapes (n_in %d, in0 %d, out %d, ws %zu); nothing launched\n", n_in, n_in > 0 ? in_sizes[0] : -1, out_size, ws_size); grid = -1; return; }
        int dev = 0, cus = 0, per_cu = 0;
        if (hipGetDevice(&dev) != hipSuccess || hipDeviceGetAttribute(&cus, hipDeviceAttributeMultiprocessorCount, dev) != hipSuccess) { fprintf(stderr, "kernel_launch: device query failed\n"); grid = -1; return; }
        if (hipFuncSetAttribute((const void*)hymba_fwd, hipFuncAttributeMaxDynamicSharedMemorySize, LDS_BYTES) != hipSuccess) { fprintf(stderr, "kernel_launch: hipFuncSetAttribute failed\n"); grid = -1; return; }
        if (hipOccupancyMaxActiveBlocksPerMultiprocessor(&per_cu, (const void*)hymba_fwd, NWAVES * 64, LDS_BYTES) != hipSuccess || per_cu < 1) { fprintf(stderr, "kernel_launch: occupancy query reports %d workgroups per CU; nothing launched\n", per_cu); (void)hipGetLastError(); grid = -1; return; }
        grid = cus;
        if (grid != 256) fprintf(stderr, "kernel_launch: launching %d workgroups; the fused final phase needs exactly 256\n", grid);
    }
    if (grid < 0) return;
    if (hipMemsetAsync((char*)d_ws + WS_CTL, 0, CTL_ZERO_BYTES, stream) != hipSuccess) { fprintf(stderr, "kernel_launch: hipMemsetAsync failed\n"); return; }
    Args a{};
    for (int i = 0; i < 12; ++i) a.in[i] = (const float*)d_in[i];
    a.out = (float*)d_out; a.ws = (unsigned char*)d_ws;
    for (int li = 0; li < N_LAUNCHES; ++li) {
        a.ph_lo = (N_LAUNCHES == PER_PHASE) ? li : 0; a.ph_hi = (N_LAUNCHES == PER_PHASE) ? li + 1 : PER_PHASE; a.li = li;
        hipLaunchKernelGGL(hymba_fwd, dim3(grid), dim3(NWAVES * 64), LDS_BYTES, stream, a);
        const hipError_t le = hipPeekAtLastError();
        if (le != hipSuccess) { fprintf(stderr, "kernel_launch: launch %d failed: %s\n", li, hipGetErrorName(le)); break; }
    }
}
```

```cpp
#include <hip/hip_runtime.h>
#include <cstdio>
#include <cstdint>
namespace pg8 {
#define PG8_LAS __attribute__((address_space(3)))
typedef unsigned short bf16_t;
typedef short bf16x8 __attribute__((ext_vector_type(8)));
typedef float f32x4 __attribute__((ext_vector_type(4)));
typedef unsigned u32x4 __attribute__((ext_vector_type(4)));
constexpr int BM = 256, BK = 64, HALF = 128, HTB = HALF * BK * 2  , STAGE_BYTES = 8 * HTB, NXCD = 8, WGM = 8;

__host__ __device__ __forceinline__ int lds_byte(int r, int c) { const int st = (r >> 4) * 2 + (c >> 5), rr = r & 15, cc = c & 31, ob = rr * 64 + cc * 2; return st * 1024 + (ob ^ (((ob >> 9) & 1) << 5)); }
__host__ __device__ __forceinline__ void stage_rc(int b, int& R, int& C) { const int st = b / 1024, sb = b % 1024, swz = sb ^ (((sb >> 9) & 1) << 5); R = (st >> 1) * 16 + swz / 64; C = (st & 1) * 32 + (swz % 64) / 2; }
__host__ __device__ __forceinline__ int perm32(int rho) { const int n = rho >> 4, i = rho & 15; return 8 * (i >> 2) + 4 * n + (i & 3); }

struct Unit { int pm, pn; };
struct Gemm { const bf16_t* A; const bf16_t* Bt; int M, N, K; };

struct StaticOrder {
    int nM, nN, nwg, G, c;
    __host__ __device__ void init(int M, int N, int G_, int c_) { nM = M / BM; nN = N / BM; nwg = nM * nN; G = G_; c = c_; }
    __host__ __device__ bool next(int i, Unit& u) const {
        const long L = (long)i * G + c; if (L >= nwg) return false;
        int wgid = (int)L; { const int q = nwg / NXCD, r = nwg % NXCD, xcd = wgid % NXCD, off = wgid / NXCD; wgid = (xcd < r ? xcd * (q + 1) : r * (q + 1) + (xcd - r) * q) + off; }
        const int nig = WGM * nN, gid = wgid / nig, fm = gid * WGM, gsz = (nM - fm) < WGM ? (nM - fm) : WGM;
        u.pm = fm + ((wgid % nig) % gsz); u.pn = (wgid % nig) / gsz; return true;
    }
    __device__ __forceinline__ void a_ready(const Unit&) const {}
    __device__ __forceinline__ void done(const Unit&) const {}
};


__device__ __forceinline__ unsigned cvt_pk_bf16(float lo, float hi) { unsigned r; asm volatile("v_cvt_pk_bf16_f32 %0, %1, %2" : "=v"(r) : "v"(lo), "v"(hi)); return r; }
typedef float f32x2 __attribute__((ext_vector_type(2)));

struct EpiBf16 {
    static constexpr bool PERM = true, AFTER_DRAIN = false;
    bf16_t* O; int ldc; int split_cols; size_t split_stride;
    __device__ __forceinline__ void operator()(const f32x4 (&acc)[2][2][4][2], const Unit& u, int wr, int wc, int fr, int fq) const {
        const int row0 = u.pm * BM + wr * 64 + fr; int colt = u.pn * BM; bf16_t* base = O;
        if (split_cols) { const int t = colt / split_cols; base += (size_t)t * split_stride; colt -= t * split_cols; }
        const int col0 = colt + wc * 32 + 8 * fq;
#pragma unroll
        for (int ai = 0; ai < 2; ++ai)
#pragma unroll
            for (int m = 0; m < 4; ++m) { bf16_t* rowp = base + (size_t)(row0 + ai * HALF + m * 16) * ldc + col0;
#pragma unroll
                for (int bj = 0; bj < 2; ++bj) { const f32x4 v0 = acc[ai][bj][m][0], v1 = acc[ai][bj][m][1];
                    u32x4 w; w.x = cvt_pk_bf16(v0[0], v0[1]); w.y = cvt_pk_bf16(v0[2], v0[3]); w.z = cvt_pk_bf16(v1[0], v1[1]); w.w = cvt_pk_bf16(v1[2], v1[3]);
                    *(u32x4*)(rowp + bj * HALF) = w; } }
    }
};

struct RouteTab { unsigned char* ws; };
struct Route { bf16_t* base; int pitch, col, mode; };
struct EpiRoute {
    static constexpr bool PERM = true, AFTER_DRAIN = false;
    unsigned char* ws; float qscale;
    __device__ __forceinline__ Route route(int g32) const;
    __device__ __forceinline__ void operator()(const f32x4 (&acc)[2][2][4][2], const Unit& u, int wr, int wc, int fr, int fq) const {
        const int row0 = u.pm * BM + wr * 64 + fr;
#pragma unroll
        for (int bj = 0; bj < 2; ++bj) {
            const Route R = route(8 * u.pn + 4 * bj + wc);
            if (R.mode == 4) continue;
            if (R.mode == 3) {
                float* glr = (float*)R.base; float* ffg = glr + (size_t)16384 * 16;
#pragma unroll
                for (int ai = 0; ai < 2; ++ai)
#pragma unroll
                    for (int m = 0; m < 4; ++m) { const size_t row = (size_t)(row0 + ai * HALF + m * 16);
                        const f32x4 v0 = acc[ai][bj][m][0], v1 = acc[ai][bj][m][1];
                        if (fq < 2) { *(f32x4*)(glr + row * 16 + 8 * fq) = v0; *(f32x4*)(glr + row * 16 + 8 * fq + 4) = v1; }
                        else if (fq == 2) { *(f32x4*)(ffg + row * 8) = v0; *(f32x4*)(ffg + row * 8 + 4) = v1; } }
                continue;
            }
            const float sc = R.mode == 1 ? qscale : 1.f;
#pragma unroll
            for (int ai = 0; ai < 2; ++ai)
#pragma unroll
                for (int m = 0; m < 4; ++m) { bf16_t* rowp = R.base + (size_t)(row0 + ai * HALF + m * 16) * R.pitch + R.col + 8 * fq;
                    f32x4 v0 = acc[ai][bj][m][0], v1 = acc[ai][bj][m][1];
                    if (R.mode == 2) {
#pragma unroll
                        for (int e = 0; e < 4; ++e) { v0[e] = v0[e] * __builtin_amdgcn_rcpf(1.f + __builtin_amdgcn_exp2f(-1.4426950408889634f * v0[e])); v1[e] = v1[e] * __builtin_amdgcn_rcpf(1.f + __builtin_amdgcn_exp2f(-1.4426950408889634f * v1[e])); }
                    } else { v0 = v0 * sc; v1 = v1 * sc; }
                    u32x4 w; w.x = cvt_pk_bf16(v0[0], v0[1]); w.y = cvt_pk_bf16(v0[2], v0[3]); w.z = cvt_pk_bf16(v1[0], v1[1]); w.w = cvt_pk_bf16(v1[2], v1[3]);
                    asm volatile("global_store_dwordx4 %0, %1, off sc0 sc1\n\ts_nop 1" :: "v"(rowp), "v"(w) : "memory"); }
        }
    }
};

struct PanelSumSq {
    unsigned* xbuf;
    unsigned* cnt;
    unsigned* tmo;
    float eps; unsigned code;
    __device__ __forceinline__ bool run(const f32x4 (&v)[2][2][4][2], const Unit& u, int wr, int wc, int fr, int fq, PG8_LAS unsigned char* lds, int wid, int lane) const {
        PG8_LAS float* P = (PG8_LAS float*)lds;
        PG8_LAS float* S = (PG8_LAS float*)(lds + 8192);
        PG8_LAS unsigned* flag = (PG8_LAS unsigned*)(lds + 8192 + 2048);
#pragma unroll
        for (int ai = 0; ai < 2; ++ai)
#pragma unroll
            for (int m = 0; m < 4; ++m) {
                float q = 0.f;
#pragma unroll
                for (int bj = 0; bj < 2; ++bj)
#pragma unroll
                    for (int n = 0; n < 2; ++n) { const f32x4 d = v[ai][bj][m][n]; q += (d[0] * d[0] + d[1] * d[1]) + (d[2] * d[2] + d[3] * d[3]); }
                q += __shfl_xor(q, 16); q += __shfl_xor(q, 32);
                if (fq == 0) P[(ai * HALF + wr * 64 + m * 16 + fr) * 4 + wc] = q;
            }
        asm volatile("s_waitcnt lgkmcnt(0)" ::: "memory"); __builtin_amdgcn_s_barrier(); asm volatile("" ::: "memory");
        const int row = wid * 32 + (lane & 31);
        if (lane < 32) {
            const float q = (P[row * 4 + 0] + P[row * 4 + 1]) + (P[row * 4 + 2] + P[row * 4 + 3]);
            unsigned* slot = xbuf + ((size_t)(u.pm * BM + row) * 4 + u.pn);
            __hip_atomic_store(slot, __float_as_uint(q), __ATOMIC_RELAXED, __HIP_MEMORY_SCOPE_AGENT);
        }
        asm volatile("s_waitcnt vmcnt(0)" ::: "memory");
        if (lane == 0) __hip_atomic_fetch_add(cnt + 64 * u.pm, 1u, __ATOMIC_RELAXED, __HIP_MEMORY_SCOPE_AGENT);
        if (wid == 0) {
            bool dead = false; const unsigned long long t0 = __builtin_amdgcn_s_memrealtime(); const unsigned want = 8u * 4u;
            for (;;) {
                if ((unsigned)__builtin_amdgcn_readfirstlane(__hip_atomic_load(cnt + 64 * u.pm, __ATOMIC_RELAXED, __HIP_MEMORY_SCOPE_AGENT)) >= want) break;
                if (__builtin_amdgcn_s_memrealtime() - t0 > 2000000ull) {
                    if (lane == 0) { unsigned expect = 0u; __hip_atomic_compare_exchange_strong(tmo + 1, &expect, code | (unsigned)(u.pm & 0xff), __ATOMIC_RELAXED, __ATOMIC_RELAXED, __HIP_MEMORY_SCOPE_AGENT);
                                     __hip_atomic_store(tmo, 1u, __ATOMIC_RELAXED, __HIP_MEMORY_SCOPE_AGENT); }
                    dead = true; break; }
                __builtin_amdgcn_s_sleep(2);
            }
            __builtin_amdgcn_fence(__ATOMIC_ACQUIRE, "agent");
            if (lane == 0) flag[0] = dead ? 1u : 0u;
        }
        asm volatile("s_waitcnt vmcnt(0) lgkmcnt(0)" ::: "memory"); __builtin_amdgcn_s_barrier(); asm volatile("" ::: "memory");
        const bool bad = flag[0] != 0u;
        if (lane < 32) {
            const unsigned* slot = xbuf + (size_t)(u.pm * BM + row) * 4; float q = 0.f;
#pragma unroll
            for (int t = 0; t < 4; ++t) q += __uint_as_float(__hip_atomic_load(slot + t, __ATOMIC_RELAXED, __HIP_MEMORY_SCOPE_AGENT));
            S[row] = 1.0f / sqrtf(q * (1.0f / 1024.0f) + eps);
        }
        asm volatile("s_waitcnt lgkmcnt(0)" ::: "memory"); __builtin_amdgcn_s_barrier(); asm volatile("" ::: "memory");
        return bad;
    }
};
struct EpiNormRes {
    static constexpr bool PERM = false, AFTER_DRAIN = true;
    const float* base; float* out; int ldc; const float* gain; PanelSumSq st; unsigned poison;
    __device__ __forceinline__ void fused(f32x4 (&acc)[2][2][4][2], const Unit& u, int wr, int wc, int fr, int fq, PG8_LAS unsigned char* lds, int wid, int lane) const {
        const PG8_LAS float* S = (const PG8_LAS float*)(lds + 8192);
        const int col0 = u.pn * BM + wc * 32 + 4 * fq;
#pragma unroll
        for (int ai = 0; ai < 2; ++ai)
#pragma unroll
            for (int m = 0; m < 4; ++m) { const size_t off = (size_t)(u.pm * BM + ai * HALF + wr * 64 + m * 16 + fr) * ldc + col0;
#pragma unroll
                for (int bj = 0; bj < 2; ++bj)
#pragma unroll
                    for (int n = 0; n < 2; ++n) acc[ai][bj][m][n] += *(const f32x4*)(base + off + bj * HALF + n * 16);
                asm volatile("" : "+v"(acc[ai][0][m][0]), "+v"(acc[ai][0][m][1]), "+v"(acc[ai][1][m][0]), "+v"(acc[ai][1][m][1]));
                if (m & 1) asm volatile("" ::: "memory"); }
        const bool bad = st.run(acc, u, wr, wc, fr, fq, lds, wid, lane) || poison != 0u;
        const float qnan = __builtin_nanf("");
        f32x4 gv[2][2];
#pragma unroll
        for (int bj = 0; bj < 2; ++bj)
#pragma unroll
            for (int n = 0; n < 2; ++n) gv[bj][n] = *(const f32x4*)(gain + col0 + bj * HALF + n * 16);
#pragma unroll
        for (int ai = 0; ai < 2; ++ai)
#pragma unroll
            for (int m = 0; m < 4; ++m) { const int r = ai * HALF + wr * 64 + m * 16 + fr; const float sr = S[r]; const size_t off = (size_t)(u.pm * BM + r) * ldc + col0;
#pragma unroll
                for (int bj = 0; bj < 2; ++bj)
#pragma unroll
                    for (int n = 0; n < 2; ++n) { f32x4 o = acc[ai][bj][m][n] * sr * gv[bj][n];
                        if (bad) o = (f32x4){qnan, qnan, qnan, qnan}; *(f32x4*)(out + off + bj * HALF + n * 16) = o; } }
    }
};

template <class Epi, class Sched, bool ALIGN_EPI = false, bool SP2 = false>
__device__ __forceinline__ void gemm_phase(PG8_LAS unsigned char* lds, const Gemm g, const Sched& S, const Epi& E) {
    const int tid = threadIdx.x, wid = __builtin_amdgcn_readfirstlane(tid >> 6), lane = tid & 63, wr = wid >> 2, wc = wid & 3, fr = lane & 15, fq = lane >> 4;
    const int K = g.K, nt = K / BK;
    unsigned voffA[2], voffB[2];
#pragma unroll
    for (int i = 0; i < 2; ++i) { int R, C; stage_rc(tid * 16 + i * 8192, R, C); const int Rb = Epi::PERM ? ((R & ~31) + perm32(R & 31)) : R;
        voffA[i] = (unsigned)(R * K + C) * 2u; voffB[i] = (unsigned)(Rb * K + C) * 2u; }
    const size_t kstep = (size_t)(BK * 2);
    const size_t hstep = (size_t)HALF * K * 2;
    const size_t tstep = 2 * hstep;
    const unsigned ldsw = (unsigned)wid * 1024u;
    const int aoff = lds_byte(wr * 64 + fr, fq * 8), boff = lds_byte(wc * 32 + fr, fq * 8);
#define PG8_SA(b, h) (((b) * 2 + (h)) * HTB)
#define PG8_SB(b, h) ((4 + (b) * 2 + (h)) * HTB)
#define PG8_STAGE(bufoff, gbase, voff) do { _Pragma("unroll") for (int _i = 0; _i < 2; ++_i) \
        __builtin_amdgcn_global_load_lds((const unsigned*)((const char*)(gbase) + (voff)[_i]), (PG8_LAS unsigned*)(lds + (bufoff) + ldsw + _i * 8192), 16, 0, 0); } while (0)
#define PG8_LDA(dst, b, h) do { _Pragma("unroll") for (int m = 0; m < 4; ++m) _Pragma("unroll") for (int k = 0; k < 2; ++k) dst[m][k] = *(const PG8_LAS bf16x8*)(lds + PG8_SA(b, h) + aoff + m * 2048 + k * 1024); } while (0)
#define PG8_LDB(dst, b, h) do { _Pragma("unroll") for (int n = 0; n < 2; ++n) _Pragma("unroll") for (int k = 0; k < 2; ++k) dst[n][k] = *(const PG8_LAS bf16x8*)(lds + PG8_SB(b, h) + boff + n * 2048 + k * 1024); } while (0)
#define PG8_MMA(ai, bj, At, Bt) do { __builtin_amdgcn_s_setprio(1); _Pragma("unroll") for (int m = 0; m < 4; ++m) _Pragma("unroll") for (int n = 0; n < 2; ++n) _Pragma("unroll") for (int k = 0; k < 2; ++k) \
        acc[ai][bj][m][n] = __builtin_amdgcn_mfma_f32_16x16x32_bf16(Bt[n][k], At[m][k], acc[ai][bj][m][n], 0, 0, 0); __builtin_amdgcn_s_setprio(0); } while (0)
#define PG8_WAIT_V(n) asm volatile("s_waitcnt vmcnt(" #n ")" ::: "memory")
#define PG8_WAIT_L(n) asm volatile("s_waitcnt lgkmcnt(" #n ")" ::: "memory")
#define PG8_BAR __builtin_amdgcn_s_barrier()
#define PG8_SCHED __builtin_amdgcn_sched_barrier(0)
    Unit cur, nxt; int ui = 0;
    if (!S.next(0, cur)) return;
    f32x4 acc[2][2][4][2];
#pragma unroll
    for (int a = 0; a < 2; ++a)
#pragma unroll
        for (int b = 0; b < 2; ++b)
#pragma unroll
            for (int m = 0; m < 4; ++m)
#pragma unroll
                for (int n = 0; n < 2; ++n) acc[a][b][m][n] = (f32x4){0.f, 0.f, 0.f, 0.f};
    bf16x8 At[4][2], B0[2][2], B1[2][2];
    const char* cA = (const char*)g.A + (size_t)cur.pm * tstep; const char* cB = (const char*)g.Bt + (size_t)cur.pn * tstep;
    S.a_ready(cur);
    if constexpr (SP2) {
        PG8_STAGE(PG8_SB(0, 0), cB, voffB); PG8_STAGE(PG8_SB(0, 1), cB + hstep, voffB); PG8_STAGE(PG8_SA(0, 0), cA, voffA); PG8_STAGE(PG8_SA(0, 1), cA + hstep, voffA);
        if (wr == 1) PG8_BAR;
        PG8_WAIT_V(2); PG8_BAR;
        PG8_STAGE(PG8_SB(1, 0), cB + kstep, voffB); PG8_STAGE(PG8_SA(1, 0), cA + kstep, voffA); PG8_STAGE(PG8_SB(1, 1), cB + hstep + kstep, voffB);
        PG8_WAIT_V(6); PG8_BAR;
    } else {
        PG8_STAGE(PG8_SB(0, 0), cB, voffB); PG8_STAGE(PG8_SA(0, 0), cA, voffA); PG8_STAGE(PG8_SB(0, 1), cB + hstep, voffB); PG8_STAGE(PG8_SA(0, 1), cA + hstep, voffA);
        if (wr == 1) PG8_BAR;
        PG8_WAIT_V(4); PG8_BAR;
        PG8_STAGE(PG8_SB(1, 0), cB + kstep, voffB); PG8_STAGE(PG8_SA(1, 0), cA + kstep, voffA); PG8_STAGE(PG8_SB(1, 1), cB + hstep + kstep, voffB);
        PG8_WAIT_V(6); PG8_BAR;
    }
    for (;;) {
        const bool has_next = S.next(ui + 1, nxt);
        const char* nA = has_next ? (const char*)g.A + (size_t)nxt.pm * tstep : cA; const char* nB = has_next ? (const char*)g.Bt + (size_t)nxt.pn * tstep : cB;
        for (int t = 0; t < nt; t += 2) {
            const bool last = (t == nt - 2);
            const char* a1 = cA + (size_t)(t + 1) * kstep;
            const char* a2 = last ? nA : cA + (size_t)(t + 2) * kstep; const char* b2 = last ? nB : cB + (size_t)(t + 2) * kstep;
            const char* a3 = a2 + kstep; const char* b3 = b2 + kstep;
            if (last && has_next) S.a_ready(nxt);
            if constexpr (SP2) {
            PG8_LDB(B0, 0, 0); PG8_LDB(B1, 0, 1); PG8_SCHED; PG8_LDA(At, 0, 0); PG8_STAGE(PG8_SA(1, 1), a1 + hstep, voffA);
            PG8_WAIT_V(8); PG8_WAIT_L(0); PG8_BAR; PG8_MMA(0, 0, At, B0); PG8_MMA(0, 1, At, B1); PG8_BAR; PG8_SCHED;
            PG8_LDA(At, 0, 1); PG8_STAGE(PG8_SB(0, 0), b2, voffB); PG8_STAGE(PG8_SB(0, 1), b2 + hstep, voffB); PG8_STAGE(PG8_SA(0, 0), a2, voffA);
            PG8_WAIT_V(8); PG8_WAIT_L(0); PG8_BAR; PG8_MMA(1, 0, At, B0); PG8_MMA(1, 1, At, B1); PG8_BAR; PG8_SCHED;
            PG8_LDB(B0, 1, 0); PG8_LDB(B1, 1, 1); PG8_SCHED; PG8_LDA(At, 1, 0); PG8_STAGE(PG8_SA(0, 1), a2 + hstep, voffA);
            PG8_WAIT_V(8); PG8_WAIT_L(0); PG8_BAR; PG8_MMA(0, 0, At, B0); PG8_MMA(0, 1, At, B1); PG8_BAR; PG8_SCHED;
            PG8_LDA(At, 1, 1); PG8_STAGE(PG8_SB(1, 0), b3, voffB); PG8_STAGE(PG8_SB(1, 1), b3 + hstep, voffB); PG8_STAGE(PG8_SA(1, 0), a3, voffA);
            PG8_WAIT_V(8); PG8_WAIT_L(0); PG8_BAR; PG8_MMA(1, 0, At, B0); PG8_MMA(1, 1, At, B1); PG8_BAR; PG8_SCHED;
            } else {
            PG8_LDB(B0, 0, 0); PG8_SCHED; PG8_LDA(At, 0, 0); PG8_STAGE(PG8_SA(1, 1), a1 + hstep, voffA);
            PG8_WAIT_L(8); PG8_BAR; PG8_WAIT_L(0); PG8_MMA(0, 0, At, B0); PG8_BAR; PG8_SCHED;
            PG8_LDB(B1, 0, 1); PG8_STAGE(PG8_SB(0, 0), b2, voffB);
            PG8_BAR; PG8_WAIT_L(0); PG8_MMA(0, 1, At, B1); PG8_BAR;
            PG8_LDA(At, 0, 1); PG8_STAGE(PG8_SA(0, 0), a2, voffA);
            PG8_BAR; PG8_WAIT_L(0); PG8_MMA(1, 0, At, B0); PG8_BAR; PG8_SCHED;
            PG8_STAGE(PG8_SB(0, 1), b2 + hstep, voffB);
            PG8_WAIT_V(6); PG8_BAR; PG8_MMA(1, 1, At, B1); PG8_BAR;
            PG8_LDB(B0, 1, 0); PG8_SCHED; PG8_LDA(At, 1, 0); PG8_STAGE(PG8_SA(0, 1), a2 + hstep, voffA);
            PG8_WAIT_L(8); PG8_BAR; PG8_WAIT_L(0); PG8_MMA(0, 0, At, B0); PG8_BAR; PG8_SCHED;
            PG8_LDB(B1, 1, 1); PG8_STAGE(PG8_SB(1, 0), b3, voffB);
            PG8_BAR; PG8_WAIT_L(0); PG8_MMA(0, 1, At, B1); PG8_BAR;
            PG8_LDA(At, 1, 1); PG8_STAGE(PG8_SA(1, 0), a3, voffA);
            PG8_BAR; PG8_WAIT_L(0); PG8_MMA(1, 0, At, B0); PG8_BAR; PG8_SCHED;
            PG8_STAGE(PG8_SB(1, 1), b3 + hstep, voffB);
            PG8_WAIT_V(6); PG8_BAR; PG8_MMA(1, 1, At, B1); PG8_BAR;
            }
        }
        if constexpr (ALIGN_EPI) { if (wr == 0) PG8_BAR; }
        if constexpr (!Epi::AFTER_DRAIN) { E(acc, cur, wr, wc, fr, fq); S.done(cur); }
        if (!has_next) break;
#pragma unroll
        for (int a = 0; a < 2; ++a)
#pragma unroll
            for (int b = 0; b < 2; ++b)
#pragma unroll
                for (int m = 0; m < 4; ++m)
#pragma unroll
                    for (int n = 0; n < 2; ++n) acc[a][b][m][n] = (f32x4){0.f, 0.f, 0.f, 0.f};
        cur = nxt; cA = nA; cB = nB; ++ui;
        if constexpr (ALIGN_EPI) { if (wr == 1) PG8_BAR; }
    }
    PG8_WAIT_V(0);
    if constexpr (!ALIGN_EPI) { if (wr == 0) PG8_BAR; }
    PG8_BAR;
    if constexpr (Epi::AFTER_DRAIN) { E.fused(acc, cur, wr, wc, fr, fq, lds, wid, lane); S.done(cur); }
#undef PG8_SA
#undef PG8_SB
#undef PG8_STAGE
#undef PG8_LDA
#undef PG8_LDB
#undef PG8_MMA
#undef PG8_WAIT_V
#undef PG8_WAIT_L
#undef PG8_BAR
#undef PG8_SCHED
}
}

#include <hip/hip_bf16.h>
#include <cmath>
namespace attn_body {
using bf16=__hip_bfloat16;
using bf16x8=__attribute__((ext_vector_type(8)))short;
using s16x4=__attribute__((ext_vector_type(4)))short;
using f32x16=__attribute__((ext_vector_type(16)))float;
using u32x4=__attribute__((ext_vector_type(4)))unsigned;
using f32x4_t=__attribute__((ext_vector_type(4)))float;
constexpr int D=64;
constexpr int NW=8,QBLK=32,QB=QBLK*NW,KVBLK=64;
constexpr int ATTN_UNIT_ROWS=QB;
__device__ __forceinline__ int crow(int r,int hi){return (r&3)+8*(r>>2)+4*hi;}
#define SBAR() __builtin_amdgcn_sched_barrier(0)
__device__ __forceinline__ void cmask(f32x16&p0,f32x16&p1,int jb,int qrel,int hi){
  const float NEG=-INFINITY; int kb=64*jb+4*hi;
  #pragma unroll
  for(int r=0;r<16;++r){int kv=kb+(r&3)+8*(r>>2); if(kv>qrel)p0[r]=NEG; if(kv+32>qrel)p1[r]=NEG;}
}

constexpr int NSLOT=3, SLOTB=8192;
constexpr int LDS_K=0, LDS_V=NSLOT*SLOTB, LDS_WS=2*NSLOT*SLOTB, LDS_OST=LDS_WS+NW*64*4, LDS_BIAS=LDS_OST+NW*4096, MAXKEYS=16384, LDS_BYTES=LDS_BIAS+MAXKEYS*4;
constexpr float C2=0.125f*1.4426950408889634f;
__device__ __forceinline__ void glds16(const void*gsrc,unsigned lds_dst){unsigned keep;
  asm volatile("s_mov_b32 %0, m0\n\ts_mov_b32 m0, %2\n\ts_nop 0\n\tglobal_load_lds_dwordx4 %1, off\n\ts_mov_b32 m0, %0":"=&s"(keep):"v"(gsrc),"s"(lds_dst):"memory");}
__device__ __forceinline__ float max3f(float a,float b,float c){float r;asm("v_max3_f32 %0, %1, %2, %3":"=v"(r):"v"(a),"v"(b),"v"(c));return r;}
__device__ __forceinline__ float max2f(float a,float b){float r;asm("v_max_f32_e32 %0, %1, %2":"=v"(r):"v"(a),"v"(b));return r;}
__device__ __forceinline__ float fadd_s(float a,float b){float r;asm("v_add_f32_e32 %0, %1, %2":"=v"(r):"v"(a),"v"(b));return r;}
__device__ __forceinline__ float fsub_s(float a,float b){float r;asm("v_sub_f32_e32 %0, %1, %2":"=v"(r):"v"(a),"v"(b));return r;}
typedef float f32x2_t __attribute__((ext_vector_type(2))); typedef __bf16 bf16x2_t __attribute__((ext_vector_type(2)));
__device__ __forceinline__ unsigned cvtpk_s(float lo,float hi){f32x2_t v={lo,hi};bf16x2_t b=__builtin_convertvector(v,bf16x2_t);return __builtin_bit_cast(unsigned,b);}
#define WAIT_BAR(N) asm volatile("s_waitcnt vmcnt(" #N ") lgkmcnt(0)\n\ts_barrier":::"memory")

__device__ __forceinline__ void qkt(f32x16&p0,f32x16&p1,const char*Kslot,const bf16x8*qr,const f32x16&negm,int r32,int hi){
  const char*kb=Kslot+hi*1024+r32*16;
  #pragma unroll
  for(int d0=0;d0<4;++d0){
    const bf16x8 b0=*reinterpret_cast<const bf16x8*>(kb+d0*2048);
    const bf16x8 b1=*reinterpret_cast<const bf16x8*>(kb+d0*2048+512);
    if(d0==0){p0=__builtin_amdgcn_mfma_f32_32x32x16_bf16(b0,qr[0],negm,0,0,0);p1=__builtin_amdgcn_mfma_f32_32x32x16_bf16(b1,qr[0],negm,0,0,0);}
    else{p0=__builtin_amdgcn_mfma_f32_32x32x16_bf16(b0,qr[d0],p0,0,0,0);p1=__builtin_amdgcn_mfma_f32_32x32x16_bf16(b1,qr[d0],p1,0,0,0);}}
}
typedef __attribute__((address_space(3))) const char* lds_cptr;
typedef short v4i16_t __attribute__((ext_vector_type(4)));
__device__ __forceinline__ void kload8(bf16x8*kf,lds_cptr kp){
  kf[0]=*(const __attribute__((address_space(3))) bf16x8*)(kp);      kf[1]=*(const __attribute__((address_space(3))) bf16x8*)(kp+512);
  kf[2]=*(const __attribute__((address_space(3))) bf16x8*)(kp+2048); kf[3]=*(const __attribute__((address_space(3))) bf16x8*)(kp+2560);
  kf[4]=*(const __attribute__((address_space(3))) bf16x8*)(kp+4096); kf[5]=*(const __attribute__((address_space(3))) bf16x8*)(kp+4608);
  kf[6]=*(const __attribute__((address_space(3))) bf16x8*)(kp+6144); kf[7]=*(const __attribute__((address_space(3))) bf16x8*)(kp+6656);
}
__device__ __forceinline__ void kload2(bf16x8*kf,lds_cptr kp,int j){ kf[2*j]=*(const __attribute__((address_space(3))) bf16x8*)(kp+j*2048); kf[2*j+1]=*(const __attribute__((address_space(3))) bf16x8*)(kp+j*2048+512); }
__device__ __forceinline__ s16x4 vtr(lds_cptr p){ return __builtin_bit_cast(s16x4,__builtin_amdgcn_ds_read_tr16_b64_v4i16((__attribute__((address_space(3))) v4i16_t*)p)); }
__device__ __forceinline__ float rowmax(const f32x16&p0,const f32x16&p1){
  float a=max3f(p0[0],p0[1],p1[0]),b=max3f(p0[2],p0[3],p1[1]);a=max3f(a,p1[2],p1[3]);
  #pragma unroll
  for(int r=4;r<16;r+=4){a=max3f(a,p0[r],p0[r+1]);b=max3f(b,p0[r+2],p0[r+3]);a=max3f(a,p1[r],p1[r+1]);b=max3f(b,p1[r+2],p1[r+3]);}
  const float m=max2f(a,b);
  auto rr=__builtin_amdgcn_permlane32_swap(__float_as_uint(m),__float_as_uint(m),false,false);
  return max2f(__uint_as_float(rr[0]),__uint_as_float(rr[1]));
}
__device__ __forceinline__ void pv(f32x16*o,int vb,bf16x8 pa0,bf16x8 pa1,bf16x8 pa2,bf16x8 pa3){
  #pragma unroll
  for(int d0=0;d0<2;++d0){s16x4 lo[4],hi[4];
    #pragma unroll
    for(int ks=0;ks<4;++ks){
      asm volatile("ds_read_b64_tr_b16 %0,%1 offset:%c2":"=&v"(lo[ks]):"v"(vb),"i"(d0*4096+ks*1024):"memory");
      asm volatile("ds_read_b64_tr_b16 %0,%1 offset:%c2":"=&v"(hi[ks]):"v"(vb),"i"(d0*4096+ks*1024+512):"memory");}
    asm volatile("s_waitcnt lgkmcnt(0)":::"memory");SBAR();
    #define PK(k) (bf16x8){lo[k][0],lo[k][1],lo[k][2],lo[k][3],hi[k][0],hi[k][1],hi[k][2],hi[k][3]}
    o[d0]=__builtin_amdgcn_mfma_f32_32x32x16_bf16(pa0,PK(0),o[d0],0,0,0);
    o[d0]=__builtin_amdgcn_mfma_f32_32x32x16_bf16(pa1,PK(1),o[d0],0,0,0);
    o[d0]=__builtin_amdgcn_mfma_f32_32x32x16_bf16(pa2,PK(2),o[d0],0,0,0);
    o[d0]=__builtin_amdgcn_mfma_f32_32x32x16_bf16(pa3,PK(3),o[d0],0,0,0);
    #undef PK
  }
}

#ifndef ATTN_STORE16
#define ATTN_STORE16(p,v) (*(u32x4*)(p)=(v))
#endif
template<int THRL,int PO,bool MASK,bool BIAS> __device__ __forceinline__ void attn_unit(int q0,int NT,int qoff,int PQ,int PKV,int PG,const bf16*Qh,const bf16*__restrict__ Kh,const bf16*__restrict__ Vh,const bf16*__restrict__ Gh,bf16*Oh,const float*__restrict__ cfl,const __attribute__((address_space(3))) float* offp,float cref,char*shm){
  int tid=threadIdx.x; asm volatile("":"+v"(tid)); const int lane=tid&63,r32=lane&31,hi=lane>>5; const int wid=__builtin_amdgcn_readfirstlane(tid>>6);
  const bf16*Qw=Qh+(long)(q0+wid*QBLK)*PQ;
  const unsigned lds0=(unsigned)(uintptr_t)shm;
  float*wsf=(float*)(shm+LDS_WS)+wid*64;
  const bf16*ksrc=Kh+(long)lane*PKV+wid*8;
  const bf16*vsrc=Vh+(long)(16*(wid&3)+(lane>>2))*PKV+(wid>>2)*32+(lane&3)*8;
  const unsigned kdst=lds0+LDS_K+wid*1024, vdst=lds0+LDS_V+wid*1024;
  #define DMA_K(t,slot) glds16(ksrc+(long)(t)*KVBLK*PKV,(unsigned)__builtin_amdgcn_readfirstlane(kdst+(slot)))
  #define DMA_V(t,slot) glds16(vsrc+(long)(t)*KVBLK*PKV,(unsigned)__builtin_amdgcn_readfirstlane(vdst+(slot)))
  const int vb0=(int)(lds0+LDS_V)+((lane>>4)&1)*32+(lane&3)*8+(4*hi+((lane&15)>>2))*64;
  const char*Kbase=shm+LDS_K; bf16x8 kf[8];
  const lds_cptr shm3=(lds_cptr)shm; const lds_cptr kp0=shm3+LDS_K+hi*1024+r32*16; const lds_cptr vp0=shm3+LDS_V+((lane>>4)&1)*32+(lane&3)*8+(4*hi+((lane&15)>>2))*64;
  typedef __attribute__((address_space(3))) const f32x4_t* lds_f4p; const lds_f4p biasp=(lds_f4p)(shm3+LDS_BIAS+16*hi);
  if(BIAS){ __attribute__((address_space(3))) float* bw=(__attribute__((address_space(3))) float*)(shm3+LDS_BIAS); for(int i=tid;i<NT*KVBLK;i+=NW*64) bw[i]=cref-(cfl[i]+offp[i>>6]); }
  DMA_K(0,0);DMA_V(0,0);DMA_K(1,SLOTB);
  bf16x8 qr[4];
  #pragma unroll
  for(int d0=0;d0<4;++d0)qr[d0]=*reinterpret_cast<const bf16x8*>(&Qw[(long)r32*PQ+d0*16+hi*8]);
  float mhat=0.f,l_reg=0.f;f32x16 o[2];o[0]=f32x16{};o[1]=f32x16{};const f32x16 zero16=f32x16{};
  const int qrel=wid*QBLK+r32+qoff;
  #define CMASK(P0,P1,t) do{ if(MASK){int jb_=(t)-(NT-4); if(jb_>=0)cmask(P0,P1,jb_,qrel,hi);} }while(0)
  #define ADDB(P0,P1,t) do{ if(BIAS){ _Pragma("unroll") for(int g_=0;g_<4;++g_){ const f32x4_t b0_=biasp[(t)*16+2*g_], b1_=biasp[(t)*16+8+2*g_]; \
      P0[4*g_]+=b0_[0];P0[4*g_+1]+=b0_[1];P0[4*g_+2]+=b0_[2];P0[4*g_+3]+=b0_[3]; P1[4*g_]+=b1_[0];P1[4*g_+1]+=b1_[1];P1[4*g_+2]+=b1_[2];P1[4*g_+3]+=b1_[3]; SBAR(); } } }while(0)
  bool resc=false;
  #define START(P0,P1) do{ const float rm=rowmax(P0,P1); resc=false; \
    { const float dl=rm; mhat=fadd_s(mhat,dl); \
      _Pragma("unroll") for(int r=0;r<16;++r){P0[r]=fsub_s(P0[r],dl);P1[r]=fsub_s(P1[r],dl);} } \
    _Pragma("unroll") for(int r=0;r<16;++r)P0[r]=__builtin_amdgcn_exp2f(P0[r]); }while(0)
  #define RESC() do{ if(resc){ asm volatile("s_waitcnt lgkmcnt(0)":::"memory"); \
      _Pragma("unroll") for(int d_=0;d_<2;++d_) _Pragma("unroll") for(int r=0;r<16;++r)o[d_][r]*=wsf[crow(r,hi)]; } }while(0)
  f32x16 pA0,pA1,pB0,pB1;
  int sl_prev=0,sl_cur=0,sl_next=SLOTB;
  #define ROT() do{sl_prev=sl_cur;sl_cur=sl_next;sl_next=(sl_next==(NSLOT-1)*SLOTB)?0:sl_next+SLOTB;}while(0)
  DMA_K(2,2*SLOTB);
  WAIT_BAR(3);
  qkt(pA0,pA1,Kbase,qr,zero16,r32,hi);asm volatile("s_nop 15\n\ts_nop 7":"+v"(pA0),"+v"(pA1));CMASK(pA0,pA1,0);ADDB(pA0,pA1,0);
  START(pA0,pA1);
  _Pragma("unroll") for(int r=0;r<16;++r)pA1[r]=__builtin_amdgcn_exp2f(pA1[r]);
  WAIT_BAR(0);
  DMA_K(3,0);DMA_V(1,SLOTB);
  ROT();
  kload8(kf,kp0+sl_cur);
  WAIT_BAR(2);
  s16x4 vlo[8],vhi[8]; u32x4 pw0,pw1,pw2,pw3;
  #define PKW(P,B) cvtpk_s(P[B],P[B+1])
  #define PAF(k) __builtin_bit_cast(bf16x8,pw##k)
  #define VFR(i) (bf16x8){vlo[i][0],vlo[i][1],vlo[i][2],vlo[i][3],vhi[i][0],vhi[i][1],vhi[i][2],vhi[i][3]}
  #define PIN(x) asm volatile("":"+v"(x))
  #define MX3(a,b,c) __builtin_fmaxf(__builtin_fmaxf((a),(b)),(c))
  #define GAPA(MF,A0,A1,A2,A3,W0,W1,PW) do{ MF; sacc+=A0; sacc+=A1; sacc+=A2; sacc+=A3; PIN(sacc); W0; W1; PIN(PW); SBAR(); }while(0)
  #define EX(v) __builtin_amdgcn_exp2f(v)
  #define GAPB(MF,X,B) do{ MF; X[B]=EX(X[B]); X[B+1]=EX(X[B+1]); X[B+2]=EX(X[B+2]); X[B+3]=EX(X[B+3]); PIN(X); SBAR(); }while(0)
  #define VRD(i) do{ vlo[i]=vtr(vp_+(((i)>>2)*4096+((i)&3)*1024)); vhi[i]=vtr(vp_+(((i)>>2)*4096+((i)&3)*1024+512)); }while(0)
  #define KRD(G,j) do{ if(G){ kload2(kf,kp0+sl_next,j); SBAR(); } }while(0)
  #define STEP(C0,C1,P0,P1,t,GK,GV,GL) do{ SBAR(); \
    const lds_cptr vp_=vp0+sl_prev; \
    VRD(0); SBAR(); float sacc=(P0[0]+P0[1]); \
    GAPA(C0=__builtin_amdgcn_mfma_f32_32x32x16_bf16(kf[0],qr[0],zero16,0,0,0), P0[2],P0[3],P0[4],P0[5],     pw0[0]=PKW(P0,0), pw0[1]=PKW(P0,2), pw0); \
    VRD(4); SBAR(); GAPA(C1=__builtin_amdgcn_mfma_f32_32x32x16_bf16(kf[1],qr[0],zero16,0,0,0), P0[6],P0[7],P0[8],P0[9],     pw0[2]=PKW(P0,4), pw0[3]=PKW(P0,6), pw0); \
    VRD(1); SBAR(); GAPA(C0=__builtin_amdgcn_mfma_f32_32x32x16_bf16(kf[2],qr[1],C0,0,0,0),   P0[10],P0[11],P0[12],P0[13], pw1[0]=PKW(P0,8), pw1[1]=PKW(P0,10), pw1); \
    VRD(5); SBAR(); GAPA(C1=__builtin_amdgcn_mfma_f32_32x32x16_bf16(kf[3],qr[1],C1,0,0,0),   P0[14],P0[15],P1[0],P1[1],   pw1[2]=PKW(P0,12),pw1[3]=PKW(P0,14), pw1); \
    VRD(2); SBAR(); GAPA(C0=__builtin_amdgcn_mfma_f32_32x32x16_bf16(kf[4],qr[2],C0,0,0,0),   P1[2],P1[3],P1[4],P1[5],     pw2[0]=PKW(P1,0), pw2[1]=PKW(P1,2), pw2); \
    VRD(6); SBAR(); GAPA(C1=__builtin_amdgcn_mfma_f32_32x32x16_bf16(kf[5],qr[2],C1,0,0,0),   P1[6],P1[7],P1[8],P1[9],     pw2[2]=PKW(P1,4), pw2[3]=PKW(P1,6), pw2); \
    VRD(3); SBAR(); GAPA(C0=__builtin_amdgcn_mfma_f32_32x32x16_bf16(kf[6],qr[3],C0,0,0,0),   P1[10],P1[11],P1[12],P1[13], pw3[0]=PKW(P1,8), pw3[1]=PKW(P1,10), pw3); \
    VRD(7); SBAR(); GAPA(C1=__builtin_amdgcn_mfma_f32_32x32x16_bf16(kf[7],qr[3],C1,0,0,0),   P1[14],P1[15],0.f,0.f,       pw3[2]=PKW(P1,12),pw3[3]=PKW(P1,14), pw3); \
    l_reg+=sacc; \
    if(GK){DMA_K((t)+3,sl_cur);} if(GV){DMA_V((t)+1,sl_next);} \
    CMASK(C0,C1,t); ADDB(C0,C1,t); \
    { float a=MX3(C0[0],C0[1],C1[0]),b=MX3(C0[2],C0[3],C1[1]); a=MX3(a,C1[2],C1[3]); \
      _Pragma("unroll") for(int r=4;r<16;r+=4){a=MX3(a,C0[r],C0[r+1]);b=MX3(b,C0[r+2],C0[r+3]);a=MX3(a,C1[r],C1[r+1]);b=MX3(b,C1[r+2],C1[r+3]);} \
      float rm=__builtin_fmaxf(a,b); { auto rr=__builtin_amdgcn_permlane32_swap(__float_as_uint(rm),__float_as_uint(rm),false,false); rm=__builtin_fmaxf(__uint_as_float(rr[0]),__uint_as_float(rr[1])); } \
      resc=false; rm-=mhat; \
      if(__builtin_expect(__any(rm>(float)THRL),0)){ const float dl=__builtin_fmaxf(rm,0.f); mhat+=dl; \
        const float f=__builtin_amdgcn_exp2f(-dl); l_reg*=f; if(hi==0)wsf[r32]=f; resc=true; } \
      _Pragma("unroll") for(int r=0;r<16;++r){C0[r]-=mhat;C1[r]-=mhat;} } \
    SBAR(); \
    GAPB(o[0]=__builtin_amdgcn_mfma_f32_32x32x16_bf16(PAF(0),VFR(0),o[0],0,0,0), C0,0); \
    GAPB(o[1]=__builtin_amdgcn_mfma_f32_32x32x16_bf16(PAF(0),VFR(4),o[1],0,0,0), C0,4); \
    KRD(GL,0); GAPB(o[0]=__builtin_amdgcn_mfma_f32_32x32x16_bf16(PAF(1),VFR(1),o[0],0,0,0), C0,8); \
    KRD(GL,1); GAPB(o[1]=__builtin_amdgcn_mfma_f32_32x32x16_bf16(PAF(1),VFR(5),o[1],0,0,0), C0,12); \
    KRD(GL,2); GAPB(o[0]=__builtin_amdgcn_mfma_f32_32x32x16_bf16(PAF(2),VFR(2),o[0],0,0,0), C1,0); \
    KRD(GL,3); GAPB(o[1]=__builtin_amdgcn_mfma_f32_32x32x16_bf16(PAF(2),VFR(6),o[1],0,0,0), C1,4); \
    GAPB(o[0]=__builtin_amdgcn_mfma_f32_32x32x16_bf16(PAF(3),VFR(3),o[0],0,0,0), C1,8); \
    GAPB(o[1]=__builtin_amdgcn_mfma_f32_32x32x16_bf16(PAF(3),VFR(7),o[1],0,0,0), C1,12); \
    }while(0)
  int t=1;
  #undef CMASK
  #define CMASK(P0,P1,t) do{}while(0)
  for(;t+5<NT;t+=2){
    STEP(pB0,pB1,pA0,pA1,t,true,true,true);     WAIT_BAR(2); RESC(); ROT();
    STEP(pA0,pA1,pB0,pB1,t+1,true,true,true);   WAIT_BAR(2); RESC(); ROT();
  }
  #undef CMASK
  #define CMASK(P0,P1,t) do{ if(MASK){int jb_=(t)-(NT-4); if(jb_>=0)cmask(P0,P1,jb_,qrel,hi);} }while(0)
  #define ENDW(tt) do{ if((tt)+3<NT){WAIT_BAR(2);} else if((tt)+2<NT){WAIT_BAR(1);} else {WAIT_BAR(0);} }while(0)
  for(;t+1<NT;t+=2){
    STEP(pB0,pB1,pA0,pA1,t,(t+3<NT),(t+1<NT),(t+1<NT));       ENDW(t);   RESC(); ROT();
    STEP(pA0,pA1,pB0,pB1,t+1,(t+4<NT),(t+2<NT),(t+2<NT));     ENDW(t+1); RESC(); ROT();
  }
  STEP(pB0,pB1,pA0,pA1,NT-1,false,false,false); RESC();
  { float sacc=pB0[0]+pB0[1]; _Pragma("unroll") for(int r=2;r<16;++r)sacc+=pB0[r]; _Pragma("unroll") for(int r=0;r<16;++r)sacc+=pB1[r]; l_reg+=sacc;
    pw0=(u32x4){PKW(pB0,0),PKW(pB0,2),PKW(pB0,4),PKW(pB0,6)};pw1=(u32x4){PKW(pB0,8),PKW(pB0,10),PKW(pB0,12),PKW(pB0,14)};pw2=(u32x4){PKW(pB1,0),PKW(pB1,2),PKW(pB1,4),PKW(pB1,6)};pw3=(u32x4){PKW(pB1,8),PKW(pB1,10),PKW(pB1,12),PKW(pB1,14)};
    SBAR(); pv(o,vb0+sl_cur,PAF(0),PAF(1),PAF(2),PAF(3)); }
  #undef PKW
  #undef PAF
  #undef VFR
  #undef PIN
  #undef MX3
  #undef GAPA
  #undef GAPB
  #undef EX
  #undef VRD
  #undef KRD
  #undef STEP
  #undef ENDW
  {auto rr=__builtin_amdgcn_permlane32_swap(__float_as_uint(l_reg),__float_as_uint(l_reg),false,false);l_reg=__uint_as_float(rr[0])+__uint_as_float(rr[1]);}
  if(hi==0)wsf[32+r32]=l_reg;asm volatile("s_waitcnt lgkmcnt(0)":::"memory");
  float rli[16];
  #pragma unroll
  for(int r=0;r<16;++r)rli[r]=__builtin_amdgcn_rcpf(wsf[32+crow(r,hi)]);
  bf16*Ow=Oh+(long)(q0+wid*QBLK)*PO; const bf16*Gw=Gh+(long)(q0+wid*QBLK)*PG;
  u32x4 gt[4];
  #pragma unroll
  for(int i=0;i<4;++i)gt[i]=*(const u32x4*)(Gw+(long)(i*8+(lane>>3))*PG+(lane&7)*8);
  { bf16*stg=(bf16*)(shm+LDS_OST)+wid*2048;
    #pragma unroll
    for(int r=0;r<16;++r){const int orow=crow(r,hi);
      #pragma unroll
      for(int d0=0;d0<2;++d0)stg[orow*64+d0*32+r32]=__float2bfloat16(o[d0][r]*rli[r]);}
    asm volatile("s_waitcnt lgkmcnt(0)":::"memory");
    #pragma unroll
    for(int i=0;i<4;++i){const int row=i*8+(lane>>3),ch=lane&7; const u32x4 v=*(const u32x4*)(stg+row*64+ch*8); u32x4 w;
      #pragma unroll
      for(int e=0;e<4;++e){ const float a0=__uint_as_float(v[e]<<16)*__uint_as_float(gt[i][e]<<16), a1=__uint_as_float(v[e]&0xffff0000u)*__uint_as_float(gt[i][e]&0xffff0000u); w[e]=cvtpk_s(a0,a1); }
      ATTN_STORE16(Ow+(long)row*PO+ch*8,w);} }
  asm volatile("s_waitcnt lgkmcnt(0)\n\ts_barrier":::"memory");
  #undef DMA_K
  #undef DMA_V
  #undef CMASK
  #undef START
  #undef RESC
  #undef ADDB
  #undef ROT
}
constexpr int ATTN_LDS_BYTES=LDS_BYTES;
#undef SBAR
#undef WAIT_BAR
}

constexpr int NWAVES = 8;
#ifndef MK_N_LAUNCHES
#define MK_N_LAUNCHES 1
#endif
#ifndef PROBE_DUP
#define PROBE_DUP -1
#endif
#define NREP(k) ((PROBE_DUP == (k)) ? 2 : 1)
constexpr int PER_PHASE = 5;
constexpr int N_LAUNCHES = MK_N_LAUNCHES;

constexpr int M = 16384, D = 1024;
constexpr int IN_COLS = 3222, NP = 3072;
constexpr int MEM_LEN = 256;
constexpr float EPS = 1e-6f;
constexpr float LOG2E = 1.4426950408889634f;
constexpr size_t MiB = 1u << 20;
constexpr size_t WS_CTL = 0, CTL_ZERO_BYTES = 1 * MiB;
constexpr size_t WS_ZERO = 512 * 1024;
constexpr size_t WS_WIN = 2 * MiB;
constexpr size_t WS_WOUTF = 9 * MiB;
constexpr size_t WS_WSF = 11 * MiB;
constexpr size_t WS_MK = 12 * MiB + 512 * 1024, WS_MV = WS_MK + 128 * 1024;
constexpr size_t WS_X = 13 * MiB;
constexpr size_t WS_XN = 16 * MiB;
constexpr size_t WS_FQ = 48 * MiB, WS_FK = 60 * MiB, WS_FV = 72 * MiB, WS_FG = 84 * MiB;
constexpr size_t WS_MQ = 96 * MiB, WS_MG = 104 * MiB;
constexpr size_t WS_GQ = 112 * MiB, WS_GK = 118 * MiB;
constexpr size_t WS_GV = 124 * MiB, WS_GG = 136 * MiB;
constexpr size_t WS_GLR = 148 * MiB;
constexpr size_t WS_FFG = 149 * MiB;
constexpr size_t WS_CFL = 149 * MiB + 512 * 1024;
constexpr size_t WS_TOT = 149 * MiB + 512 * 1024 + 6 * 16384 * 4;
constexpr size_t WS_KVT = 150 * MiB;
constexpr size_t WS_DEC = 168 * MiB;
constexpr size_t WS_ST = 169 * MiB;
constexpr size_t WS_MIX = 192 * MiB;
constexpr size_t WS_GB = 224 * MiB;
constexpr size_t WS_END = 240 * MiB;
static_assert(WS_GLR + (size_t)M * 16 * 4 == WS_FFG, "g_lr | f_fg adjacency (EpiRoute mode 3)");
constexpr int CW_TMO = 0, CW_CODE = 1;
constexpr int CW_Q3 = 64;
constexpr int CW_NMAX = 128;
constexpr float ACP_THRESH = 50.f;
constexpr int CW_BAR = 4096;
constexpr int CW_SEAM = 16384;
static_assert((CW_SEAM + 2 * 64 * 64) * 4 <= (int)CTL_ZERO_BYTES, "CTL words inside the memset region");
constexpr int RING_OFF = 0, RING_BYTES = 151552;
constexpr int LDSCTL_OFF = RING_BYTES, MISC_OFF = LDSCTL_OFF + 320;
constexpr int OFFT_OFF = 153600, OFFT_ROW = 257;
constexpr int LDS_BYTES = 153600 + 8 * 1024;
static_assert(MISC_OFF + 128 <= OFFT_OFF && LDS_BYTES <= 163840 && attn_body::ATTN_LDS_BYTES <= RING_BYTES && pg8::STAGE_BYTES <= RING_BYTES, "LDS map");

#define GAS __attribute__((address_space(1)))
#define LAS __attribute__((address_space(3)))
typedef unsigned short bf16;
typedef unsigned v4u __attribute__((ext_vector_type(4)));
typedef float f32x4 __attribute__((ext_vector_type(4)));
typedef short bf16x8 __attribute__((ext_vector_type(8)));
typedef GAS unsigned gu32;
typedef GAS unsigned long long gu64;
#define RLX_AGENT __ATOMIC_RELAXED, __HIP_MEMORY_SCOPE_AGENT
#define LDS_WAIT() asm volatile("s_waitcnt lgkmcnt(0)" ::: "memory")
#define VM_WAIT() asm volatile("s_waitcnt vmcnt(0)" ::: "memory")
__device__ __forceinline__ unsigned long long rt() { return __builtin_amdgcn_s_memrealtime(); }
__device__ __forceinline__ unsigned f2bf(float f) { unsigned u = __builtin_bit_cast(unsigned, f); return (u + 0x7fffu + ((u >> 16) & 1u)) >> 16; }
__device__ __forceinline__ unsigned pk2(float lo, float hi) { return f2bf(lo) | (f2bf(hi) << 16); }

#define XB_TMO      128
#define XB_XCNT(j)  (256  + 64 * (j))
#define XB_XSUB(j)  (1280 + 64 * (j))
#define XB_XGEN(j)  (2304 + 64 * (j))
#define XB_TOP      3328
#define XB_TOPGEN   3392
#define XCD_BAR_WORDS 3456
#define XB_SPIN_CAP (1u << 18)

__device__ __forceinline__ unsigned xb_ld(unsigned* p)              { return __hip_atomic_load(p, __ATOMIC_RELAXED, __HIP_MEMORY_SCOPE_AGENT); }
__device__ __forceinline__ unsigned xb_add(unsigned* p, unsigned v) { return __hip_atomic_fetch_add(p, v, __ATOMIC_RELAXED, __HIP_MEMORY_SCOPE_AGENT); }
__device__ __forceinline__ unsigned xb_xcc_id() { return (unsigned)__builtin_amdgcn_s_getreg((3 << 11) | 20) & 0xFu; }
#define XB_SPIN(cond, bar) do { unsigned _sp = 0; while (cond) { __builtin_amdgcn_s_sleep(1); \
    if ((++_sp & 255u) == 0u) { if (xb_ld(&(bar)[XB_TMO])) break; if (_sp > XB_SPIN_CAP) { atomicAdd(&(bar)[XB_TMO], 1u); break; } } } } while (0)

struct XcdBarrier {
    unsigned* bar; unsigned x;
    volatile LAS unsigned* st;
};

__device__ __forceinline__ XcdBarrier xcd_barrier_post(unsigned* bar, volatile LAS unsigned* st) {
    XcdBarrier b; b.bar = bar; b.x = xb_xcc_id(); b.st = st;
    if (threadIdx.x == 0) (void)xb_add(&bar[XB_XCNT(b.x)], 1u);
    return b;
}
__device__ __forceinline__ void xcd_barrier_complete(unsigned* bar, unsigned x, unsigned& nloc, unsigned& nx) {
    const unsigned G = gridDim.x * gridDim.y * gridDim.z;
    unsigned sum, cnt, mine, sp = 0u;
    for (;;) {
        sum = 0u; cnt = 0u; mine = 0u;
#pragma unroll
        for (unsigned j = 0; j < 16; ++j) { const unsigned c = xb_ld(&bar[XB_XCNT(j)]); sum += c; cnt += (c > 0u) ? 1u : 0u; mine = (j == x) ? c : mine; }
        if (sum == G) break;
        __builtin_amdgcn_s_sleep(1);
        if ((++sp & 255u) == 0u) { if (xb_ld(&bar[XB_TMO])) break; if (sp > XB_SPIN_CAP) { atomicAdd(&bar[XB_TMO], 1u); break; } }
    }
    nloc = mine > 0u ? mine : 1u; nx = cnt > 0u ? cnt : 1u;
}

__device__ __forceinline__ void xcd_barrier(const XcdBarrier& b) {
    asm volatile("s_waitcnt vmcnt(0)" ::: "memory");
    __syncthreads();
    if (threadIdx.x == 0) {
        unsigned* bar = b.bar;
        __builtin_amdgcn_s_waitcnt(0);
        unsigned nloc = b.st[0], nx = b.st[1];
        if (nloc == 0u) { xcd_barrier_complete(bar, b.x, nloc, nx); b.st[0] = nloc; b.st[1] = nx; }
        const unsigned old = xb_add(&bar[XB_XSUB(b.x)], 1u);
        const unsigned gen = old / nloc;
        if (old + 1u == (gen + 1u) * nloc) {
            __builtin_amdgcn_fence(__ATOMIC_RELEASE, "agent");
            asm volatile("s_waitcnt vmcnt(0)" ::: "memory");
            const unsigned og = xb_add(&bar[XB_TOP], 1u);
            const unsigned tg = og / nx;
            if (og + 1u == (tg + 1u) * nx) xb_add(&bar[XB_TOPGEN], 1u);
            else XB_SPIN(xb_ld(&bar[XB_TOPGEN]) == tg, bar);
            __builtin_amdgcn_fence(__ATOMIC_ACQUIRE, "agent");
            xb_add(&bar[XB_XGEN(b.x)], 1u);
            asm volatile("s_waitcnt vmcnt(0)" ::: "memory");
        } else {
            XB_SPIN(xb_ld(&bar[XB_XGEN(b.x)]) == gen, bar);
            __builtin_amdgcn_fence(__ATOMIC_ACQUIRE, "agent");
            asm volatile("s_waitcnt vmcnt(0)" ::: "memory");
        }
    }
    __syncthreads();
}


__device__ __forceinline__ pg8::Route pg8::EpiRoute::route(int g32) const {
    Route R; R.mode = 0; R.col = 0; R.pitch = 384; size_t off;
    if (g32 < 12) { off = WS_FQ; R.col = g32 * 32; R.mode = 1; }
    else if (g32 < 24) { off = WS_FK; R.col = (g32 - 12) * 32; }
    else if (g32 < 36) { off = WS_FV; R.col = (g32 - 24) * 32; }
    else if (g32 < 48) { off = WS_FG; R.col = (g32 - 36) * 32; R.mode = 2; }
    else if (g32 < 56) { off = WS_MQ; R.col = (g32 - 48) * 32; R.pitch = 256; R.mode = 1; }
    else if (g32 < 64) { off = WS_MG; R.col = (g32 - 56) * 32; R.pitch = 256; R.mode = 2; }
    else if (g32 < 70) { off = WS_GQ; R.col = (g32 - 64) * 32; R.pitch = 192; }
    else if (g32 < 76) { off = WS_GK; R.col = (g32 - 70) * 32; R.pitch = 192; }
    else if (g32 < 88) { off = WS_GV; R.col = (g32 - 76) * 32; }
    else { off = WS_GG; R.col = (g32 - 88) * 32; R.mode = 2; }
    R.base = (bf16_t*)(ws + off); return R;
}

template <int CTRL> __device__ __forceinline__ float dppf(float x) { return __builtin_bit_cast(float, __builtin_amdgcn_mov_dpp(__builtin_bit_cast(int, x), CTRL, 0xf, 0xf, true)); }
__device__ __forceinline__ float half_sum(float v) {
    v += dppf<0xB1>(v); v += dppf<0x4E>(v); v += dppf<0x141>(v); v += dppf<0x140>(v);
    auto s = __builtin_amdgcn_permlane16_swap(__float_as_uint(v), __float_as_uint(v), false, false);
    return __uint_as_float(s[0]) + __uint_as_float(s[1]);
}
__device__ __forceinline__ float wave_sum(float v) {
#pragma unroll
    for (int o = 1; o < 64; o <<= 1) v += __shfl_xor(v, o);
    return v;
}
__device__ __forceinline__ void p0_transpose_item(const float* W, int K, int N, bf16* WT, int n0, int nv, int drow0, int k0, LAS float* scr, int lane) {
    float tv[32];
#pragma unroll
    for (int i = 0; i < 32; ++i) { const int kk = 2 * i + (lane >> 5), nn = lane & 31; tv[i] = W[(size_t)(k0 + kk) * N + n0 + (nn < nv ? nn : 0)]; }
#pragma unroll
    for (int i = 0; i < 32; ++i) { const int kk = 2 * i + (lane >> 5), nn = lane & 31; scr[kk * 33 + nn] = nn < nv ? tv[i] : 0.f; }
    LDS_WAIT(); asm volatile("" ::: "memory");
    const int c = lane & 7;
#pragma unroll
    for (int j = 0; j < 4; ++j) { const int n = (lane >> 3) + 8 * j; const LAS float* s = scr + (8 * c) * 33 + n;
        v4u o; o.x = pk2(s[0 * 33], s[1 * 33]); o.y = pk2(s[2 * 33], s[3 * 33]); o.z = pk2(s[4 * 33], s[5 * 33]); o.w = pk2(s[6 * 33], s[7 * 33]);
        if (n < nv) *(GAS v4u*)(WT + (size_t)(drow0 + n) * K + k0 + 8 * c) = o; }
    LDS_WAIT(); asm volatile("" ::: "memory");
}
__device__ __forceinline__ void rms_row_to_bf16(const float* xrow, const float* g, bf16* orow, int lane) {
    const GAS f32x4* xr = (const GAS f32x4*)xrow + lane; const GAS f32x4* gr = (const GAS f32x4*)g + lane;
    f32x4 v[4]; float s = 0.f;
#pragma unroll
    for (int j = 0; j < 4; ++j) { v[j] = xr[64 * j]; s += (v[j].x * v[j].x + v[j].y * v[j].y) + (v[j].z * v[j].z + v[j].w * v[j].w); }
    const float rstd = 1.f / sqrtf(wave_sum(s) * (1.f / D) + EPS);
    GAS unsigned long long* o8 = (GAS unsigned long long*)orow + lane;
#pragma unroll
    for (int j = 0; j < 4; ++j) { const f32x4 gg = gr[64 * j]; o8[64 * j] = (unsigned long long)pk2(v[j].x * rstd * gg.x, v[j].y * rstd * gg.y) | ((unsigned long long)pk2(v[j].z * rstd * gg.z, v[j].w * rstd * gg.w) << 32); }
}
__device__ __forceinline__ void p0_mem_kv(LAS unsigned char* lds, int b, int tid, int wave, int lane, const float* mem, const float* g, const float* w, unsigned char* ws) {
    const int rg = b >> 3, cg = b & 7, c = tid & 63, col = 64 * cg + c;
    LAS float* ML = (LAS float*)lds;
    LAS float* red = ML + 8 * 1024; LAS float* sq = red + 8 * 8 * 64;
    { float ss = 0.f;
#pragma unroll
      for (int i = 0; i < 4; ++i) { const f32x4 m = *(const GAS f32x4*)(mem + (size_t)(8 * rg + wave) * D + 256 * i + 4 * lane); const f32x4 gg = *(const GAS f32x4*)(g + 256 * i + 4 * lane);
          ss += (m.x * m.x + m.y * m.y) + (m.z * m.z + m.w * m.w); *(LAS f32x4*)(ML + wave * 1024 + 256 * i + 4 * lane) = m * gg; }
      ss = wave_sum(ss); if (lane == 0) sq[wave] = ss; }
    __syncthreads();
    float acc[8];
#pragma unroll
    for (int r = 0; r < 8; ++r) acc[r] = 0.f;
    const float* wp = w + (size_t)(128 * wave) * 512 + col;
    float wall[128];
#pragma unroll
    for (int k = 0; k < 128; ++k) wall[k] = wp[(size_t)k * 512];
#pragma unroll
    for (int k4 = 0; k4 < 32; ++k4) { float wv[4];
#pragma unroll
        for (int j = 0; j < 4; ++j) wv[j] = wall[4 * k4 + j];
#pragma unroll
        for (int r = 0; r < 8; ++r) { const f32x4 m = *(const LAS f32x4*)(ML + r * 1024 + 128 * wave + 4 * k4); acc[r] += (m.x * wv[0] + m.y * wv[1]) + (m.z * wv[2] + m.w * wv[3]); } }
#pragma unroll
    for (int r = 0; r < 8; ++r) red[(wave * 8 + r) * 64 + c] = acc[r];
    __syncthreads();
    { const int r = tid >> 6; float a = 0.f;
#pragma unroll
      for (int wv = 0; wv < 8; ++wv) a += red[(wv * 8 + r) * 64 + c];
      const float o = a / sqrtf(sq[r] * (1.f / D) + EPS);
      bf16* dst = (bf16*)(ws + (col < 256 ? WS_MK : WS_MV)) + (size_t)(8 * rg + r) * 256 + (col & 255);
      *dst = (bf16)f2bf(o); }
    __syncthreads();
}
__device__ __forceinline__ void p0_prologue(LAS unsigned char* lds, int vcu, int G, int tid, int wave, int lane, const float* x, const float* mem, const float* norm_g, const float* w_in, const float* mem_norm_g,
                                            const float* w_mem_kv, const float* w_out, unsigned char* ws) {
    LAS float* scr = (LAS float*)(lds + RING_OFF + wave * 16384);
    const int gw = vcu * NWAVES + wave, NGW = G * NWAVES;
    constexpr int NB_IN = 96, I_IN = NB_IN * 16, I_OUT = 32 * 16, I_SK = 5 * 16, NITEMS = I_IN + I_OUT + I_SK;
    for (int rq = 0; rq < NREP(50); ++rq)
    for (int it = gw; it < NITEMS; it += NGW) {
        if (it < I_IN) {
            const int nb = it >> 4, kb = it & 15; int src, width, dst, b = nb;
            if (b < 6) { src = 0; width = 192; dst = 2048; }
            else if ((b -= 6) < 6) { src = 192; width = 192; dst = 2240; }
            else if ((b -= 6) < 12) { src = 384; width = 384; dst = 2432; }
            else if ((b -= 12) < 8) { src = 784; width = 256; dst = 2816; }
            else if ((b -= 8) < 12) { src = 1168; width = 384; dst = 0; }
            else if ((b -= 12) < 12) { src = 1552; width = 384; dst = 384; }
            else if ((b -= 12) < 12) { src = 1936; width = 384; dst = 768; }
            else if ((b -= 12) < 12) { src = 2326; width = 384; dst = 1152; }
            else if ((b -= 12) < 8) { src = 2710; width = 256; dst = 1536; }
            else { b -= 8; src = 2966; width = 256; dst = 1792; }
            const int nv = (width - 32 * b) < 32 ? (width - 32 * b) : 32;
            p0_transpose_item(w_in, D, IN_COLS, (bf16*)(ws + WS_WIN), src + 32 * b, nv, dst + 32 * b, 64 * kb, scr, lane);
        } else if (it < I_IN + I_OUT) { const int r = it - I_IN, nt = r >> 4, kq = r & 15;
#pragma unroll
            for (int u = 0; u < 4; ++u) { const int ks = 4 * kq + u; const float* src = w_out + (size_t)(16 * ks + 8 * (lane >> 5)) * D + 32 * nt + (lane & 31);
                v4u o; o.x = pk2(src[0 * D], src[1 * D]); o.y = pk2(src[2 * D], src[3 * D]); o.z = pk2(src[4 * D], src[5 * D]); o.w = pk2(src[6 * D], src[7 * D]);
                *((GAS v4u*)(ws + WS_WOUTF) + (size_t)(nt * 64 + ks) * 64 + lane) = o; }
        } else { const int r = it - I_IN - I_OUT, ct = r >> 4, kq = r & 15; const int r32 = lane & 31;
            int col = -1; if (ct < 4) col = 784 + 256 + 32 * ct + r32; else if (r32 < 16) col = 768 + r32; else if (r32 < 22) col = 2320 + (r32 - 16);
#pragma unroll
            for (int u = 0; u < 4; ++u) { const int ks = 4 * kq + u; const float* src = w_in + (size_t)(16 * ks + 8 * (lane >> 5)) * IN_COLS + (col < 0 ? 0 : col);
                v4u o; o.x = pk2(src[0 * IN_COLS], src[1 * IN_COLS]); o.y = pk2(src[2 * IN_COLS], src[3 * IN_COLS]); o.z = pk2(src[4 * IN_COLS], src[5 * IN_COLS]); o.w = pk2(src[6 * IN_COLS], src[7 * IN_COLS]);
                if (col < 0) o = (v4u){0u, 0u, 0u, 0u};
                *((GAS v4u*)(ws + WS_WSF) + (size_t)(ct * 64 + ks) * 64 + lane) = o; } }
    }
    {
      f32x4 gg[4];
#pragma unroll
      for (int j = 0; j < 4; ++j) gg[j] = ((const GAS f32x4*)norm_g)[64 * j + lane];
      for (int rq = 0; rq < NREP(51); ++rq)
      for (int m0 = gw; m0 < M; m0 += 4 * NGW) { f32x4 v[4][4]; float ss[4];
#pragma unroll
          for (int q = 0; q < 4; ++q) { const int m = m0 + q * NGW; const GAS f32x4* xr = (const GAS f32x4*)(x + (size_t)(m < M ? m : 0) * D) + lane;
#pragma unroll
              for (int j = 0; j < 4; ++j) v[q][j] = xr[64 * j]; }
#pragma unroll
          for (int q = 0; q < 4; ++q) { float a = 0.f;
#pragma unroll
              for (int j = 0; j < 4; ++j) a += (v[q][j].x * v[q][j].x + v[q][j].y * v[q][j].y) + (v[q][j].z * v[q][j].z + v[q][j].w * v[q][j].w);
              ss[q] = a; }
#pragma unroll
          for (int q = 0; q < 4; ++q) { float a = half_sum(ss[q]); auto t = __builtin_amdgcn_permlane32_swap(__float_as_uint(a), __float_as_uint(a), false, false); ss[q] = __uint_as_float(t[0]) + __uint_as_float(t[1]); }
#pragma unroll
          for (int q = 0; q < 4; ++q) { const int m = m0 + q * NGW; if (m < M) { const float rstd = 1.f / sqrtf(ss[q] * (1.f / D) + EPS);
              GAS unsigned long long* o8 = (GAS unsigned long long*)((bf16*)(ws + WS_XN) + (size_t)m * D) + lane;
#pragma unroll
              for (int j = 0; j < 4; ++j) { const unsigned long long w8 = (unsigned long long)pk2(v[q][j].x * rstd * gg[j].x, v[q][j].y * rstd * gg[j].y) | ((unsigned long long)pk2(v[q][j].z * rstd * gg[j].z, v[q][j].w * rstd * gg[j].w) << 32);
                  asm volatile("global_store_dwordx2 %0, %1, off sc0 sc1\n\ts_nop 1" :: "v"(o8 + 64 * j), "v"(w8) : "memory"); } } } } }
    for (int rq = 0; rq < NREP(52); ++rq)
    for (int b = vcu; b < 256; b += G) p0_mem_kv(lds, b, tid, wave, lane, mem, mem_norm_g, w_mem_kv, ws);
}
__device__ __forceinline__ void nan_rows_f32(int vcu, int G, int wave, int lane, float* out) {
    const int gw = vcu * NWAVES + wave, NGW = G * NWAVES; const float q = __builtin_nanf("");
    for (int m = gw; m < M; m += NGW) { GAS f32x4* o = (GAS f32x4*)(out + (size_t)m * D) + lane;
#pragma unroll
        for (int j = 0; j < 4; ++j) o[64 * j] = (f32x4){q, q, q, q}; }
}
__device__ __forceinline__ void glds16(const void* gsrc, unsigned lds_dst) { unsigned keep;
    asm volatile("s_mov_b32 %0, m0\n\ts_mov_b32 m0, %2\n\ts_nop 0\n\tglobal_load_lds_dwordx4 %1, off\n\ts_mov_b32 m0, %0" : "=&s"(keep) : "v"(gsrc), "s"(lds_dst) : "memory"); }
__device__ __forceinline__ float log_sigmoid(float z) { return fminf(z, 0.f) - log1pf(__expf(-fabsf(z))); }
__device__ __forceinline__ float bf_lo(unsigned u) { return __uint_as_float(u << 16); }
__device__ __forceinline__ float bf_hi(unsigned u) { return __uint_as_float(u & 0xffff0000u); }
__device__ __forceinline__ void gla_cum_decay(float (&b)[24], const float* glr_row, const LAS float* w_up, const LAS float* b_alpha, int w, int lane) {
    f32x4 g4[4];
#pragma unroll
    for (int i = 0; i < 4; ++i) g4[i] = *(const f32x4*)(glr_row + 4 * i);
#pragma unroll
    for (int jj = 0; jj < 24; ++jj) { const int j = 24 * w + jj; float z = b_alpha[j];
#pragma unroll
        for (int r = 0; r < 16; ++r) z += g4[r >> 2][r & 3] * w_up[r * 192 + j];
        float v = log_sigmoid(z) * (1.f / 16.f);
#pragma unroll
        for (int d = 1; d < 64; d <<= 1) { const float o = __shfl_up(v, d); if (lane >= d) v += o; }
        b[jj] = v; }
}
constexpr int GL_VT = 0, GL_VT_PITCH = 72, GL_VT_BYTES = 384 * GL_VT_PITCH * 2;
constexpr int GL_KT = GL_VT_BYTES, GL_KT_PITCH = 72, GL_KT_BYTES = 192 * GL_KT_PITCH * 2;
constexpr int GL_QD = GL_VT_BYTES, GL_QD_PITCH = 200, GL_QD_BYTES = 64 * GL_QD_PITCH * 2;
constexpr int GL_KD = GL_QD + GL_QD_BYTES;
constexpr int GL_AT = GL_QD, GL_AT_PITCH = 72, GL_AT_WAVE = 32 * GL_AT_PITCH * 2;
constexpr int GL_W = 112 * 1024, GL_BA = GL_W + 16 * 192 * 4;
static_assert(GL_KD + GL_QD_BYTES <= GL_W && GL_KT + GL_KT_BYTES <= GL_W && GL_BA + 192 * 4 <= RING_BYTES && GL_AT + 8 * GL_AT_WAVE <= GL_KD + GL_QD_BYTES + 65536 && GL_AT + 8 * GL_AT_WAVE <= RING_BYTES, "GLA LDS map");
__device__ __forceinline__ void gla_stage_vt(LAS unsigned char* lds, const bf16* GV, int t0, int tid, const float* w_up, const float* b_alpha) {
    for (int i = tid; i < 16 * 192 / 4; i += 512) ((LAS f32x4*)(lds + GL_W))[i] = ((const GAS f32x4*)w_up)[i];
    if (tid < 48) ((LAS f32x4*)(lds + GL_BA))[tid] = ((const GAS f32x4*)b_alpha)[tid];
#pragma unroll
    for (int i = 0; i < 6; ++i) { const int q = tid + 512 * i, c = q & 63, cc = q >> 6;
        const v4u d = *(const GAS v4u*)(GV + (size_t)(t0 + c) * 384 + 8 * cc);
        LAS unsigned short* p = (LAS unsigned short*)(lds + GL_VT) + (8 * cc) * GL_VT_PITCH + c;
        p[0 * GL_VT_PITCH] = (unsigned short)(d.x & 0xffffu); p[1 * GL_VT_PITCH] = (unsigned short)(d.x >> 16); p[2 * GL_VT_PITCH] = (unsigned short)(d.y & 0xffffu); p[3 * GL_VT_PITCH] = (unsigned short)(d.y >> 16);
        p[4 * GL_VT_PITCH] = (unsigned short)(d.z & 0xffffu); p[5 * GL_VT_PITCH] = (unsigned short)(d.z >> 16); p[6 * GL_VT_PITCH] = (unsigned short)(d.w & 0xffffu); p[7 * GL_VT_PITCH] = (unsigned short)(d.w >> 16); }
}
constexpr int P2_VT = 0, P2_KT = GL_VT_BYTES, P2_BL = P2_KT + GL_KT_BYTES, P2_BL_PITCH = 193;
constexpr int P2_GLR = 133 * 1024, P2_LF = P2_GLR + 4096, P2_NRM = P2_LF + 1536;
static_assert(P2_BL + 64 * P2_BL_PITCH * 4 <= P2_GLR && P2_NRM + 64 <= RING_BYTES, "P2 LDS map");
__device__ __forceinline__ float log_sigmoid_fast(float z) { const float t = __builtin_amdgcn_exp2f(-LOG2E * fabsf(z)); return fminf(z, 0.f) - 0.6931471805599453f * __builtin_amdgcn_logf(1.f + t); }
__device__ __forceinline__ void p2_chunk_item(LAS unsigned char* lds, int n, int tid, int wave, int lane, unsigned char* ws, gu32* ctl, const float* w_up, const float* b_alpha, const float* b_forget) {
    typedef float f32x16 __attribute__((ext_vector_type(16)));
    asm volatile("" : "+v"(tid), "+v"(lane), "+s"(wave));
    const int t0 = 64 * n, r32 = lane & 31, hi = lane >> 5;
    { const unsigned lds0 = (unsigned)(uintptr_t)(lds); const bf16* xn = (const bf16*)(ws + WS_XN) + (size_t)t0 * 1024;
#pragma unroll
      for (int i = 0; i < 16; ++i) { const int p = 16 * wave + i, row = p >> 1, half = p & 1; const int kc = 64 * half + (lane ^ (row & 15));
          glds16(xn + (size_t)row * 1024 + 8 * kc, (unsigned)__builtin_amdgcn_readfirstlane(lds0 + row * 2048 + half * 1024)); } }
    if (tid < 12) ((LAS unsigned*)(lds + P2_NRM))[tid] = 0u;
    v4u vreg[6];
#pragma unroll
    for (int i = 0; i < 6; ++i) { const int q = tid + 512 * i, c = q & 63, cc = q >> 6; vreg[i] = *(const GAS v4u*)((const bf16*)(ws + WS_GV) + (size_t)(t0 + c) * 384 + 8 * cc); }
    v4u kk[3];
#pragma unroll
    for (int i = 0; i < 3; ++i) kk[i] = *(const GAS v4u*)((const bf16*)(ws + WS_GK) + (size_t)(t0 + lane) * 192 + 24 * wave + 8 * i);
    const int jc = tid < 192 ? tid : tid - 192;
    float wc[16]; float ba = 0.f;
    if (tid < 384) { ba = b_alpha[jc];
#pragma unroll
        for (int r = 0; r < 16; ++r) wc[r] = w_up[r * 192 + jc]; }
    LAS float* GLRL = (LAS float*)(lds + P2_GLR); LAS float* LF = (LAS float*)(lds + P2_LF);
    if (wave < 5) {
        f32x16 c[2] = {f32x16{}, f32x16{}};
        const GAS bf16x8* bp = (const GAS bf16x8*)(ws + WS_WSF) + (size_t)(wave * 64) * 64 + lane;
        bf16x8 bq[16];
#pragma unroll
        for (int u = 0; u < 16; ++u) bq[u] = bp[u * 64];
        asm volatile("s_waitcnt vmcnt(0)" ::: "memory"); __syncthreads();
        const int sw = r32 & 15;
#pragma unroll 1
        for (int ks0 = 0; ks0 < 64; ks0 += 16) {
#pragma unroll
            for (int u = 0; u < 16; ++u) { const int ks = ks0 + u; const int off = r32 * 2048 + (((2 * ks + hi) ^ sw) * 16);
                const bf16x8 a0 = *(const LAS bf16x8*)(lds + off), a1 = *(const LAS bf16x8*)(lds + off + 32 * 2048);
                c[0] = __builtin_amdgcn_mfma_f32_32x32x16_bf16(a0, bq[u], c[0], 0, 0, 0); c[1] = __builtin_amdgcn_mfma_f32_32x32x16_bf16(a1, bq[u], c[1], 0, 0, 0);
                if (ks + 16 < 64) bq[u] = bp[(ks + 16) * 64]; } }
        if (wave < 4) {
#pragma unroll
            for (int rt = 0; rt < 2; ++rt)
#pragma unroll
                for (int r = 0; r < 16; ++r) { const float v = c[rt][r]; const int row = 32 * rt + (r & 3) + 8 * (r >> 2) + 4 * hi;
                    ((bf16*)(ws + WS_GG))[(size_t)(t0 + row) * 384 + 256 + 32 * wave + r32] = (bf16)f2bf(v * __builtin_amdgcn_rcpf(1.f + __builtin_amdgcn_exp2f(-LOG2E * v))); }
        } else {
            const float bf = r32 >= 16 && r32 < 22 ? b_forget[r32 - 16] : 0.f;
#pragma unroll
            for (int rt = 0; rt < 2; ++rt)
#pragma unroll
                for (int r = 0; r < 16; ++r) { const float v = c[rt][r]; const int row = 32 * rt + (r & 3) + 8 * (r >> 2) + 4 * hi;
                    if (r32 < 16) GLRL[row * 16 + r32] = v;
                    else if (r32 < 22) LF[(r32 - 16) * 64 + row] = LOG2E * log_sigmoid(v + bf); }
        }
    } else {
        asm volatile("s_waitcnt vmcnt(0)" ::: "memory"); __syncthreads();
        const int t = tid - 320;
#pragma unroll
        for (int pp = 0; pp < 2; ++pp) { const int p = t + 192 * pp, row = p / 6, h = p % 6;
#pragma unroll
            for (int which = 0; which < 2; ++which) { const bf16* src = (const bf16*)(ws + (which ? WS_FK : WS_FQ)) + (size_t)(t0 + row) * 384 + h * 64; float sacc = 0.f;
#pragma unroll
                for (int i = 0; i < 8; ++i) { const v4u a = *(const GAS v4u*)(src + 8 * i);
#pragma unroll
                    for (int e = 0; e < 4; ++e) { const float lo = bf_lo(a[e]), hh = bf_hi(a[e]); sacc += lo * lo + hh * hh; } }
                __hip_atomic_fetch_max((LAS unsigned*)(lds + P2_NRM) + which * 6 + h, __float_as_uint(sacc), __ATOMIC_RELAXED, __HIP_MEMORY_SCOPE_WORKGROUP); } }
    }
    __syncthreads();
    if (tid < 12) __hip_atomic_fetch_max((unsigned*)(ctl + CW_NMAX + tid), ((LAS unsigned*)(lds + P2_NRM))[tid], RLX_AGENT);
#pragma unroll
    for (int i = 0; i < 6; ++i) { const int q = tid + 512 * i, c = q & 63, cc = q >> 6; const v4u d = vreg[i];
        LAS unsigned short* p = (LAS unsigned short*)(lds + P2_VT) + (8 * cc) * GL_VT_PITCH + c;
        p[0 * GL_VT_PITCH] = (unsigned short)(d.x & 0xffffu); p[1 * GL_VT_PITCH] = (unsigned short)(d.x >> 16); p[2 * GL_VT_PITCH] = (unsigned short)(d.y & 0xffffu); p[3 * GL_VT_PITCH] = (unsigned short)(d.y >> 16);
        p[4 * GL_VT_PITCH] = (unsigned short)(d.z & 0xffffu); p[5 * GL_VT_PITCH] = (unsigned short)(d.z >> 16); p[6 * GL_VT_PITCH] = (unsigned short)(d.w & 0xffffu); p[7 * GL_VT_PITCH] = (unsigned short)(d.w >> 16); }
    LAS float* BL = (LAS float*)(lds + P2_BL);
    if (tid < 384) { const int c0 = tid < 192 ? 0 : 32; float run = 0.f;
#pragma unroll 4
        for (int c = 0; c < 32; ++c) { const LAS f32x4* g4 = (const LAS f32x4*)(GLRL + (c0 + c) * 16); float z = ba;
#pragma unroll
            for (int q = 0; q < 4; ++q) { const f32x4 g = g4[q]; z += (g.x * wc[4 * q] + g.y * wc[4 * q + 1]) + (g.z * wc[4 * q + 2] + g.w * wc[4 * q + 3]); }
            run += log_sigmoid_fast(z) * (1.f / 16.f); BL[(c0 + c) * P2_BL_PITCH + jc] = run; } }
    else if (wave == 6 || wave == 7) {
#pragma unroll
        for (int hh = 0; hh < 3; ++hh) { const int h = 3 * (wave - 6) + hh; float v = LF[h * 64 + lane];
#pragma unroll
            for (int d = 1; d < 64; d <<= 1) { const float o = __shfl_up(v, d); if (lane >= d) v += o; }
            ((float*)(ws + WS_CFL))[(size_t)h * M + t0 + lane] = v; if (lane == 63) ((float*)(ws + WS_TOT))[h * 256 + n] = v; } }
    __syncthreads();
    { LAS unsigned short* kt = (LAS unsigned short*)(lds + P2_KT); float* dec = (float*)(ws + WS_DEC) + (size_t)n * 192; float b[24];
#pragma unroll
      for (int jj = 0; jj < 24; ++jj) { const int j = 24 * wave + jj; const float half = BL[31 * P2_BL_PITCH + j]; const float bl = BL[63 * P2_BL_PITCH + j] + half;
          const float bv = BL[lane * P2_BL_PITCH + j] + (lane >= 32 ? half : 0.f); b[jj] = bv;
          const unsigned u = kk[jj >> 3][(jj & 7) >> 1]; const float kv = (jj & 1) ? bf_hi(u) : bf_lo(u);
          kt[j * GL_KT_PITCH + lane] = (unsigned short)f2bf(kv * __expf(bl - bv));
          if (lane == 63) dec[j] = __expf(bl); }
      float* gb = (float*)(ws + WS_GB) + (size_t)(t0 + lane) * 192 + 24 * wave;
#pragma unroll
      for (int i = 0; i < 6; ++i) *(f32x4*)(gb + 4 * i) = (f32x4){b[4 * i], b[4 * i + 1], b[4 * i + 2], b[4 * i + 3]}; }
    __syncthreads();
    { const int r16 = lane & 15, q4 = lane >> 4;
      float* kvt = (float*)(ws + WS_KVT) + (size_t)n * 18432;
      for (int ti = wave; ti < 72; ti += 8) { const int h = ti / 18, rem = ti % 18, vt = rem / 3, kt3 = rem % 3;
          pg8::f32x4 acc = {0.f, 0.f, 0.f, 0.f};
#pragma unroll
          for (int ks = 0; ks < 2; ++ks) {
              const bf16x8 a = *(const LAS bf16x8*)(lds + P2_VT + ((h * 96 + vt * 16 + r16) * GL_VT_PITCH + ks * 32 + 8 * q4) * 2);
              const bf16x8 bb = *(const LAS bf16x8*)(lds + P2_KT + ((h * 48 + kt3 * 16 + r16) * GL_KT_PITCH + ks * 32 + 8 * q4) * 2);
              acc = __builtin_amdgcn_mfma_f32_16x16x32_bf16(a, bb, acc, 0, 0, 0); }
#pragma unroll
          for (int r = 0; r < 4; ++r) kvt[(size_t)(h * 96 + vt * 16 + q4 * 4 + r) * 48 + kt3 * 16 + r16] = acc[r]; } }
    __syncthreads();
}
__device__ __forceinline__ void gla_scan_item(int item, int tid, unsigned char* ws) {
    const int e = item * 512 + tid, h = e / 4608, k = e % 48;
    const float* kvt = (const float*)(ws + WS_KVT) + e; const float* dec = (const float*)(ws + WS_DEC) + h * 48 + k; bf16* st = (bf16*)(ws + WS_ST) + e;
    float S = 0.f;
    for (int n0 = 0; n0 < 256; n0 += 16) { float kv[16], dc[16];
#pragma unroll
        for (int i = 0; i < 16; ++i) { kv[i] = kvt[(size_t)(n0 + i) * 18432]; dc[i] = dec[(size_t)(n0 + i) * 192]; }
#pragma unroll
        for (int i = 0; i < 16; ++i) { st[(size_t)(n0 + i) * 18432] = (bf16)f2bf(S); S = dc[i] * S + kv[i]; } }
}
constexpr int FO_AMG = 0;
constexpr int FO_VT = 49152;
constexpr int FO_QD = 98304, FO_KD = FO_QD + 24576;
constexpr int FO_AT = FO_QD;
constexpr int FO_AR1 = 49152;
constexpr int FO_AR2 = FO_AR1 + 65536;
constexpr int FO_TR = 0, FO_TR_WAVE = 32 * 528;
constexpr int FO_RED = 8 * FO_TR_WAVE, FO_RS = FO_RED + 2048;
static_assert(FO_AR2 + 16384 <= RING_BYTES && FO_KD + 24576 <= RING_BYTES && FO_RS + 256 <= RING_BYTES, "fused out-projection LDS map");
__device__ __forceinline__ void fused_out_item(LAS unsigned char* lds, int n, int tid, int wave, int lane, unsigned char* ws, const float* x, const float* gng, const float* fng, float* out) {
    typedef float f32x16 __attribute__((ext_vector_type(16)));
    asm volatile("" : "+v"(tid), "+v"(lane), "+s"(wave));
    const int t0 = 64 * n; const int r32 = lane & 31, hi = lane >> 5;
    for (int rpa = 0; rpa < NREP(40); ++rpa) {
    { const unsigned lds0 = (unsigned)(uintptr_t)(lds); const bf16* gsrc = (const bf16*)(ws + WS_GG) + (size_t)t0 * 384;
      if (lane < 48) {
#pragma unroll
          for (int i = 0; i < 8; ++i) { const int row = 8 * wave + i; glds16(gsrc + (size_t)row * 384 + 8 * (lane ^ (row & 15)), (unsigned)__builtin_amdgcn_readfirstlane(lds0 + FO_AMG + row * 768)); } } }
    bf16x8 sb[3][3];
    { const bf16* stn = (const bf16*)(ws + WS_ST) + (size_t)n * 18432 + (size_t)(wave >> 1) * 4608;
#pragma unroll
      for (int vt = 0; vt < 3; ++vt)
#pragma unroll
          for (int ks = 0; ks < 3; ++ks) sb[vt][ks] = *(const GAS bf16x8*)(stn + (32 * vt + r32) * 48 + 16 * ks + 8 * hi); }
    float gn[3];
#pragma unroll
    for (int vt = 0; vt < 3; ++vt) gn[vt] = gng[32 * vt + r32];
#pragma unroll
    for (int i = 0; i < 6; ++i) { const int q = tid + 512 * i, c = q & 63, cc = q >> 6;
        const v4u d = *(const GAS v4u*)((const bf16*)(ws + WS_GV) + (size_t)(t0 + c) * 384 + 8 * cc);
        LAS unsigned char* p = lds + FO_VT + (c & 7) * 2; const int kc = c >> 3;
#pragma unroll
        for (int e = 0; e < 8; ++e) { const int v = 8 * cc + e; const unsigned w = d[e >> 1]; const unsigned short val = (e & 1) ? (unsigned short)(w >> 16) : (unsigned short)(w & 0xffffu);
            *(LAS unsigned short*)(p + v * 128 + ((kc ^ ((v >> 1) & 7)) * 16)) = val; } }
    { const size_t row = (size_t)(t0 + lane);
      v4u qq[3], kk[3]; f32x4 bb[6];
#pragma unroll
      for (int i = 0; i < 3; ++i) { qq[i] = *(const GAS v4u*)((const bf16*)(ws + WS_GQ) + row * 192 + 24 * wave + 8 * i); kk[i] = *(const GAS v4u*)((const bf16*)(ws + WS_GK) + row * 192 + 24 * wave + 8 * i); }
#pragma unroll
      for (int i = 0; i < 6; ++i) bb[i] = *(const GAS f32x4*)((const float*)(ws + WS_GB) + row * 192 + 24 * wave + 4 * i);
      const float qs = 0.14433756729740643f;
      const int sw = (lane >> 1) & 7;
#pragma unroll
      for (int i = 0; i < 3; ++i) { v4u oq, ok;
#pragma unroll
          for (int e = 0; e < 4; ++e) { const float b0 = bb[2 * i + (e >> 1)][(2 * e) & 3], b1 = bb[2 * i + (e >> 1)][((2 * e) & 3) + 1];
              oq[e] = pk2(bf_lo(qq[i][e]) * qs * __expf(b0), bf_hi(qq[i][e]) * qs * __expf(b1)); ok[e] = pk2(bf_lo(kk[i][e]) * __expf(-b0), bf_hi(kk[i][e]) * __expf(-b1)); }
          const int ch = 3 * wave + i, chs = (ch & ~7) | ((ch & 7) ^ sw);
          *(LAS v4u*)(lds + FO_QD + lane * 384 + chs * 16) = oq; *(LAS v4u*)(lds + FO_KD + lane * 384 + chs * 16) = ok; } }
    __syncthreads();
    const int h = wave >> 1, rh = wave & 1;
    {
      f32x16 at[2] = {f32x16{}, f32x16{}}, o[3] = {f32x16{}, f32x16{}, f32x16{}};
      bf16x8 qa[3];
      { const int row = 32 * rh + r32, sw = (row >> 1) & 7;
#pragma unroll
        for (int ks = 0; ks < 3; ++ks) { const int ch = 6 * h + 2 * ks + hi; qa[ks] = *(const LAS bf16x8*)(lds + FO_QD + row * 384 + ((ch & ~7) | ((ch & 7) ^ sw)) * 16); } }
#pragma unroll
      for (int st = 0; st < 2; ++st) if (st <= rh) { const int row = 32 * st + r32, sw = (row >> 1) & 7;
#pragma unroll
          for (int ks = 0; ks < 3; ++ks) { const int ch = 6 * h + 2 * ks + hi; const bf16x8 kb = *(const LAS bf16x8*)(lds + FO_KD + row * 384 + ((ch & ~7) | ((ch & 7) ^ sw)) * 16);
              at[st] = __builtin_amdgcn_mfma_f32_32x32x16_bf16(qa[ks], kb, at[st], 0, 0, 0); } }
#pragma unroll
      for (int vt = 0; vt < 3; ++vt)
#pragma unroll
          for (int ks = 0; ks < 3; ++ks) o[vt] = __builtin_amdgcn_mfma_f32_32x32x16_bf16(qa[ks], sb[vt][ks], o[vt], 0, 0, 0);
      __syncthreads();
      LAS unsigned char* atw = lds + FO_AT + wave * 4096;
#pragma unroll
      for (int st = 0; st < 2; ++st) if (st <= rh) {
#pragma unroll
          for (int r = 0; r < 16; ++r) { const int cl = (r & 3) + 8 * (r >> 2) + 4 * hi, c = 32 * rh + cl, s = 32 * st + r32;
              *(LAS unsigned short*)(atw + cl * 128 + (((s >> 3) ^ ((cl >> 1) & 7)) * 16) + (s & 7) * 2) = (unsigned short)f2bf(s <= c ? at[st][r] : 0.f); } }
      LDS_WAIT(); asm volatile("" ::: "memory");
#pragma unroll
      for (int ks = 0; ks < 4; ++ks) if (ks < 2 * rh + 2) { const bf16x8 aa = *(const LAS bf16x8*)(atw + r32 * 128 + (((2 * ks + hi) ^ ((r32 >> 1) & 7)) * 16));
#pragma unroll
          for (int vt = 0; vt < 3; ++vt) { const int v = h * 96 + 32 * vt + r32; const bf16x8 vb = *(const LAS bf16x8*)(lds + FO_VT + v * 128 + (((2 * ks + hi) ^ ((v >> 1) & 7)) * 16));
              o[vt] = __builtin_amdgcn_mfma_f32_32x32x16_bf16(aa, vb, o[vt], 0, 0, 0); } }
#pragma unroll
      for (int r = 0; r < 16; ++r) { const float ss = half_sum(o[0][r] * o[0][r] + o[1][r] * o[1][r] + o[2][r] * o[2][r]);
          const float rstd = 1.f / sqrtf(ss * (1.f / 96.f) + EPS);
          const int rl = 32 * rh + (r & 3) + 8 * (r >> 2) + 4 * hi;
#pragma unroll
          for (int vt = 0; vt < 3; ++vt) { const int col = h * 96 + 32 * vt + r32; LAS unsigned short* ap = (LAS unsigned short*)(lds + FO_AMG + rl * 768 + (((col >> 3) ^ (rl & 15)) * 16) + (col & 7) * 2);
              const float g = __uint_as_float((unsigned)(*ap) << 16); *ap = (unsigned short)f2bf(o[vt][r] * rstd * gn[vt] * g); } }
    }
    __syncthreads();
    }
    { const unsigned lds0 = (unsigned)(uintptr_t)(lds); const bf16* mix = (const bf16*)(ws + WS_MIX) + (size_t)t0 * 1024;
#pragma unroll
      for (int i = 0; i < 8; ++i) { const int row = 8 * wave + i; const int kc = lane ^ (row & 15);
          glds16(mix + (size_t)row * 1024 + 384 + 8 * kc, (unsigned)__builtin_amdgcn_readfirstlane(lds0 + FO_AR1 + row * 1024)); }
#pragma unroll
      for (int i = 0; i < 2; ++i) { const int q = 2 * wave + i, row = 4 * q + (lane >> 4); const int kc = (lane & 15) ^ (row & 15);
          glds16(mix + (size_t)row * 1024 + 896 + 8 * kc, (unsigned)__builtin_amdgcn_readfirstlane(lds0 + FO_AR2 + q * 1024)); } }
    f32x16 acc[2][4];
#pragma unroll
    for (int rt = 0; rt < 2; ++rt)
#pragma unroll
        for (int ct = 0; ct < 4; ++ct) acc[rt][ct] = f32x16{};
    const GAS bf16x8* wf = (const GAS bf16x8*)(ws + WS_WOUTF) + (size_t)(4 * wave) * 64 * 64 + lane;
    bf16x8 bq[4][4];
    for (int rpb = 0; rpb < NREP(41); ++rpb) {
#pragma unroll
    for (int u = 0; u < 4; ++u)
#pragma unroll
        for (int ct = 0; ct < 4; ++ct) bq[u][ct] = wf[(ct * 64 + u) * 64];
    const int sw15 = r32 & 15;
#pragma unroll 1
    for (int ks0 = 0; ks0 < 64; ks0 += 4) {
        if (ks0 == 24) { asm volatile("s_waitcnt vmcnt(0)" ::: "memory"); __syncthreads(); }
#pragma unroll
        for (int u = 0; u < 4; ++u) { const int ks = ks0 + u, kc = 2 * ks + hi;
            int a_off;
            if (ks0 < 24) a_off = FO_AMG + r32 * 768 + ((kc ^ sw15) * 16);
            else if (ks0 < 56) a_off = FO_AR1 + r32 * 1024 + (((kc - 48) ^ sw15) * 16);
            else a_off = FO_AR2 + r32 * 256 + (((kc - 112) ^ sw15) * 16);
            const int rstep = ks0 < 24 ? 32 * 768 : (ks0 < 56 ? 32 * 1024 : 32 * 256);
            const bf16x8 a0 = *(const LAS bf16x8*)(lds + a_off), a1 = *(const LAS bf16x8*)(lds + a_off + rstep);
#pragma unroll
            for (int ct = 0; ct < 4; ++ct) { acc[0][ct] = __builtin_amdgcn_mfma_f32_32x32x16_bf16(a0, bq[u][ct], acc[0][ct], 0, 0, 0); acc[1][ct] = __builtin_amdgcn_mfma_f32_32x32x16_bf16(a1, bq[u][ct], acc[1][ct], 0, 0, 0); }
            if (ks + 4 < 64) {
#pragma unroll
                for (int ct = 0; ct < 4; ++ct) bq[u][ct] = wf[(ct * 64 + ks + 4) * 64]; }
        }
    }
    }
    __syncthreads();
    LAS float* tr = (LAS float*)(lds + FO_TR + wave * FO_TR_WAVE);
    LAS float* red = (LAS float*)(lds + FO_RED);
    f32x4 v[2][16];
    const int c4 = lane & 31, rsel = lane >> 5;
#pragma unroll
    for (int rt = 0; rt < 2; ++rt) {
#pragma unroll
        for (int ct = 0; ct < 4; ++ct)
#pragma unroll
            for (int r = 0; r < 16; ++r) tr[((r & 3) + 8 * (r >> 2) + 4 * hi) * 132 + 32 * ct + r32] = acc[rt][ct][r];
        LDS_WAIT(); asm volatile("" ::: "memory");
#pragma unroll
        for (int i = 0; i < 16; ++i) { const int rl = 2 * i + rsel; const size_t row = (size_t)(t0 + 32 * rt + rl);
            const f32x4 xv = *(const GAS f32x4*)(x + row * 1024 + 128 * wave + 4 * c4);
            f32x4 t = *(const LAS f32x4*)(tr + rl * 132 + 4 * c4); t = t * (NREP(41) == 2 ? 0.5f : 1.0f) + xv; v[rt][i] = t;
            const float ss = half_sum((t[0] * t[0] + t[1] * t[1]) + (t[2] * t[2] + t[3] * t[3]));
            if (c4 == 0) red[(32 * rt + rl) * 8 + wave] = ss; }
        LDS_WAIT(); asm volatile("" ::: "memory");
    }
    __syncthreads();
    if (tid < 64) { float q = 0.f;
#pragma unroll
        for (int w = 0; w < 8; ++w) q += red[tid * 8 + w];
        ((LAS float*)(lds + FO_RS))[tid] = 1.0f / sqrtf(q * (1.0f / 1024.0f) + EPS); }
    __syncthreads();
    const f32x4 gv = *(const GAS f32x4*)(fng + 128 * wave + 4 * c4);
#pragma unroll
    for (int rt = 0; rt < 2; ++rt)
#pragma unroll
        for (int i = 0; i < 16; ++i) { const int rl = 32 * rt + 2 * i + rsel; const float rs = ((const LAS float*)(lds + FO_RS))[rl];
            *(GAS f32x4*)(out + (size_t)(t0 + rl) * 1024 + 128 * wave + 4 * c4) = v[rt][i] * rs * gv; }
    __syncthreads();
}


struct Args { const float* in[12]; float* out; unsigned char* ws; int ph_lo, ph_hi, li, pad; };
__global__ void __launch_bounds__(NWAVES * 64, 2) hymba_fwd(Args args) {
    extern __shared__ __attribute__((aligned(16))) unsigned char lds_raw[];
    LAS unsigned char* lds = (LAS unsigned char*)lds_raw;
    volatile LAS unsigned* MISC = (volatile LAS unsigned*)(lds + MISC_OFF);
    const int tid = threadIdx.x, lane = tid & 63, wave = __builtin_amdgcn_readfirstlane(tid >> 6);
    const int G = gridDim.x; const int bx = blockIdx.x; const int vcu = (G % 8 == 0) ? (bx % 8) * (G / 8) + bx / 8 : bx;
    unsigned char* ws = args.ws; gu32* ctl = (gu32*)(ws + WS_CTL);
    const float* x = args.in[0]; const float* mem = args.in[1]; const float* norm_g = args.in[2]; const float* w_in = args.in[3]; const float* w_up = args.in[4]; const float* b_alpha = args.in[5];
    const float* b_forget = args.in[6]; const float* gla_norm_g = args.in[7]; const float* mem_norm_g = args.in[8]; const float* w_mem_kv = args.in[9]; const float* w_out = args.in[10]; const float* final_norm_g = args.in[11];
    for (int u = tid; u < (LDS_BYTES - LDSCTL_OFF) / 4; u += NWAVES * 64) ((LAS unsigned*)(lds + LDSCTL_OFF))[u] = 0u;
    __syncthreads();
    XcdBarrier bar; bar.bar = (unsigned*)(ctl + CW_BAR); bar.x = 0; bar.st = nullptr;
    if (N_LAUNCHES != PER_PHASE) bar = xcd_barrier_post((unsigned*)(ctl + CW_BAR), MISC + 8);
#define GRID_BAR(seam) do { if (N_LAUNCHES == PER_PHASE) { if (tid == 0) __hip_atomic_store(ctl + CW_TMO, 0xBADBA0u | (unsigned)(seam), RLX_AGENT); } else { xcd_barrier(bar); } } while (0)
    const int lo = args.ph_lo, hi = args.ph_hi;
#define IN(k) (lo <= (k) && (k) < hi)
#define BOTH(k) (IN(k) && IN((k) + 1))

    if (IN(0)) { for (int rp = 0; rp < NREP(0); ++rp) p0_prologue(lds, vcu, G, tid, wave, lane, x, mem, norm_g, w_in, mem_norm_g, w_mem_kv, w_out, ws); if (BOTH(0)) GRID_BAR(0); }

    if (PROBE_DUP == 9) { for (int rb = 0; rb < 4; ++rb) GRID_BAR(9); }
    if (IN(1)) {
        for (int rp = 0; rp < NREP(1); ++rp) {
        { pg8::Gemm g{(const pg8::bf16_t*)(ws + WS_XN), (const pg8::bf16_t*)(ws + WS_WIN), M, NP, D}; pg8::StaticOrder S; S.init(M, NP, G, (int)blockIdx.x);
          pg8::EpiRoute E{ws, attn_body::C2};
          pg8::gemm_phase<pg8::EpiRoute, pg8::StaticOrder, true, true>(lds + RING_OFF, g, S, E); }
        }
        if (BOTH(1)) GRID_BAR(1);
    }

    if (IN(2)) {
        for (int rp = 0; rp < NREP(2); ++rp) {
        for (int n = vcu; n < 256; n += G) p2_chunk_item(lds, n, tid, wave, lane, ws, ctl, w_up, b_alpha, b_forget);
        }
        if (BOTH(2)) GRID_BAR(2);
    }

    if (IN(3)) {
        {
          LAS float* offt = (LAS float*)(lds + OFFT_OFF);
          float v[6];
          if (tid < 256) {
#pragma unroll
              for (int h = 0; h < 6; ++h) v[h] = ((const float*)(ws + WS_TOT))[h * 256 + tid];
#pragma unroll
              for (int d = 1; d < 64; d <<= 1) {
#pragma unroll
                  for (int h = 0; h < 6; ++h) { const float o = __shfl_up(v[h], d); if (lane >= d) v[h] += o; } }
              if (lane == 63) {
#pragma unroll
                  for (int h = 0; h < 6; ++h) ((LAS float*)(lds + RING_OFF))[h * 4 + wave] = v[h]; } }
          __syncthreads();
          if (tid < 256) {
#pragma unroll
              for (int h = 0; h < 6; ++h) { float add = 0.f; for (int w = 0; w < wave; ++w) add += ((LAS float*)(lds + RING_OFF))[h * 4 + w]; offt[h * OFFT_ROW + tid + 1] = v[h] + add; }
              offt[6 * OFFT_ROW + tid] = 0.f; if (tid < 7) offt[tid * OFFT_ROW + (tid == 6 ? 256 : 0)] = 0.f; }
          __syncthreads(); }
        for (int rp = 0; rp < NREP(3); ++rp)
        for (;;) {
            __syncthreads();
            if (tid == 0) { MISC[16] = __hip_atomic_fetch_add(ctl + CW_Q3 + 32 * rp, 1u, RLX_AGENT); MISC[17] = 0xffffu; }
            __syncthreads();
            const int it = (int)MISC[16];
            if (it >= 36 + 384 + 256) break;
            if (it < 36) { gla_scan_item(it, tid, ws); continue; }
            int q0, NT, qoff, pitch; size_t oq, ok, ov, og; int ocol; const float* cfl; float cref; const LAS float* offp;
            if (it < 36 + 384) { const int i = it - 36, qb = 63 - i / 6, h = i % 6; q0 = 256 * qb; NT = 4 * qb + 4; qoff = 0; pitch = 384;
                oq = WS_FQ + h * 128; ok = WS_FK + h * 128; ov = WS_FV + h * 128; og = WS_FG + h * 128; ocol = 384 + h * 64; cfl = (const float*)(ws + WS_CFL) + (size_t)h * M;
                const LAS float* offt = (const LAS float*)(lds + OFFT_OFF) + h * OFFT_ROW;
                cref = cfl[q0] + offt[4 * qb];
                const float b2 = 2.f * sqrtf(__uint_as_float(ctl[CW_NMAX + h]) * __uint_as_float(ctl[CW_NMAX + 6 + h])) + 1.0f;
                int cand = NT - 4; if (tid < NT - 4 && b2 + cref - offt[tid + 1] >= -ACP_THRESH) cand = tid;
#pragma unroll
                for (int o = 1; o < 64; o <<= 1) { const int t = __shfl_xor(cand, o); cand = t < cand ? t : cand; }
                if (lane == 0) __hip_atomic_fetch_min((LAS unsigned*)(lds + MISC_OFF) + 17, (unsigned)cand, __ATOMIC_RELAXED, __HIP_MEMORY_SCOPE_WORKGROUP);
                __syncthreads();
                const int t_lo = (int)MISC[17] & ~1;
                NT -= t_lo; ok += (size_t)t_lo * 64 * 384 * 2; ov += (size_t)t_lo * 64 * 384 * 2; cfl += t_lo * 64; offp = offt + t_lo; }
            else { const int i = it - 36 - 384, qb = i >> 2, h = i & 3; q0 = 256 * qb; NT = 4; qoff = 1 << 24; pitch = 256;
                oq = WS_MQ + h * 128; ok = WS_MK + h * 128; ov = WS_MV + h * 128; og = WS_MG + h * 128; ocol = 768 + h * 64; cfl = (const float*)(ws + WS_ZERO); cref = 0.f; offp = (const LAS float*)(lds + OFFT_OFF) + 6 * OFFT_ROW; }
            attn_body::attn_unit<8, 1024, true, true>(q0, NT, qoff, pitch, pitch, pitch, (const attn_body::bf16*)(ws + oq), (const attn_body::bf16*)(ws + ok), (const attn_body::bf16*)(ws + ov),
                (const attn_body::bf16*)(ws + og), (attn_body::bf16*)(ws + WS_MIX) + ocol, cfl, offp, cref, (char*)lds_raw + RING_OFF);
        }
        if (BOTH(3)) GRID_BAR(3);
    }

    if (IN(4)) {
        for (int rp = 0; rp < NREP(4); ++rp)
        for (int n = vcu; n < 256; n += G) fused_out_item(lds, n, tid, wave, lane, ws, x, gla_norm_g, final_norm_g, args.out);
    }
#undef IN
#undef BOTH
}

extern "C" void kernel_launch(void* const* d_in, const int* in_sizes, int n_in, void* d_out, int out_size, void* d_ws, size_t ws_size, hipStream_t stream) {
    static int grid = 0;
    if (grid == 0) {
        if (n_in != 12 || in_sizes[0] != M * D || out_size != M * D || ws_size < WS_END) { fprintf(stderr, "kernel_launch: unexpected shapes (n_in %d, in0 %d, out %d, ws %zu); nothing launched\n", n_in, n_in > 0 ? in_sizes[0] : -1, out_size, ws_size); grid = -1; return; }
        int dev = 0, cus = 0, per_cu = 0;
        if (hipGetDevice(&dev) != hipSuccess || hipDeviceGetAttribute(&cus, hipDeviceAttributeMultiprocessorCount, dev) != hipSuccess) { fprintf(stderr, "kernel_launch: device query failed\n"); grid = -1; return; }
        if (hipFuncSetAttribute((const void*)hymba_fwd, hipFuncAttributeMaxDynamicSharedMemorySize, LDS_BYTES) != hipSuccess) { fprintf(stderr, "kernel_launch: hipFuncSetAttribute failed\n"); grid = -1; return; }
        if (hipOccupancyMaxActiveBlocksPerMultiprocessor(&per_cu, (const void*)hymba_fwd, NWAVES * 64, LDS_BYTES) != hipSuccess || per_cu < 1) { fprintf(stderr, "kernel_launch: occupancy query reports %d workgroups per CU; nothing launched\n", per_cu); (void)hipGetLastError(); grid = -1; return; }
        grid = cus;
        if (grid != 256) fprintf(stderr, "kernel_launch: launching %d workgroups; the fused final phase needs exactly 256\n", grid);
    }
    if (grid < 0) return;
    if (hipMemsetAsync((char*)d_ws + WS_CTL, 0, CTL_ZERO_BYTES, stream) != hipSuccess) { fprintf(stderr, "kernel_launch: hipMemsetAsync failed\n"); return; }
    Args a{};
    for (int i = 0; i < 12; ++i) a.in[i] = (const float*)d_in[i];
    a.out = (float*)d_out; a.ws = (unsigned char*)d_ws;
    for (int li = 0; li < N_LAUNCHES; ++li) {
        a.ph_lo = (N_LAUNCHES == PER_PHASE) ? li : 0; a.ph_hi = (N_LAUNCHES == PER_PHASE) ? li + 1 : PER_PHASE; a.li = li;
        hipLaunchKernelGGL(hymba_fwd, dim3(grid), dim3(NWAVES * 64), LDS_BYTES, stream, a);
        const hipError_t le = hipPeekAtLastError();
        if (le != hipSuccess) { fprintf(stderr, "kernel_launch: launch %d failed: %s\n", li, hipGetErrorName(le)); break; }
    }
}
```

```cpp
#include <hip/hip_runtime.h>
#include <cstdio>
#include <cstdint>
namespace pg8 {
#define PG8_LAS __attribute__((address_space(3)))
typedef unsigned short bf16_t;
typedef short bf16x8 __attribute__((ext_vector_type(8)));
typedef float f32x4 __attribute__((ext_vector_type(4)));
typedef unsigned u32x4 __attribute__((ext_vector_type(4)));
constexpr int BM = 256, BK = 64, HALF = 128, HTB = HALF * BK * 2  , STAGE_BYTES = 8 * HTB, NXCD = 8, WGM = 8;

__host__ __device__ __forceinline__ int lds_byte(int r, int c) { const int st = (r >> 4) * 2 + (c >> 5), rr = r & 15, cc = c & 31, ob = rr * 64 + cc * 2; return st * 1024 + (ob ^ (((ob >> 9) & 1) << 5)); }
__host__ __device__ __forceinline__ void stage_rc(int b, int& R, int& C) { const int st = b / 1024, sb = b % 1024, swz = sb ^ (((sb >> 9) & 1) << 5); R = (st >> 1) * 16 + swz / 64; C = (st & 1) * 32 + (swz % 64) / 2; }
__host__ __device__ __forceinline__ int perm32(int rho) { const int n = rho >> 4, i = rho & 15; return 8 * (i >> 2) + 4 * n + (i & 3); }

struct Unit { int pm, pn; };
struct Gemm { const bf16_t* A; const bf16_t* Bt; int M, N, K; };

struct StaticOrder {
    int nM, nN, nwg, G, c;
    __host__ __device__ void init(int M, int N, int G_, int c_) { nM = M / BM; nN = N / BM; nwg = nM * nN; G = G_; c = c_; }
    __host__ __device__ bool next(int i, Unit& u) const {
        const long L = (long)i * G + c; if (L >= nwg) return false;
        int wgid = (int)L; { const int q = nwg / NXCD, r = nwg % NXCD, xcd = wgid % NXCD, off = wgid / NXCD; wgid = (xcd < r ? xcd * (q + 1) : r * (q + 1) + (xcd - r) * q) + off; }
        const int nig = WGM * nN, gid = wgid / nig, fm = gid * WGM, gsz = (nM - fm) < WGM ? (nM - fm) : WGM;
        u.pm = fm + ((wgid % nig) % gsz); u.pn = (wgid % nig) / gsz; return true;
    }
    __device__ __forceinline__ void a_ready(const Unit&) const {}
    __device__ __forceinline__ void done(const Unit&) const {}
};


__device__ __forceinline__ unsigned cvt_pk_bf16(float lo, float hi) { unsigned r; asm volatile("v_cvt_pk_bf16_f32 %0, %1, %2" : "=v"(r) : "v"(lo), "v"(hi)); return r; }
typedef float f32x2 __attribute__((ext_vector_type(2)));

struct EpiBf16 {
    static constexpr bool PERM = true, AFTER_DRAIN = false;
    bf16_t* O; int ldc; int split_cols; size_t split_stride;
    __device__ __forceinline__ void operator()(const f32x4 (&acc)[2][2][4][2], const Unit& u, int wr, int wc, int fr, int fq) const {
        const int row0 = u.pm * BM + wr * 64 + fr; int colt = u.pn * BM; bf16_t* base = O;
        if (split_cols) { const int t = colt / split_cols; base += (size_t)t * split_stride; colt -= t * split_cols; }
        const int col0 = colt + wc * 32 + 8 * fq;
#pragma unroll
        for (int ai = 0; ai < 2; ++ai)
#pragma unroll
            for (int m = 0; m < 4; ++m) { bf16_t* rowp = base + (size_t)(row0 + ai * HALF + m * 16) * ldc + col0;
#pragma unroll
                for (int bj = 0; bj < 2; ++bj) { const f32x4 v0 = acc[ai][bj][m][0], v1 = acc[ai][bj][m][1];
                    u32x4 w; w.x = cvt_pk_bf16(v0[0], v0[1]); w.y = cvt_pk_bf16(v0[2], v0[3]); w.z = cvt_pk_bf16(v1[0], v1[1]); w.w = cvt_pk_bf16(v1[2], v1[3]);
                    *(u32x4*)(rowp + bj * HALF) = w; } }
    }
};

struct RouteTab { unsigned char* ws; };
struct Route { bf16_t* base; int pitch, col, mode; };
struct EpiRoute {
    static constexpr bool PERM = true, AFTER_DRAIN = false;
    unsigned char* ws; float qscale;
    __device__ __forceinline__ Route route(int g32) const;
    __device__ __forceinline__ void operator()(const f32x4 (&acc)[2][2][4][2], const Unit& u, int wr, int wc, int fr, int fq) const {
        const int row0 = u.pm * BM + wr * 64 + fr;
#pragma unroll
        for (int bj = 0; bj < 2; ++bj) {
            const Route R = route(8 * u.pn + 4 * bj + wc);
            if (R.mode == 4) continue;
            if (R.mode == 3) {
                float* glr = (float*)R.base; float* ffg = glr + (size_t)16384 * 16;
#pragma unroll
                for (int ai = 0; ai < 2; ++ai)
#pragma unroll
                    for (int m = 0; m < 4; ++m) { const size_t row = (size_t)(row0 + ai * HALF + m * 16);
                        const f32x4 v0 = acc[ai][bj][m][0], v1 = acc[ai][bj][m][1];
                        if (fq < 2) { *(f32x4*)(glr + row * 16 + 8 * fq) = v0; *(f32x4*)(glr + row * 16 + 8 * fq + 4) = v1; }
                        else if (fq == 2) { *(f32x4*)(ffg + row * 8) = v0; *(f32x4*)(ffg + row * 8 + 4) = v1; } }
                continue;
            }
            const float sc = R.mode == 1 ? qscale : 1.f;
#pragma unroll
            for (int ai = 0; ai < 2; ++ai)
#pragma unroll
                for (int m = 0; m < 4; ++m) { bf16_t* rowp = R.base + (size_t)(row0 + ai * HALF + m * 16) * R.pitch + R.col + 8 * fq;
                    f32x4 v0 = acc[ai][bj][m][0], v1 = acc[ai][bj][m][1];
                    if (R.mode == 2) {
#pragma unroll
                        for (int e = 0; e < 4; ++e) { v0[e] = v0[e] * __builtin_amdgcn_rcpf(1.f + __builtin_amdgcn_exp2f(-1.4426950408889634f * v0[e])); v1[e] = v1[e] * __builtin_amdgcn_rcpf(1.f + __builtin_amdgcn_exp2f(-1.4426950408889634f * v1[e])); }
                    } else { v0 = v0 * sc; v1 = v1 * sc; }
                    u32x4 w; w.x = cvt_pk_bf16(v0[0], v0[1]); w.y = cvt_pk_bf16(v0[2], v0[3]); w.z = cvt_pk_bf16(v1[0], v1[1]); w.w = cvt_pk_bf16(v1[2], v1[3]);
                    asm volatile("global_store_dwordx4 %0, %1, off sc0 sc1\n\ts_nop 1" :: "v"(rowp), "v"(w) : "memory"); }
        }
    }
};

struct PanelSumSq {
    unsigned* xbuf;
    unsigned* cnt;
    unsigned* tmo;
    float eps; unsigned code;
    __device__ __forceinline__ bool run(const f32x4 (&v)[2][2][4][2], const Unit& u, int wr, int wc, int fr, int fq, PG8_LAS unsigned char* lds, int wid, int lane) const {
        PG8_LAS float* P = (PG8_LAS float*)lds;
        PG8_LAS float* S = (PG8_LAS float*)(lds + 8192);
        PG8_LAS unsigned* flag = (PG8_LAS unsigned*)(lds + 8192 + 2048);
#pragma unroll
        for (int ai = 0; ai < 2; ++ai)
#pragma unroll
            for (int m = 0; m < 4; ++m) {
                float q = 0.f;
#pragma unroll
                for (int bj = 0; bj < 2; ++bj)
#pragma unroll
                    for (int n = 0; n < 2; ++n) { const f32x4 d = v[ai][bj][m][n]; q += (d[0] * d[0] + d[1] * d[1]) + (d[2] * d[2] + d[3] * d[3]); }
                q += __shfl_xor(q, 16); q += __shfl_xor(q, 32);
                if (fq == 0) P[(ai * HALF + wr * 64 + m * 16 + fr) * 4 + wc] = q;
            }
        asm volatile("s_waitcnt lgkmcnt(0)" ::: "memory"); __builtin_amdgcn_s_barrier(); asm volatile("" ::: "memory");
        const int row = wid * 32 + (lane & 31);
        if (lane < 32) {
            const float q = (P[row * 4 + 0] + P[row * 4 + 1]) + (P[row * 4 + 2] + P[row * 4 + 3]);
            unsigned* slot = xbuf + ((size_t)(u.pm * BM + row) * 4 + u.pn);
            __hip_atomic_store(slot, __float_as_uint(q), __ATOMIC_RELAXED, __HIP_MEMORY_SCOPE_AGENT);
        }
        asm volatile("s_waitcnt vmcnt(0)" ::: "memory");
        if (lane == 0) __hip_atomic_fetch_add(cnt + 64 * u.pm, 1u, __ATOMIC_RELAXED, __HIP_MEMORY_SCOPE_AGENT);
        if (wid == 0) {
            bool dead = false; const unsigned long long t0 = __builtin_amdgcn_s_memrealtime(); const unsigned want = 8u * 4u;
            for (;;) {
                if ((unsigned)__builtin_amdgcn_readfirstlane(__hip_atomic_load(cnt + 64 * u.pm, __ATOMIC_RELAXED, __HIP_MEMORY_SCOPE_AGENT)) >= want) break;
                if (__builtin_amdgcn_s_memrealtime() - t0 > 2000000ull) {
                    if (lane == 0) { unsigned expect = 0u; __hip_atomic_compare_exchange_strong(tmo + 1, &expect, code | (unsigned)(u.pm & 0xff), __ATOMIC_RELAXED, __ATOMIC_RELAXED, __HIP_MEMORY_SCOPE_AGENT);
                                     __hip_atomic_store(tmo, 1u, __ATOMIC_RELAXED, __HIP_MEMORY_SCOPE_AGENT); }
                    dead = true; break; }
                __builtin_amdgcn_s_sleep(2);
            }
            __builtin_amdgcn_fence(__ATOMIC_ACQUIRE, "agent");
            if (lane == 0) flag[0] = dead ? 1u : 0u;
        }
        asm volatile("s_waitcnt vmcnt(0) lgkmcnt(0)" ::: "memory"); __builtin_amdgcn_s_barrier(); asm volatile("" ::: "memory");
        const bool bad = flag[0] != 0u;
        if (lane < 32) {
            const unsigned* slot = xbuf + (size_t)(u.pm * BM + row) * 4; float q = 0.f;
#pragma unroll
            for (int t = 0; t < 4; ++t) q += __uint_as_float(__hip_atomic_load(slot + t, __ATOMIC_RELAXED, __HIP_MEMORY_SCOPE_AGENT));
            S[row] = 1.0f / sqrtf(q * (1.0f / 1024.0f) + eps);
        }
        asm volatile("s_waitcnt lgkmcnt(0)" ::: "memory"); __builtin_amdgcn_s_barrier(); asm volatile("" ::: "memory");
        return bad;
    }
};
struct EpiNormRes {
    static constexpr bool PERM = false, AFTER_DRAIN = true;
    const float* base; float* out; int ldc; const float* gain; PanelSumSq st; unsigned poison;
    __device__ __forceinline__ void fused(f32x4 (&acc)[2][2][4][2], const Unit& u, int wr, int wc, int fr, int fq, PG8_LAS unsigned char* lds, int wid, int lane) const {
        const PG8_LAS float* S = (const PG8_LAS float*)(lds + 8192);
        const int col0 = u.pn * BM + wc * 32 + 4 * fq;
#pragma unroll
        for (int ai = 0; ai < 2; ++ai)
#pragma unroll
            for (int m = 0; m < 4; ++m) { const size_t off = (size_t)(u.pm * BM + ai * HALF + wr * 64 + m * 16 + fr) * ldc + col0;
#pragma unroll
                for (int bj = 0; bj < 2; ++bj)
#pragma unroll
                    for (int n = 0; n < 2; ++n) acc[ai][bj][m][n] += *(const f32x4*)(base + off + bj * HALF + n * 16);
                asm volatile("" : "+v"(acc[ai][0][m][0]), "+v"(acc[ai][0][m][1]), "+v"(acc[ai][1][m][0]), "+v"(acc[ai][1][m][1]));
                if (m & 1) asm volatile("" ::: "memory"); }
        const bool bad = st.run(acc, u, wr, wc, fr, fq, lds, wid, lane) || poison != 0u;
        const float qnan = __builtin_nanf("");
        f32x4 gv[2][2];
#pragma unroll
        for (int bj = 0; bj < 2; ++bj)
#pragma unroll
            for (int n = 0; n < 2; ++n) gv[bj][n] = *(const f32x4*)(gain + col0 + bj * HALF + n * 16);
#pragma unroll
        for (int ai = 0; ai < 2; ++ai)
#pragma unroll
            for (int m = 0; m < 4; ++m) { const int r = ai * HALF + wr * 64 + m * 16 + fr; const float sr = S[r]; const size_t off = (size_t)(u.pm * BM + r) * ldc + col0;
#pragma unroll
                for (int bj = 0; bj < 2; ++bj)
#pragma unroll
                    for (int n = 0; n < 2; ++n) { f32x4 o = acc[ai][bj][m][n] * sr * gv[bj][n];
                        if (bad) o = (f32x4){qnan, qnan, qnan, qnan}; *(f32x4*)(out + off + bj * HALF + n * 16) = o; } }
    }
};

template <class Epi, class Sched, bool ALIGN_EPI = false, bool SP2 = false>
__device__ __forceinline__ void gemm_phase(PG8_LAS unsigned char* lds, const Gemm g, const Sched& S, const Epi& E) {
    const int tid = threadIdx.x, wid = __builtin_amdgcn_readfirstlane(tid >> 6), lane = tid & 63, wr = wid >> 2, wc = wid & 3, fr = lane & 15, fq = lane >> 4;
    const int K = g.K, nt = K / BK;
    unsigned voffA[2], voffB[2];
#pragma unroll
    for (int i = 0; i < 2; ++i) { int R, C; stage_rc(tid * 16 + i * 8192, R, C); const int Rb = Epi::PERM ? ((R & ~31) + perm32(R & 31)) : R;
        voffA[i] = (unsigned)(R * K + C) * 2u; voffB[i] = (unsigned)(Rb * K + C) * 2u; }
    const size_t kstep = (size_t)(BK * 2);
    const size_t hstep = (size_t)HALF * K * 2;
    const size_t tstep = 2 * hstep;
    const unsigned ldsw = (unsigned)wid * 1024u;
    const int aoff = lds_byte(wr * 64 + fr, fq * 8), boff = lds_byte(wc * 32 + fr, fq * 8);
#define PG8_SA(b, h) (((b) * 2 + (h)) * HTB)
#define PG8_SB(b, h) ((4 + (b) * 2 + (h)) * HTB)
#define PG8_STAGE(bufoff, gbase, voff) do { _Pragma("unroll") for (int _i = 0; _i < 2; ++_i) \
        __builtin_amdgcn_global_load_lds((const unsigned*)((const char*)(gbase) + (voff)[_i]), (PG8_LAS unsigned*)(lds + (bufoff) + ldsw + _i * 8192), 16, 0, 0); } while (0)
#define PG8_LDA(dst, b, h) do { _Pragma("unroll") for (int m = 0; m < 4; ++m) _Pragma("unroll") for (int k = 0; k < 2; ++k) dst[m][k] = *(const PG8_LAS bf16x8*)(lds + PG8_SA(b, h) + aoff + m * 2048 + k * 1024); } while (0)
#define PG8_LDB(dst, b, h) do { _Pragma("unroll") for (int n = 0; n < 2; ++n) _Pragma("unroll") for (int k = 0; k < 2; ++k) dst[n][k] = *(const PG8_LAS bf16x8*)(lds + PG8_SB(b, h) + boff + n * 2048 + k * 1024); } while (0)
#define PG8_MMA(ai, bj, At, Bt) do { __builtin_amdgcn_s_setprio(1); _Pragma("unroll") for (int m = 0; m < 4; ++m) _Pragma("unroll") for (int n = 0; n < 2; ++n) _Pragma("unroll") for (int k = 0; k < 2; ++k) \
        acc[ai][bj][m][n] = __builtin_amdgcn_mfma_f32_16x16x32_bf16(Bt[n][k], At[m][k], acc[ai][bj][m][n], 0, 0, 0); __builtin_amdgcn_s_setprio(0); } while (0)
#define PG8_WAIT_V(n) asm volatile("s_waitcnt vmcnt(" #n ")" ::: "memory")
#define PG8_WAIT_L(n) asm volatile("s_waitcnt lgkmcnt(" #n ")" ::: "memory")
#define PG8_BAR __builtin_amdgcn_s_barrier()
#define PG8_SCHED __builtin_amdgcn_sched_barrier(0)
    Unit cur, nxt; int ui = 0;
    if (!S.next(0, cur)) return;
    f32x4 acc[2][2][4][2];
#pragma unroll
    for (int a = 0; a < 2; ++a)
#pragma unroll
        for (int b = 0; b < 2; ++b)
#pragma unroll
            for (int m = 0; m < 4; ++m)
#pragma unroll
                for (int n = 0; n < 2; ++n) acc[a][b][m][n] = (f32x4){0.f, 0.f, 0.f, 0.f};
    bf16x8 At[4][2], B0[2][2], B1[2][2];
    const char* cA = (const char*)g.A + (size_t)cur.pm * tstep; const char* cB = (const char*)g.Bt + (size_t)cur.pn * tstep;
    S.a_ready(cur);
    if constexpr (SP2) {
        PG8_STAGE(PG8_SB(0, 0), cB, voffB); PG8_STAGE(PG8_SB(0, 1), cB + hstep, voffB); PG8_STAGE(PG8_SA(0, 0), cA, voffA); PG8_STAGE(PG8_SA(0, 1), cA + hstep, voffA);
        if (wr == 1) PG8_BAR;
        PG8_WAIT_V(2); PG8_BAR;
        PG8_STAGE(PG8_SB(1, 0), cB + kstep, voffB); PG8_STAGE(PG8_SA(1, 0), cA + kstep, voffA); PG8_STAGE(PG8_SB(1, 1), cB + hstep + kstep, voffB);
        PG8_WAIT_V(6); PG8_BAR;
    } else {
        PG8_STAGE(PG8_SB(0, 0), cB, voffB); PG8_STAGE(PG8_SA(0, 0), cA, voffA); PG8_STAGE(PG8_SB(0, 1), cB + hstep, voffB); PG8_STAGE(PG8_SA(0, 1), cA + hstep, voffA);
        if (wr == 1) PG8_BAR;
        PG8_WAIT_V(4); PG8_BAR;
        PG8_STAGE(PG8_SB(1, 0), cB + kstep, voffB); PG8_STAGE(PG8_SA(1, 0), cA + kstep, voffA); PG8_STAGE(PG8_SB(1, 1), cB + hstep + kstep, voffB);
        PG8_WAIT_V(6); PG8_BAR;
    }
    for (;;) {
        const bool has_next = S.next(ui + 1, nxt);
        const char* nA = has_next ? (const char*)g.A + (size_t)nxt.pm * tstep : cA; const char* nB = has_next ? (const char*)g.Bt + (size_t)nxt.pn * tstep : cB;
        for (int t = 0; t < nt; t += 2) {
            const bool last = (t == nt - 2);
            const char* a1 = cA + (size_t)(t + 1) * kstep;
            const char* a2 = last ? nA : cA + (size_t)(t + 2) * kstep; const char* b2 = last ? nB : cB + (size_t)(t + 2) * kstep;
            const char* a3 = a2 + kstep; const char* b3 = b2 + kstep;
            if (last && has_next) S.a_ready(nxt);
            if constexpr (SP2) {
            PG8_LDB(B0, 0, 0); PG8_LDB(B1, 0, 1); PG8_SCHED; PG8_LDA(At, 0, 0); PG8_STAGE(PG8_SA(1, 1), a1 + hstep, voffA);
            PG8_WAIT_V(8); PG8_WAIT_L(0); PG8_BAR; PG8_MMA(0, 0, At, B0); PG8_MMA(0, 1, At, B1); PG8_BAR; PG8_SCHED;
            PG8_LDA(At, 0, 1); PG8_STAGE(PG8_SB(0, 0), b2, voffB); PG8_STAGE(PG8_SB(0, 1), b2 + hstep, voffB); PG8_STAGE(PG8_SA(0, 0), a2, voffA);
            PG8_WAIT_V(8); PG8_WAIT_L(0); PG8_BAR; PG8_MMA(1, 0, At, B0); PG8_MMA(1, 1, At, B1); PG8_BAR; PG8_SCHED;
            PG8_LDB(B0, 1, 0); PG8_LDB(B1, 1, 1); PG8_SCHED; PG8_LDA(At, 1, 0); PG8_STAGE(PG8_SA(0, 1), a2 + hstep, voffA);
            PG8_WAIT_V(8); PG8_WAIT_L(0); PG8_BAR; PG8_MMA(0, 0, At, B0); PG8_MMA(0, 1, At, B1); PG8_BAR; PG8_SCHED;
            PG8_LDA(At, 1, 1); PG8_STAGE(PG8_SB(1, 0), b3, voffB); PG8_STAGE(PG8_SB(1, 1), b3 + hstep, voffB); PG8_STAGE(PG8_SA(1, 0), a3, voffA);
            PG8_WAIT_V(8); PG8_WAIT_L(0); PG8_BAR; PG8_MMA(1, 0, At, B0); PG8_MMA(1, 1, At, B1); PG8_BAR; PG8_SCHED;
            } else {
            PG8_LDB(B0, 0, 0); PG8_SCHED; PG8_LDA(At, 0, 0); PG8_STAGE(PG8_SA(1, 1), a1 + hstep, voffA);
            PG8_WAIT_L(8); PG8_BAR; PG8_WAIT_L(0); PG8_MMA(0, 0, At, B0); PG8_BAR; PG8_SCHED;
            PG8_LDB(B1, 0, 1); PG8_STAGE(PG8_SB(0, 0), b2, voffB);
            PG8_BAR; PG8_WAIT_L(0); PG8_MMA(0, 1, At, B1); PG8_BAR;
            PG8_LDA(At, 0, 1); PG8_STAGE(PG8_SA(0, 0), a2, voffA);
            PG8_BAR; PG8_WAIT_L(0); PG8_MMA(1, 0, At, B0); PG8_BAR; PG8_SCHED;
            PG8_STAGE(PG8_SB(0, 1), b2 + hstep, voffB);
            PG8_WAIT_V(6); PG8_BAR; PG8_MMA(1, 1, At, B1); PG8_BAR;
            PG8_LDB(B0, 1, 0); PG8_SCHED; PG8_LDA(At, 1, 0); PG8_STAGE(PG8_SA(0, 1), a2 + hstep, voffA);
            PG8_WAIT_L(8); PG8_BAR; PG8_WAIT_L(0); PG8_MMA(0, 0, At, B0); PG8_BAR; PG8_SCHED;
            PG8_LDB(B1, 1, 1); PG8_STAGE(PG8_SB(1, 0), b3, voffB);
            PG8_BAR; PG8_WAIT_L(0); PG8_MMA(0, 1, At, B1); PG8_BAR;
            PG8_LDA(At, 1, 1); PG8_STAGE(PG8_SA(1, 0), a3, voffA);
            PG8_BAR; PG8_WAIT_L(0); PG8_MMA(1, 0, At, B0); PG8_BAR; PG8_SCHED;
            PG8_STAGE(PG8_SB(1, 1), b3 + hstep, voffB);
            PG8_WAIT_V(6); PG8_BAR; PG8_MMA(1, 1, At, B1); PG8_BAR;
            }
        }
        if constexpr (ALIGN_EPI) { if (wr == 0) PG8_BAR; }
        if constexpr (!Epi::AFTER_DRAIN) { E(acc, cur, wr, wc, fr, fq); S.done(cur); }
        if (!has_next) break;
#pragma unroll
        for (int a = 0; a < 2; ++a)
#pragma unroll
            for (int b = 0; b < 2; ++b)
#pragma unroll
                for (int m = 0; m < 4; ++m)
#pragma unroll
                    for (int n = 0; n < 2; ++n) acc[a][b][m][n] = (f32x4){0.f, 0.f, 0.f, 0.f};
        cur = nxt; cA = nA; cB = nB; ++ui;
        if constexpr (ALIGN_EPI) { if (wr == 1) PG8_BAR; }
    }
    PG8_WAIT_V(0);
    if constexpr (!ALIGN_EPI) { if (wr == 0) PG8_BAR; }
    PG8_BAR;
    if constexpr (Epi::AFTER_DRAIN) { E.fused(acc, cur, wr, wc, fr, fq, lds, wid, lane); S.done(cur); }
#undef PG8_SA
#undef PG8_SB
#undef PG8_STAGE
#undef PG8_LDA
#undef PG8_LDB
#undef PG8_MMA
#undef PG8_WAIT_V
#undef PG8_WAIT_L
#undef PG8_BAR
#undef PG8_SCHED
}
}

#include <hip/hip_bf16.h>
#include <cmath>
namespace attn_body {
using bf16=__hip_bfloat16;
using bf16x8=__attribute__((ext_vector_type(8)))short;
using s16x4=__attribute__((ext_vector_type(4)))short;
using f32x16=__attribute__((ext_vector_type(16)))float;
using u32x4=__attribute__((ext_vector_type(4)))unsigned;
using f32x4_t=__attribute__((ext_vector_type(4)))float;
constexpr int D=64;
constexpr int NW=8,QBLK=32,QB=QBLK*NW,KVBLK=64;
constexpr int ATTN_UNIT_ROWS=QB;
__device__ __forceinline__ int crow(int r,int hi){return (r&3)+8*(r>>2)+4*hi;}
#define SBAR() __builtin_amdgcn_sched_barrier(0)
__device__ __forceinline__ void cmask(f32x16&p0,f32x16&p1,int jb,int qrel,int hi){
  const float NEG=-INFINITY; int kb=64*jb+4*hi;
  #pragma unroll
  for(int r=0;r<16;++r){int kv=kb+(r&3)+8*(r>>2); if(kv>qrel)p0[r]=NEG; if(kv+32>qrel)p1[r]=NEG;}
}

constexpr int NSLOT=3, SLOTB=8192;
constexpr int LDS_K=0, LDS_V=NSLOT*SLOTB, LDS_WS=2*NSLOT*SLOTB, LDS_OST=LDS_WS+NW*64*4, LDS_BIAS=LDS_OST+NW*4096, MAXKEYS=16384, LDS_BYTES=LDS_BIAS+MAXKEYS*4;
constexpr float C2=0.125f*1.4426950408889634f;
__device__ __forceinline__ void glds16(const void*gsrc,unsigned lds_dst){unsigned keep;
  asm volatile("s_mov_b32 %0, m0\n\ts_mov_b32 m0, %2\n\ts_nop 0\n\tglobal_load_lds_dwordx4 %1, off\n\ts_mov_b32 m0, %0":"=&s"(keep):"v"(gsrc),"s"(lds_dst):"memory");}
__device__ __forceinline__ float max3f(float a,float b,float c){float r;asm("v_max3_f32 %0, %1, %2, %3":"=v"(r):"v"(a),"v"(b),"v"(c));return r;}
__device__ __forceinline__ float max2f(float a,float b){float r;asm("v_max_f32_e32 %0, %1, %2":"=v"(r):"v"(a),"v"(b));return r;}
__device__ __forceinline__ float fadd_s(float a,float b){float r;asm("v_add_f32_e32 %0, %1, %2":"=v"(r):"v"(a),"v"(b));return r;}
__device__ __forceinline__ float fsub_s(float a,float b){float r;asm("v_sub_f32_e32 %0, %1, %2":"=v"(r):"v"(a),"v"(b));return r;}
typedef float f32x2_t __attribute__((ext_vector_type(2))); typedef __bf16 bf16x2_t __attribute__((ext_vector_type(2)));
__device__ __forceinline__ unsigned cvtpk_s(float lo,float hi){f32x2_t v={lo,hi};bf16x2_t b=__builtin_convertvector(v,bf16x2_t);return __builtin_bit_cast(unsigned,b);}
#define WAIT_BAR(N) asm volatile("s_waitcnt vmcnt(" #N ") lgkmcnt(0)\n\ts_barrier":::"memory")

__device__ __forceinline__ void qkt(f32x16&p0,f32x16&p1,const char*Kslot,const bf16x8*qr,const f32x16&negm,int r32,int hi){
  const char*kb=Kslot+hi*1024+r32*16;
  #pragma unroll
  for(int d0=0;d0<4;++d0){
    const bf16x8 b0=*reinterpret_cast<const bf16x8*>(kb+d0*2048);
    const bf16x8 b1=*reinterpret_cast<const bf16x8*>(kb+d0*2048+512);
    if(d0==0){p0=__builtin_amdgcn_mfma_f32_32x32x16_bf16(b0,qr[0],negm,0,0,0);p1=__builtin_amdgcn_mfma_f32_32x32x16_bf16(b1,qr[0],negm,0,0,0);}
    else{p0=__builtin_amdgcn_mfma_f32_32x32x16_bf16(b0,qr[d0],p0,0,0,0);p1=__builtin_amdgcn_mfma_f32_32x32x16_bf16(b1,qr[d0],p1,0,0,0);}}
}
typedef __attribute__((address_space(3))) const char* lds_cptr;
typedef short v4i16_t __attribute__((ext_vector_type(4)));
__device__ __forceinline__ void kload8(bf16x8*kf,lds_cptr kp){
  kf[0]=*(const __attribute__((address_space(3))) bf16x8*)(kp);      kf[1]=*(const __attribute__((address_space(3))) bf16x8*)(kp+512);
  kf[2]=*(const __attribute__((address_space(3))) bf16x8*)(kp+2048); kf[3]=*(const __attribute__((address_space(3))) bf16x8*)(kp+2560);
  kf[4]=*(const __attribute__((address_space(3))) bf16x8*)(kp+4096); kf[5]=*(const __attribute__((address_space(3))) bf16x8*)(kp+4608);
  kf[6]=*(const __attribute__((address_space(3))) bf16x8*)(kp+6144); kf[7]=*(const __attribute__((address_space(3))) bf16x8*)(kp+6656);
}
__device__ __forceinline__ void kload2(bf16x8*kf,lds_cptr kp,int j){ kf[2*j]=*(const __attribute__((address_space(3))) bf16x8*)(kp+j*2048); kf[2*j+1]=*(const __attribute__((address_space(3))) bf16x8*)(kp+j*2048+512); }
__device__ __forceinline__ s16x4 vtr(lds_cptr p){ return __builtin_bit_cast(s16x4,__builtin_amdgcn_ds_read_tr16_b64_v4i16((__attribute__((address_space(3))) v4i16_t*)p)); }
__device__ __forceinline__ float rowmax(const f32x16&p0,const f32x16&p1){
  float a=max3f(p0[0],p0[1],p1[0]),b=max3f(p0[2],p0[3],p1[1]);a=max3f(a,p1[2],p1[3]);
  #pragma unroll
  for(int r=4;r<16;r+=4){a=max3f(a,p0[r],p0[r+1]);b=max3f(b,p0[r+2],p0[r+3]);a=max3f(a,p1[r],p1[r+1]);b=max3f(b,p1[r+2],p1[r+3]);}
  const float m=max2f(a,b);
  auto rr=__builtin_amdgcn_permlane32_swap(__float_as_uint(m),__float_as_uint(m),false,false);
  return max2f(__uint_as_float(rr[0]),__uint_as_float(rr[1]));
}
__device__ __forceinline__ void pv(f32x16*o,int vb,bf16x8 pa0,bf16x8 pa1,bf16x8 pa2,bf16x8 pa3){
  #pragma unroll
  for(int d0=0;d0<2;++d0){s16x4 lo[4],hi[4];
    #pragma unroll
    for(int ks=0;ks<4;++ks){
      asm volatile("ds_read_b64_tr_b16 %0,%1 offset:%c2":"=&v"(lo[ks]):"v"(vb),"i"(d0*4096+ks*1024):"memory");
      asm volatile("ds_read_b64_tr_b16 %0,%1 offset:%c2":"=&v"(hi[ks]):"v"(vb),"i"(d0*4096+ks*1024+512):"memory");}
    asm volatile("s_waitcnt lgkmcnt(0)":::"memory");SBAR();
    #define PK(k) (bf16x8){lo[k][0],lo[k][1],lo[k][2],lo[k][3],hi[k][0],hi[k][1],hi[k][2],hi[k][3]}
    o[d0]=__builtin_amdgcn_mfma_f32_32x32x16_bf16(pa0,PK(0),o[d0],0,0,0);
    o[d0]=__builtin_amdgcn_mfma_f32_32x32x16_bf16(pa1,PK(1),o[d0],0,0,0);
    o[d0]=__builtin_amdgcn_mfma_f32_32x32x16_bf16(pa2,PK(2),o[d0],0,0,0);
    o[d0]=__builtin_amdgcn_mfma_f32_32x32x16_bf16(pa3,PK(3),o[d0],0,0,0);
    #undef PK
  }
}

#ifndef ATTN_STORE16
#define ATTN_STORE16(p,v) (*(u32x4*)(p)=(v))
#endif
template<int THRL,int PO,bool MASK,bool BIAS> __device__ __forceinline__ void attn_unit(int q0,int NT,int qoff,int PQ,int PKV,int PG,const bf16*Qh,const bf16*__restrict__ Kh,const bf16*__restrict__ Vh,const bf16*__restrict__ Gh,bf16*Oh,const float*__restrict__ cfl,const __attribute__((address_space(3))) float* offp,float cref,char*shm){
  int tid=threadIdx.x; asm volatile("":"+v"(tid)); const int lane=tid&63,r32=lane&31,hi=lane>>5; const int wid=__builtin_amdgcn_readfirstlane(tid>>6);
  const bf16*Qw=Qh+(long)(q0+wid*QBLK)*PQ;
  const unsigned lds0=(unsigned)(uintptr_t)shm;
  float*wsf=(float*)(shm+LDS_WS)+wid*64;
  const bf16*ksrc=Kh+(long)lane*PKV+wid*8;
  const bf16*vsrc=Vh+(long)(16*(wid&3)+(lane>>2))*PKV+(wid>>2)*32+(lane&3)*8;
  const unsigned kdst=lds0+LDS_K+wid*1024, vdst=lds0+LDS_V+wid*1024;
  #define DMA_K(t,slot) glds16(ksrc+(long)(t)*KVBLK*PKV,(unsigned)__builtin_amdgcn_readfirstlane(kdst+(slot)))
  #define DMA_V(t,slot) glds16(vsrc+(long)(t)*KVBLK*PKV,(unsigned)__builtin_amdgcn_readfirstlane(vdst+(slot)))
  const int vb0=(int)(lds0+LDS_V)+((lane>>4)&1)*32+(lane&3)*8+(4*hi+((lane&15)>>2))*64;
  const char*Kbase=shm+LDS_K; bf16x8 kf[8];
  const lds_cptr shm3=(lds_cptr)shm; const lds_cptr kp0=shm3+LDS_K+hi*1024+r32*16; const lds_cptr vp0=shm3+LDS_V+((lane>>4)&1)*32+(lane&3)*8+(4*hi+((lane&15)>>2))*64;
  typedef __attribute__((address_space(3))) const f32x4_t* lds_f4p; const lds_f4p biasp=(lds_f4p)(shm3+LDS_BIAS+16*hi);
  if(BIAS){ __attribute__((address_space(3))) float* bw=(__attribute__((address_space(3))) float*)(shm3+LDS_BIAS); for(int i=tid;i<NT*KVBLK;i+=NW*64) bw[i]=cref-(cfl[i]+offp[i>>6]); }
  DMA_K(0,0);DMA_V(0,0);DMA_K(1,SLOTB);
  bf16x8 qr[4];
  #pragma unroll
  for(int d0=0;d0<4;++d0)qr[d0]=*reinterpret_cast<const bf16x8*>(&Qw[(long)r32*PQ+d0*16+hi*8]);
  float mhat=0.f,l_reg=0.f;f32x16 o[2];o[0]=f32x16{};o[1]=f32x16{};const f32x16 zero16=f32x16{};
  const int qrel=wid*QBLK+r32+qoff;
  #define CMASK(P0,P1,t) do{ if(MASK){int jb_=(t)-(NT-4); if(jb_>=0)cmask(P0,P1,jb_,qrel,hi);} }while(0)
  #define ADDB(P0,P1,t) do{ if(BIAS){ _Pragma("unroll") for(int g_=0;g_<4;++g_){ const f32x4_t b0_=biasp[(t)*16+2*g_], b1_=biasp[(t)*16+8+2*g_]; \
      P0[4*g_]+=b0_[0];P0[4*g_+1]+=b0_[1];P0[4*g_+2]+=b0_[2];P0[4*g_+3]+=b0_[3]; P1[4*g_]+=b1_[0];P1[4*g_+1]+=b1_[1];P1[4*g_+2]+=b1_[2];P1[4*g_+3]+=b1_[3]; SBAR(); } } }while(0)
  bool resc=false;
  #define START(P0,P1) do{ const float rm=rowmax(P0,P1); resc=false; \
    { const float dl=rm; mhat=fadd_s(mhat,dl); \
      _Pragma("unroll") for(int r=0;r<16;++r){P0[r]=fsub_s(P0[r],dl);P1[r]=fsub_s(P1[r],dl);} } \
    _Pragma("unroll") for(int r=0;r<16;++r)P0[r]=__builtin_amdgcn_exp2f(P0[r]); }while(0)
  #define RESC() do{ if(resc){ asm volatile("s_waitcnt lgkmcnt(0)":::"memory"); \
      _Pragma("unroll") for(int d_=0;d_<2;++d_) _Pragma("unroll") for(int r=0;r<16;++r)o[d_][r]*=wsf[crow(r,hi)]; } }while(0)
  f32x16 pA0,pA1,pB0,pB1;
  int sl_prev=0,sl_cur=0,sl_next=SLOTB;
  #define ROT() do{sl_prev=sl_cur;sl_cur=sl_next;sl_next=(sl_next==(NSLOT-1)*SLOTB)?0:sl_next+SLOTB;}while(0)
  DMA_K(2,2*SLOTB);
  WAIT_BAR(3);
  qkt(pA0,pA1,Kbase,qr,zero16,r32,hi);asm volatile("s_nop 15\n\ts_nop 7":"+v"(pA0),"+v"(pA1));CMASK(pA0,pA1,0);ADDB(pA0,pA1,0);
  START(pA0,pA1);
  _Pragma("unroll") for(int r=0;r<16;++r)pA1[r]=__builtin_amdgcn_exp2f(pA1[r]);
  WAIT_BAR(0);
  DMA_K(3,0);DMA_V(1,SLOTB);
  ROT();
  kload8(kf,kp0+sl_cur);
  WAIT_BAR(2);
  s16x4 vlo[8],vhi[8]; u32x4 pw0,pw1,pw2,pw3;
  #define PKW(P,B) cvtpk_s(P[B],P[B+1])
  #define PAF(k) __builtin_bit_cast(bf16x8,pw##k)
  #define VFR(i) (bf16x8){vlo[i][0],vlo[i][1],vlo[i][2],vlo[i][3],vhi[i][0],vhi[i][1],vhi[i][2],vhi[i][3]}
  #define PIN(x) asm volatile("":"+v"(x))
  #define MX3(a,b,c) __builtin_fmaxf(__builtin_fmaxf((a),(b)),(c))
  #define GAPA(MF,A0,A1,A2,A3,W0,W1,PW) do{ MF; sacc+=A0; sacc+=A1; sacc+=A2; sacc+=A3; PIN(sacc); W0; W1; PIN(PW); SBAR(); }while(0)
  #define EX(v) __builtin_amdgcn_exp2f(v)
  #define GAPB(MF,X,B) do{ MF; X[B]=EX(X[B]); X[B+1]=EX(X[B+1]); X[B+2]=EX(X[B+2]); X[B+3]=EX(X[B+3]); PIN(X); SBAR(); }while(0)
  #define VRD(i) do{ vlo[i]=vtr(vp_+(((i)>>2)*4096+((i)&3)*1024)); vhi[i]=vtr(vp_+(((i)>>2)*4096+((i)&3)*1024+512)); }while(0)
  #define KRD(G,j) do{ if(G){ kload2(kf,kp0+sl_next,j); SBAR(); } }while(0)
  #define STEP(C0,C1,P0,P1,t,GK,GV,GL) do{ SBAR(); \
    const lds_cptr vp_=vp0+sl_prev; \
    VRD(0); SBAR(); float sacc=(P0[0]+P0[1]); \
    GAPA(C0=__builtin_amdgcn_mfma_f32_32x32x16_bf16(kf[0],qr[0],zero16,0,0,0), P0[2],P0[3],P0[4],P0[5],     pw0[0]=PKW(P0,0), pw0[1]=PKW(P0,2), pw0); \
    VRD(4); SBAR(); GAPA(C1=__builtin_amdgcn_mfma_f32_32x32x16_bf16(kf[1],qr[0],zero16,0,0,0), P0[6],P0[7],P0[8],P0[9],     pw0[2]=PKW(P0,4), pw0[3]=PKW(P0,6), pw0); \
    VRD(1); SBAR(); GAPA(C0=__builtin_amdgcn_mfma_f32_32x32x16_bf16(kf[2],qr[1],C0,0,0,0),   P0[10],P0[11],P0[12],P0[13], pw1[0]=PKW(P0,8), pw1[1]=PKW(P0,10), pw1); \
    VRD(5); SBAR(); GAPA(C1=__builtin_amdgcn_mfma_f32_32x32x16_bf16(kf[3],qr[1],C1,0,0,0),   P0[14],P0[15],P1[0],P1[1],   pw1[2]=PKW(P0,12),pw1[3]=PKW(P0,14), pw1); \
    VRD(2); SBAR(); GAPA(C0=__builtin_amdgcn_mfma_f32_32x32x16_bf16(kf[4],qr[2],C0,0,0,0),   P1[2],P1[3],P1[4],P1[5],     pw2[0]=PKW(P1,0), pw2[1]=PKW(P1,2), pw2); \
    VRD(6); SBAR(); GAPA(C1=__builtin_amdgcn_mfma_f32_32x32x16_bf16(kf[5],qr[2],C1,0,0,0),   P1[6],P1[7],P1[8],P1[9],     pw2[2]=PKW(P1,4), pw2[3]=PKW(P1,6), pw2); \
    VRD(3); SBAR(); GAPA(C0=__builtin_amdgcn_mfma_f32_32x32x16_bf16(kf[6],qr[3],C0,0,0,0),   P1[10],P1[11],P1[12],P1[13], pw3[0]=PKW(P1,8), pw3[1]=PKW(P1,10), pw3); \
    VRD(7); SBAR(); GAPA(C1=__builtin_amdgcn_mfma_f32_32x32x16_bf16(kf[7],qr[3],C1,0,0,0),   P1[14],P1[15],0.f,0.f,       pw3[2]=PKW(P1,12),pw3[3]=PKW(P1,14), pw3); \
    l_reg+=sacc; \
    if(GK){DMA_K((t)+3,sl_cur);} if(GV){DMA_V((t)+1,sl_next);} \
    CMASK(C0,C1,t); ADDB(C0,C1,t); \
    { float a=MX3(C0[0],C0[1],C1[0]),b=MX3(C0[2],C0[3],C1[1]); a=MX3(a,C1[2],C1[3]); \
      _Pragma("unroll") for(int r=4;r<16;r+=4){a=MX3(a,C0[r],C0[r+1]);b=MX3(b,C0[r+2],C0[r+3]);a=MX3(a,C1[r],C1[r+1]);b=MX3(b,C1[r+2],C1[r+3]);} \
      float rm=__builtin_fmaxf(a,b); { auto rr=__builtin_amdgcn_permlane32_swap(__float_as_uint(rm),__float_as_uint(rm),false,false); rm=__builtin_fmaxf(__uint_as_float(rr[0]),__uint_as_float(rr[1])); } \
      resc=false; rm-=mhat; \
      if(__builtin_expect(__any(rm>(float)THRL),0)){ const float dl=__builtin_fmaxf(rm,0.f); mhat+=dl; \
        const float f=__builtin_amdgcn_exp2f(-dl); l_reg*=f; if(hi==0)wsf[r32]=f; resc=true; } \
      _Pragma("unroll") for(int r=0;r<16;++r){C0[r]-=mhat;C1[r]-=mhat;} } \
    SBAR(); \
    GAPB(o[0]=__builtin_amdgcn_mfma_f32_32x32x16_bf16(PAF(0),VFR(0),o[0],0,0,0), C0,0); \
    GAPB(o[1]=__builtin_amdgcn_mfma_f32_32x32x16_bf16(PAF(0),VFR(4),o[1],0,0,0), C0,4); \
    KRD(GL,0); GAPB(o[0]=__builtin_amdgcn_mfma_f32_32x32x16_bf16(PAF(1),VFR(1),o[0],0,0,0), C0,8); \
    KRD(GL,1); GAPB(o[1]=__builtin_amdgcn_mfma_f32_32x32x16_bf16(PAF(1),VFR(5),o[1],0,0,0), C0,12); \
    KRD(GL,2); GAPB(o[0]=__builtin_amdgcn_mfma_f32_32x32x16_bf16(PAF(2),VFR(2),o[0],0,0,0), C1,0); \
    KRD(GL,3); GAPB(o[1]=__builtin_amdgcn_mfma_f32_32x32x16_bf16(PAF(2),VFR(6),o[1],0,0,0), C1,4); \
    GAPB(o[0]=__builtin_amdgcn_mfma_f32_32x32x16_bf16(PAF(3),VFR(3),o[0],0,0,0), C1,8); \
    GAPB(o[1]=__builtin_amdgcn_mfma_f32_32x32x16_bf16(PAF(3),VFR(7),o[1],0,0,0), C1,12); \
    }while(0)
  int t=1;
  #undef CMASK
  #define CMASK(P0,P1,t) do{}while(0)
  for(;t+5<NT;t+=2){
    STEP(pB0,pB1,pA0,pA1,t,true,true,true);     WAIT_BAR(2); RESC(); ROT();
    STEP(pA0,pA1,pB0,pB1,t+1,true,true,true);   WAIT_BAR(2); RESC(); ROT();
  }
  #undef CMASK
  #define CMASK(P0,P1,t) do{ if(MASK){int jb_=(t)-(NT-4); if(jb_>=0)cmask(P0,P1,jb_,qrel,hi);} }while(0)
  #define ENDW(tt) do{ if((tt)+3<NT){WAIT_BAR(2);} else if((tt)+2<NT){WAIT_BAR(1);} else {WAIT_BAR(0);} }while(0)
  for(;t+1<NT;t+=2){
    STEP(pB0,pB1,pA0,pA1,t,(t+3<NT),(t+1<NT),(t+1<NT));       ENDW(t);   RESC(); ROT();
    STEP(pA0,pA1,pB0,pB1,t+1,(t+4<NT),(t+2<NT),(t+2<NT));     ENDW(t+1); RESC(); ROT();
  }
  STEP(pB0,pB1,pA0,pA1,NT-1,false,false,false); RESC();
  { float sacc=pB0[0]+pB0[1]; _Pragma("unroll") for(int r=2;r<16;++r)sacc+=pB0[r]; _Pragma("unroll") for(int r=0;r<16;++r)sacc+=pB1[r]; l_reg+=sacc;
    pw0=(u32x4){PKW(pB0,0),PKW(pB0,2),PKW(pB0,4),PKW(pB0,6)};pw1=(u32x4){PKW(pB0,8),PKW(pB0,10),PKW(pB0,12),PKW(pB0,14)};pw2=(u32x4){PKW(pB1,0),PKW(pB1,2),PKW(pB1,4),PKW(pB1,6)};pw3=(u32x4){PKW(pB1,8),PKW(pB1,10),PKW(pB1,12),PKW(pB1,14)};
    SBAR(); pv(o,vb0+sl_cur,PAF(0),PAF(1),PAF(2),PAF(3)); }
  #undef PKW
  #undef PAF
  #undef VFR
  #undef PIN
  #undef MX3
  #undef GAPA
  #undef GAPB
  #undef EX
  #undef VRD
  #undef KRD
  #undef STEP
  #undef ENDW
  {auto rr=__builtin_amdgcn_permlane32_swap(__float_as_uint(l_reg),__float_as_uint(l_reg),false,false);l_reg=__uint_as_float(rr[0])+__uint_as_float(rr[1]);}
  if(hi==0)wsf[32+r32]=l_reg;asm volatile("s_waitcnt lgkmcnt(0)":::"memory");
  float rli[16];
  #pragma unroll
  for(int r=0;r<16;++r)rli[r]=__builtin_amdgcn_rcpf(wsf[32+crow(r,hi)]);
  bf16*Ow=Oh+(long)(q0+wid*QBLK)*PO; const bf16*Gw=Gh+(long)(q0+wid*QBLK)*PG;
  u32x4 gt[4];
  #pragma unroll
  for(int i=0;i<4;++i)gt[i]=*(const u32x4*)(Gw+(long)(i*8+(lane>>3))*PG+(lane&7)*8);
  { bf16*stg=(bf16*)(shm+LDS_OST)+wid*2048;
    #pragma unroll
    for(int r=0;r<16;++r){const int orow=crow(r,hi);
      #pragma unroll
      for(int d0=0;d0<2;++d0)stg[orow*64+d0*32+r32]=__float2bfloat16(o[d0][r]*rli[r]);}
    asm volatile("s_waitcnt lgkmcnt(0)":::"memory");
    #pragma unroll
    for(int i=0;i<4;++i){const int row=i*8+(lane>>3),ch=lane&7; const u32x4 v=*(const u32x4*)(stg+row*64+ch*8); u32x4 w;
      #pragma unroll
      for(int e=0;e<4;++e){ const float a0=__uint_as_float(v[e]<<16)*__uint_as_float(gt[i][e]<<16), a1=__uint_as_float(v[e]&0xffff0000u)*__uint_as_float(gt[i][e]&0xffff0000u); w[e]=cvtpk_s(a0,a1); }
      ATTN_STORE16(Ow+(long)row*PO+ch*8,w);} }
  asm volatile("s_waitcnt lgkmcnt(0)\n\ts_barrier":::"memory");
  #undef DMA_K
  #undef DMA_V
  #undef CMASK
  #undef START
  #undef RESC
  #undef ADDB
  #undef ROT
}
constexpr int ATTN_LDS_BYTES=LDS_BYTES;
#undef SBAR
#undef WAIT_BAR
}

constexpr int NWAVES = 8;
#ifndef MK_N_LAUNCHES
#define MK_N_LAUNCHES 1
#endif
#ifndef PROBE_DUP
#define PROBE_DUP -1
#endif
#define NREP(k) ((PROBE_DUP == (k)) ? 2 : 1)
constexpr int PER_PHASE = 5;
constexpr int N_LAUNCHES = MK_N_LAUNCHES;

constexpr int M = 16384, D = 1024;
constexpr int IN_COLS = 3222, NP = 3072;
constexpr int MEM_LEN = 256;
constexpr float EPS = 1e-6f;
constexpr float LOG2E = 1.4426950408889634f;
constexpr size_t MiB = 1u << 20;
constexpr size_t WS_CTL = 0, CTL_ZERO_BYTES = 1 * MiB;
constexpr size_t WS_ZERO = 512 * 1024;
constexpr size_t WS_WIN = 2 * MiB;
constexpr size_t WS_WOUTF = 9 * MiB;
constexpr size_t WS_WSF = 11 * MiB;
constexpr size_t WS_MK = 12 * MiB + 512 * 1024, WS_MV = WS_MK + 128 * 1024;
constexpr size_t WS_X = 13 * MiB;
constexpr size_t WS_XN = 16 * MiB;
constexpr size_t WS_FQ = 48 * MiB, WS_FK = 60 * MiB, WS_FV = 72 * MiB, WS_FG = 84 * MiB;
constexpr size_t WS_MQ = 96 * MiB, WS_MG = 104 * MiB;
constexpr size_t WS_GQ = 112 * MiB, WS_GK = 118 * MiB;
constexpr size_t WS_GV = 124 * MiB, WS_GG = 136 * MiB;
constexpr size_t WS_GLR = 148 * MiB;
constexpr size_t WS_FFG = 149 * MiB;
constexpr size_t WS_CFL = 149 * MiB + 512 * 1024;
constexpr size_t WS_TOT = 149 * MiB + 512 * 1024 + 6 * 16384 * 4;
constexpr size_t WS_KVT = 150 * MiB;
constexpr size_t WS_DEC = 168 * MiB;
constexpr size_t WS_ST = 169 * MiB;
constexpr size_t WS_MIX = 192 * MiB;
constexpr size_t WS_GB = 224 * MiB;
constexpr size_t WS_END = 240 * MiB;
static_assert(WS_GLR + (size_t)M * 16 * 4 == WS_FFG, "g_lr | f_fg adjacency (EpiRoute mode 3)");
constexpr int CW_TMO = 0, CW_CODE = 1;
constexpr int CW_Q3 = 64;
constexpr int CW_NMAX = 128;
constexpr float ACP_THRESH = 50.f;
constexpr int CW_BAR = 4096;
constexpr int CW_SEAM = 16384;
static_assert((CW_SEAM + 2 * 64 * 64) * 4 <= (int)CTL_ZERO_BYTES, "CTL words inside the memset region");
constexpr int RING_OFF = 0, RING_BYTES = 151552;
constexpr int LDSCTL_OFF = RING_BYTES, MISC_OFF = LDSCTL_OFF + 320;
constexpr int OFFT_OFF = 153600, OFFT_ROW = 257;
constexpr int LDS_BYTES = 153600 + 8 * 1024;
static_assert(MISC_OFF + 128 <= OFFT_OFF && LDS_BYTES <= 163840 && attn_body::ATTN_LDS_BYTES <= RING_BYTES && pg8::STAGE_BYTES <= RING_BYTES, "LDS map");

#define GAS __attribute__((address_space(1)))
#define LAS __attribute__((address_space(3)))
typedef unsigned short bf16;
typedef unsigned v4u __attribute__((ext_vector_type(4)));
typedef float f32x4 __attribute__((ext_vector_type(4)));
typedef short bf16x8 __attribute__((ext_vector_type(8)));
typedef GAS unsigned gu32;
typedef GAS unsigned long long gu64;
#define RLX_AGENT __ATOMIC_RELAXED, __HIP_MEMORY_SCOPE_AGENT
#define LDS_WAIT() asm volatile("s_waitcnt lgkmcnt(0)" ::: "memory")
#define VM_WAIT() asm volatile("s_waitcnt vmcnt(0)" ::: "memory")
__device__ __forceinline__ unsigned long long rt() { return __builtin_amdgcn_s_memrealtime(); }
__device__ __forceinline__ unsigned f2bf(float f) { unsigned u = __builtin_bit_cast(unsigned, f); return (u + 0x7fffu + ((u >> 16) & 1u)) >> 16; }
__device__ __forceinline__ unsigned pk2(float lo, float hi) { return f2bf(lo) | (f2bf(hi) << 16); }

#define XB_TMO      128
#define XB_XCNT(j)  (256  + 64 * (j))
#define XB_XSUB(j)  (1280 + 64 * (j))
#define XB_XGEN(j)  (2304 + 64 * (j))
#define XB_TOP      3328
#define XB_TOPGEN   3392
#define XCD_BAR_WORDS 3456
#define XB_SPIN_CAP (1u << 18)

__device__ __forceinline__ unsigned xb_ld(unsigned* p)              { return __hip_atomic_load(p, __ATOMIC_RELAXED, __HIP_MEMORY_SCOPE_AGENT); }
__device__ __forceinline__ unsigned xb_add(unsigned* p, unsigned v) { return __hip_atomic_fetch_add(p, v, __ATOMIC_RELAXED, __HIP_MEMORY_SCOPE_AGENT); }
__device__ __forceinline__ unsigned xb_xcc_id() { return (unsigned)__builtin_amdgcn_s_getreg((3 << 11) | 20) & 0xFu; }
#define XB_SPIN(cond, bar) do { unsigned _sp = 0; while (cond) { __builtin_amdgcn_s_sleep(1); \
    if ((++_sp & 255u) == 0u) { if (xb_ld(&(bar)[XB_TMO])) break; if (_sp > XB_SPIN_CAP) { atomicAdd(&(bar)[XB_TMO], 1u); break; } } } } while (0)

struct XcdBarrier {
    unsigned* bar; unsigned x;
    volatile LAS unsigned* st;
};

__device__ __forceinline__ XcdBarrier xcd_barrier_post(unsigned* bar, volatile LAS unsigned* st) {
    XcdBarrier b; b.bar = bar; b.x = xb_xcc_id(); b.st = st;
    if (threadIdx.x == 0) (void)xb_add(&bar[XB_XCNT(b.x)], 1u);
    return b;
}
__device__ __forceinline__ void xcd_barrier_complete(unsigned* bar, unsigned x, unsigned& nloc, unsigned& nx) {
    const unsigned G = gridDim.x * gridDim.y * gridDim.z;
    unsigned sum, cnt, mine, sp = 0u;
    for (;;) {
        sum = 0u; cnt = 0u; mine = 0u;
#pragma unroll
        for (unsigned j = 0; j < 16; ++j) { const unsigned c = xb_ld(&bar[XB_XCNT(j)]); sum += c; cnt += (c > 0u) ? 1u : 0u; mine = (j == x) ? c : mine; }
        if (sum == G) break;
        __builtin_amdgcn_s_sleep(1);
        if ((++sp & 255u) == 0u) { if (xb_ld(&bar[XB_TMO])) break; if (sp > XB_SPIN_CAP) { atomicAdd(&bar[XB_TMO], 1u); break; } }
    }
    nloc = mine > 0u ? mine : 1u; nx = cnt > 0u ? cnt : 1u;
}

__device__ __forceinline__ void xcd_barrier(const XcdBarrier& b) {
    asm volatile("s_waitcnt vmcnt(0)" ::: "memory");
    __syncthreads();
    if (threadIdx.x == 0) {
        unsigned* bar = b.bar;
        __builtin_amdgcn_s_waitcnt(0);
        unsigned nloc = b.st[0], nx = b.st[1];
        if (nloc == 0u) { xcd_barrier_complete(bar, b.x, nloc, nx); b.st[0] = nloc; b.st[1] = nx; }
        const unsigned old = xb_add(&bar[XB_XSUB(b.x)], 1u);
        const unsigned gen = old / nloc;
        if (old + 1u == (gen + 1u) * nloc) {
            __builtin_amdgcn_fence(__ATOMIC_RELEASE, "agent");
            asm volatile("s_waitcnt vmcnt(0)" ::: "memory");
            const unsigned og = xb_add(&bar[XB_TOP], 1u);
            const unsigned tg = og / nx;
            if (og + 1u == (tg + 1u) * nx) xb_add(&bar[XB_TOPGEN], 1u);
            else XB_SPIN(xb_ld(&bar[XB_TOPGEN]) == tg, bar);
            __builtin_amdgcn_fence(__ATOMIC_ACQUIRE, "agent");
            xb_add(&bar[XB_XGEN(b.x)], 1u);
            asm volatile("s_waitcnt vmcnt(0)" ::: "memory");
        } else {
            XB_SPIN(xb_ld(&bar[XB_XGEN(b.x)]) == gen, bar);
            __builtin_amdgcn_fence(__ATOMIC_ACQUIRE, "agent");
            asm volatile("s_waitcnt vmcnt(0)" ::: "memory");
        }
    }
    __syncthreads();
}


__device__ __forceinline__ pg8::Route pg8::EpiRoute::route(int g32) const {
    Route R; R.mode = 0; R.col = 0; R.pitch = 384; size_t off;
    if (g32 < 12) { off = WS_FQ; R.col = g32 * 32; R.mode = 1; }
    else if (g32 < 24) { off = WS_FK; R.col = (g32 - 12) * 32; }
    else if (g32 < 36) { off = WS_FV; R.col = (g32 - 24) * 32; }
    else if (g32 < 48) { off = WS_FG; R.col = (g32 - 36) * 32; R.mode = 2; }
    else if (g32 < 56) { off = WS_MQ; R.col = (g32 - 48) * 32; R.pitch = 256; R.mode = 1; }
    else if (g32 < 64) { off = WS_MG; R.col = (g32 - 56) * 32; R.pitch = 256; R.mode = 2; }
    else if (g32 < 70) { off = WS_GQ; R.col = (g32 - 64) * 32; R.pitch = 192; }
    else if (g32 < 76) { off = WS_GK; R.col = (g32 - 70) * 32; R.pitch = 192; }
    else if (g32 < 88) { off = WS_GV; R.col = (g32 - 76) * 32; }
    else { off = WS_GG; R.col = (g32 - 88) * 32; R.mode = 2; }
    R.base = (bf16_t*)(ws + off); return R;
}

template <int CTRL> __device__ __forceinline__ float dppf(float x) { return __builtin_bit_cast(float, __builtin_amdgcn_mov_dpp(__builtin_bit_cast(int, x), CTRL, 0xf, 0xf, true)); }
__device__ __forceinline__ float half_sum(float v) {
    v += dppf<0xB1>(v); v += dppf<0x4E>(v); v += dppf<0x141>(v); v += dppf<0x140>(v);
    auto s = __builtin_amdgcn_permlane16_swap(__float_as_uint(v), __float_as_uint(v), false, false);
    return __uint_as_float(s[0]) + __uint_as_float(s[1]);
}
__device__ __forceinline__ float wave_sum(float v) {
#pragma unroll
    for (int o = 1; o < 64; o <<= 1) v += __shfl_xor(v, o);
    return v;
}
__device__ __forceinline__ void p0_transpose_item(const float* W, int K, int N, bf16* WT, int n0, int nv, int drow0, int k0, LAS float* scr, int lane) {
    float tv[32];
#pragma unroll
    for (int i = 0; i < 32; ++i) { const int kk = 2 * i + (lane >> 5), nn = lane & 31; tv[i] = W[(size_t)(k0 + kk) * N + n0 + (nn < nv ? nn : 0)]; }
#pragma unroll
    for (int i = 0; i < 32; ++i) { const int kk = 2 * i + (lane >> 5), nn = lane & 31; scr[kk * 33 + nn] = nn < nv ? tv[i] : 0.f; }
    LDS_WAIT(); asm volatile("" ::: "memory");
    const int c = lane & 7;
#pragma unroll
    for (int j = 0; j < 4; ++j) { const int n = (lane >> 3) + 8 * j; const LAS float* s = scr + (8 * c) * 33 + n;
        v4u o; o.x = pk2(s[0 * 33], s[1 * 33]); o.y = pk2(s[2 * 33], s[3 * 33]); o.z = pk2(s[4 * 33], s[5 * 33]); o.w = pk2(s[6 * 33], s[7 * 33]);
        if (n < nv) *(GAS v4u*)(WT + (size_t)(drow0 + n) * K + k0 + 8 * c) = o; }
    LDS_WAIT(); asm volatile("" ::: "memory");
}
__device__ __forceinline__ void rms_row_to_bf16(const float* xrow, const float* g, bf16* orow, int lane) {
    const GAS f32x4* xr = (const GAS f32x4*)xrow + lane; const GAS f32x4* gr = (const GAS f32x4*)g + lane;
    f32x4 v[4]; float s = 0.f;
#pragma unroll
    for (int j = 0; j < 4; ++j) { v[j] = xr[64 * j]; s += (v[j].x * v[j].x + v[j].y * v[j].y) + (v[j].z * v[j].z + v[j].w * v[j].w); }
    const float rstd = 1.f / sqrtf(wave_sum(s) * (1.f / D) + EPS);
    GAS unsigned long long* o8 = (GAS unsigned long long*)orow + lane;
#pragma unroll
    for (int j = 0; j < 4; ++j) { const f32x4 gg = gr[64 * j]; o8[64 * j] = (unsigned long long)pk2(v[j].x * rstd * gg.x, v[j].y * rstd * gg.y) | ((unsigned long long)pk2(v[j].z * rstd * gg.z, v[j].w * rstd * gg.w) << 32); }
}
__device__ __forceinline__ void p0_mem_kv(LAS unsigned char* lds, int b, int tid, int wave, int lane, const float* mem, const float* g, const float* w, unsigned char* ws) {
    const int rg = b >> 3, cg = b & 7, c = tid & 63, col = 64 * cg + c;
    LAS float* ML = (LAS float*)lds;
    LAS float* red = ML + 8 * 1024; LAS float* sq = red + 8 * 8 * 64;
    { float ss = 0.f;
#pragma unroll
      for (int i = 0; i < 4; ++i) { const f32x4 m = *(const GAS f32x4*)(mem + (size_t)(8 * rg + wave) * D + 256 * i + 4 * lane); const f32x4 gg = *(const GAS f32x4*)(g + 256 * i + 4 * lane);
          ss += (m.x * m.x + m.y * m.y) + (m.z * m.z + m.w * m.w); *(LAS f32x4*)(ML + wave * 1024 + 256 * i + 4 * lane) = m * gg; }
      ss = wave_sum(ss); if (lane == 0) sq[wave] = ss; }
    __syncthreads();
    float acc[8];
#pragma unroll
    for (int r = 0; r < 8; ++r) acc[r] = 0.f;
    const float* wp = w + (size_t)(128 * wave) * 512 + col;
    float wall[128];
#pragma unroll
    for (int k = 0; k < 128; ++k) wall[k] = wp[(size_t)k * 512];
#pragma unroll
    for (int k4 = 0; k4 < 32; ++k4) { float wv[4];
#pragma unroll
        for (int j = 0; j < 4; ++j) wv[j] = wall[4 * k4 + j];
#pragma unroll
        for (int r = 0; r < 8; ++r) { const f32x4 m = *(const LAS f32x4*)(ML + r * 1024 + 128 * wave + 4 * k4); acc[r] += (m.x * wv[0] + m.y * wv[1]) + (m.z * wv[2] + m.w * wv[3]); } }
#pragma unroll
    for (int r = 0; r < 8; ++r) red[(wave * 8 + r) * 64 + c] = acc[r];
    __syncthreads();
    { const int r = tid >> 6; float a = 0.f;
#pragma unroll
      for (int wv = 0; wv < 8; ++wv) a += red[(wv * 8 + r) * 64 + c];
      const float o = a / sqrtf(sq[r] * (1.f / D) + EPS);
      bf16* dst = (bf16*)(ws + (col < 256 ? WS_MK : WS_MV)) + (size_t)(8 * rg + r) * 256 + (col & 255);
      *dst = (bf16)f2bf(o); }
    __syncthreads();
}
__device__ __forceinline__ void p0_prologue(LAS unsigned char* lds, int vcu, int G, int tid, int wave, int lane, const float* x, const float* mem, const float* norm_g, const float* w_in, const float* mem_norm_g,
                                            const float* w_mem_kv, const float* w_out, unsigned char* ws) {
    LAS float* scr = (LAS float*)(lds + RING_OFF + wave * 16384);
    const int gw = vcu * 4 + (wave & 3), NGW = G * 4;
    constexpr int NB_IN = 96, I_IN = NB_IN * 16, I_OUT = 32 * 16, I_SK = 5 * 16, NITEMS = I_IN + I_OUT + I_SK;
    if (wave >= 4)
    for (int it = gw; it < NITEMS; it += NGW) {
        if (it < I_IN) {
            const int nb = it >> 4, kb = it & 15; int src, width, dst, b = nb;
            if (b < 6) { src = 0; width = 192; dst = 2048; }
            else if ((b -= 6) < 6) { src = 192; width = 192; dst = 2240; }
            else if ((b -= 6) < 12) { src = 384; width = 384; dst = 2432; }
            else if ((b -= 12) < 8) { src = 784; width = 256; dst = 2816; }
            else if ((b -= 8) < 12) { src = 1168; width = 384; dst = 0; }
            else if ((b -= 12) < 12) { src = 1552; width = 384; dst = 384; }
            else if ((b -= 12) < 12) { src = 1936; width = 384; dst = 768; }
            else if ((b -= 12) < 12) { src = 2326; width = 384; dst = 1152; }
            else if ((b -= 12) < 8) { src = 2710; width = 256; dst = 1536; }
            else { b -= 8; src = 2966; width = 256; dst = 1792; }
            const int nv = (width - 32 * b) < 32 ? (width - 32 * b) : 32;
            p0_transpose_item(w_in, D, IN_COLS, (bf16*)(ws + WS_WIN), src + 32 * b, nv, dst + 32 * b, 64 * kb, scr, lane);
        } else if (it < I_IN + I_OUT) { const int r = it - I_IN, nt = r >> 4, kq = r & 15;
#pragma unroll
            for (int u = 0; u < 4; ++u) { const int ks = 4 * kq + u; const float* src = w_out + (size_t)(16 * ks + 8 * (lane >> 5)) * D + 32 * nt + (lane & 31);
                v4u o; o.x = pk2(src[0 * D], src[1 * D]); o.y = pk2(src[2 * D], src[3 * D]); o.z = pk2(src[4 * D], src[5 * D]); o.w = pk2(src[6 * D], src[7 * D]);
                *((GAS v4u*)(ws + WS_WOUTF) + (size_t)(nt * 64 + ks) * 64 + lane) = o; }
        } else { const int r = it - I_IN - I_OUT, ct = r >> 4, kq = r & 15; const int r32 = lane & 31;
            int col = -1; if (ct < 4) col = 784 + 256 + 32 * ct + r32; else if (r32 < 16) col = 768 + r32; else if (r32 < 22) col = 2320 + (r32 - 16);
#pragma unroll
            for (int u = 0; u < 4; ++u) { const int ks = 4 * kq + u; const float* src = w_in + (size_t)(16 * ks + 8 * (lane >> 5)) * IN_COLS + (col < 0 ? 0 : col);
                v4u o; o.x = pk2(src[0 * IN_COLS], src[1 * IN_COLS]); o.y = pk2(src[2 * IN_COLS], src[3 * IN_COLS]); o.z = pk2(src[4 * IN_COLS], src[5 * IN_COLS]); o.w = pk2(src[6 * IN_COLS], src[7 * IN_COLS]);
                if (col < 0) o = (v4u){0u, 0u, 0u, 0u};
                *((GAS v4u*)(ws + WS_WSF) + (size_t)(ct * 64 + ks) * 64 + lane) = o; } }
    }
    {
      f32x4 gg[4];
#pragma unroll
      for (int j = 0; j < 4; ++j) gg[j] = ((const GAS f32x4*)norm_g)[64 * j + lane];
      if (wave < 4)
      for (int m0 = gw; m0 < M; m0 += 4 * NGW) { f32x4 v[4][4]; float ss[4];
#pragma unroll
          for (int q = 0; q < 4; ++q) { const int m = m0 + q * NGW; const GAS f32x4* xr = (const GAS f32x4*)(x + (size_t)(m < M ? m : 0) * D) + lane;
#pragma unroll
              for (int j = 0; j < 4; ++j) v[q][j] = xr[64 * j]; }
#pragma unroll
          for (int q = 0; q < 4; ++q) { float a = 0.f;
#pragma unroll
              for (int j = 0; j < 4; ++j) a += (v[q][j].x * v[q][j].x + v[q][j].y * v[q][j].y) + (v[q][j].z * v[q][j].z + v[q][j].w * v[q][j].w);
              ss[q] = a; }
#pragma unroll
          for (int q = 0; q < 4; ++q) { float a = half_sum(ss[q]); auto t = __builtin_amdgcn_permlane32_swap(__float_as_uint(a), __float_as_uint(a), false, false); ss[q] = __uint_as_float(t[0]) + __uint_as_float(t[1]); }
#pragma unroll
          for (int q = 0; q < 4; ++q) { const int m = m0 + q * NGW; if (m < M) { const float rstd = 1.f / sqrtf(ss[q] * (1.f / D) + EPS);
              GAS unsigned long long* o8 = (GAS unsigned long long*)((bf16*)(ws + WS_XN) + (size_t)m * D) + lane;
#pragma unroll
              for (int j = 0; j < 4; ++j) { const unsigned long long w8 = (unsigned long long)pk2(v[q][j].x * rstd * gg[j].x, v[q][j].y * rstd * gg[j].y) | ((unsigned long long)pk2(v[q][j].z * rstd * gg[j].z, v[q][j].w * rstd * gg[j].w) << 32);
                  asm volatile("global_store_dwordx2 %0, %1, off sc0 sc1\n\ts_nop 1" :: "v"(o8 + 64 * j), "v"(w8) : "memory"); } } } } }
    for (int rq = 0; rq < NREP(52); ++rq)
    for (int b = vcu; b < 256; b += G) p0_mem_kv(lds, b, tid, wave, lane, mem, mem_norm_g, w_mem_kv, ws);
}
__device__ __forceinline__ void nan_rows_f32(int vcu, int G, int wave, int lane, float* out) {
    const int gw = vcu * NWAVES + wave, NGW = G * NWAVES; const float q = __builtin_nanf("");
    for (int m = gw; m < M; m += NGW) { GAS f32x4* o = (GAS f32x4*)(out + (size_t)m * D) + lane;
#pragma unroll
        for (int j = 0; j < 4; ++j) o[64 * j] = (f32x4){q, q, q, q}; }
}
__device__ __forceinline__ void glds16(const void* gsrc, unsigned lds_dst) { unsigned keep;
    asm volatile("s_mov_b32 %0, m0\n\ts_mov_b32 m0, %2\n\ts_nop 0\n\tglobal_load_lds_dwordx4 %1, off\n\ts_mov_b32 m0, %0" : "=&s"(keep) : "v"(gsrc), "s"(lds_dst) : "memory"); }
__device__ __forceinline__ float log_sigmoid(float z) { return fminf(z, 0.f) - log1pf(__expf(-fabsf(z))); }
__device__ __forceinline__ float bf_lo(unsigned u) { return __uint_as_float(u << 16); }
__device__ __forceinline__ float bf_hi(unsigned u) { return __uint_as_float(u & 0xffff0000u); }
__device__ __forceinline__ void gla_cum_decay(float (&b)[24], const float* glr_row, const LAS float* w_up, const LAS float* b_alpha, int w, int lane) {
    f32x4 g4[4];
#pragma unroll
    for (int i = 0; i < 4; ++i) g4[i] = *(const f32x4*)(glr_row + 4 * i);
#pragma unroll
    for (int jj = 0; jj < 24; ++jj) { const int j = 24 * w + jj; float z = b_alpha[j];
#pragma unroll
        for (int r = 0; r < 16; ++r) z += g4[r >> 2][r & 3] * w_up[r * 192 + j];
        float v = log_sigmoid(z) * (1.f / 16.f);
#pragma unroll
        for (int d = 1; d < 64; d <<= 1) { const float o = __shfl_up(v, d); if (lane >= d) v += o; }
        b[jj] = v; }
}
constexpr int GL_VT = 0, GL_VT_PITCH = 72, GL_VT_BYTES = 384 * GL_VT_PITCH * 2;
constexpr int GL_KT = GL_VT_BYTES, GL_KT_PITCH = 72, GL_KT_BYTES = 192 * GL_KT_PITCH * 2;
constexpr int GL_QD = GL_VT_BYTES, GL_QD_PITCH = 200, GL_QD_BYTES = 64 * GL_QD_PITCH * 2;
constexpr int GL_KD = GL_QD + GL_QD_BYTES;
constexpr int GL_AT = GL_QD, GL_AT_PITCH = 72, GL_AT_WAVE = 32 * GL_AT_PITCH * 2;
constexpr int GL_W = 112 * 1024, GL_BA = GL_W + 16 * 192 * 4;
static_assert(GL_KD + GL_QD_BYTES <= GL_W && GL_KT + GL_KT_BYTES <= GL_W && GL_BA + 192 * 4 <= RING_BYTES && GL_AT + 8 * GL_AT_WAVE <= GL_KD + GL_QD_BYTES + 65536 && GL_AT + 8 * GL_AT_WAVE <= RING_BYTES, "GLA LDS map");
__device__ __forceinline__ void gla_stage_vt(LAS unsigned char* lds, const bf16* GV, int t0, int tid, const float* w_up, const float* b_alpha) {
    for (int i = tid; i < 16 * 192 / 4; i += 512) ((LAS f32x4*)(lds + GL_W))[i] = ((const GAS f32x4*)w_up)[i];
    if (tid < 48) ((LAS f32x4*)(lds + GL_BA))[tid] = ((const GAS f32x4*)b_alpha)[tid];
#pragma unroll
    for (int i = 0; i < 6; ++i) { const int q = tid + 512 * i, c = q & 63, cc = q >> 6;
        const v4u d = *(const GAS v4u*)(GV + (size_t)(t0 + c) * 384 + 8 * cc);
        LAS unsigned short* p = (LAS unsigned short*)(lds + GL_VT) + (8 * cc) * GL_VT_PITCH + c;
        p[0 * GL_VT_PITCH] = (unsigned short)(d.x & 0xffffu); p[1 * GL_VT_PITCH] = (unsigned short)(d.x >> 16); p[2 * GL_VT_PITCH] = (unsigned short)(d.y & 0xffffu); p[3 * GL_VT_PITCH] = (unsigned short)(d.y >> 16);
        p[4 * GL_VT_PITCH] = (unsigned short)(d.z & 0xffffu); p[5 * GL_VT_PITCH] = (unsigned short)(d.z >> 16); p[6 * GL_VT_PITCH] = (unsigned short)(d.w & 0xffffu); p[7 * GL_VT_PITCH] = (unsigned short)(d.w >> 16); }
}
constexpr int P2_VT = 0, P2_KT = GL_VT_BYTES, P2_BL = P2_KT + GL_KT_BYTES, P2_BL_PITCH = 193;
constexpr int P2_GLR = 133 * 1024, P2_LF = P2_GLR + 4096, P2_NRM = P2_LF + 1536;
static_assert(P2_BL + 64 * P2_BL_PITCH * 4 <= P2_GLR && P2_NRM + 64 <= RING_BYTES, "P2 LDS map");
__device__ __forceinline__ float log_sigmoid_fast(float z) { const float t = __builtin_amdgcn_exp2f(-LOG2E * fabsf(z)); return fminf(z, 0.f) - 0.6931471805599453f * __builtin_amdgcn_logf(1.f + t); }
__device__ __forceinline__ void p2_chunk_item(LAS unsigned char* lds, int n, int tid, int wave, int lane, unsigned char* ws, gu32* ctl, const float* w_up, const float* b_alpha, const float* b_forget) {
    typedef float f32x16 __attribute__((ext_vector_type(16)));
    asm volatile("" : "+v"(tid), "+v"(lane), "+s"(wave));
    const int t0 = 64 * n, r32 = lane & 31, hi = lane >> 5;
    { const unsigned lds0 = (unsigned)(uintptr_t)(lds); const bf16* xn = (const bf16*)(ws + WS_XN) + (size_t)t0 * 1024;
#pragma unroll
      for (int i = 0; i < 16; ++i) { const int p = 16 * wave + i, row = p >> 1, half = p & 1; const int kc = 64 * half + (lane ^ (row & 15));
          glds16(xn + (size_t)row * 1024 + 8 * kc, (unsigned)__builtin_amdgcn_readfirstlane(lds0 + row * 2048 + half * 1024)); } }
    if (tid < 12) ((LAS unsigned*)(lds + P2_NRM))[tid] = 0u;
    v4u vreg[6];
#pragma unroll
    for (int i = 0; i < 6; ++i) { const int q = tid + 512 * i, c = q & 63, cc = q >> 6; vreg[i] = *(const GAS v4u*)((const bf16*)(ws + WS_GV) + (size_t)(t0 + c) * 384 + 8 * cc); }
    v4u kk[3];
#pragma unroll
    for (int i = 0; i < 3; ++i) kk[i] = *(const GAS v4u*)((const bf16*)(ws + WS_GK) + (size_t)(t0 + lane) * 192 + 24 * wave + 8 * i);
    const int jc = tid < 192 ? tid : tid - 192;
    float wc[16]; float ba = 0.f;
    if (tid < 384) { ba = b_alpha[jc];
#pragma unroll
        for (int r = 0; r < 16; ++r) wc[r] = w_up[r * 192 + jc]; }
    LAS float* GLRL = (LAS float*)(lds + P2_GLR); LAS float* LF = (LAS float*)(lds + P2_LF);
    if (wave < 5) {
        f32x16 c[2] = {f32x16{}, f32x16{}};
        const GAS bf16x8* bp = (const GAS bf16x8*)(ws + WS_WSF) + (size_t)(wave * 64) * 64 + lane;
        bf16x8 bq[16];
#pragma unroll
        for (int u = 0; u < 16; ++u) bq[u] = bp[u * 64];
        asm volatile("s_waitcnt vmcnt(0)" ::: "memory"); __syncthreads();
        const int sw = r32 & 15;
#pragma unroll 1
        for (int ks0 = 0; ks0 < 64; ks0 += 16) {
#pragma unroll
            for (int u = 0; u < 16; ++u) { const int ks = ks0 + u; const int off = r32 * 2048 + (((2 * ks + hi) ^ sw) * 16);
                const bf16x8 a0 = *(const LAS bf16x8*)(lds + off), a1 = *(const LAS bf16x8*)(lds + off + 32 * 2048);
                c[0] = __builtin_amdgcn_mfma_f32_32x32x16_bf16(a0, bq[u], c[0], 0, 0, 0); c[1] = __builtin_amdgcn_mfma_f32_32x32x16_bf16(a1, bq[u], c[1], 0, 0, 0);
                if (ks + 16 < 64) bq[u] = bp[(ks + 16) * 64]; } }
        if (wave < 4) {
#pragma unroll
            for (int rt = 0; rt < 2; ++rt)
#pragma unroll
                for (int r = 0; r < 16; ++r) { const float v = c[rt][r]; const int row = 32 * rt + (r & 3) + 8 * (r >> 2) + 4 * hi;
                    ((bf16*)(ws + WS_GG))[(size_t)(t0 + row) * 384 + 256 + 32 * wave + r32] = (bf16)f2bf(v * __builtin_amdgcn_rcpf(1.f + __builtin_amdgcn_exp2f(-LOG2E * v))); }
        } else {
            const float bf = r32 >= 16 && r32 < 22 ? b_forget[r32 - 16] : 0.f;
#pragma unroll
            for (int rt = 0; rt < 2; ++rt)
#pragma unroll
                for (int r = 0; r < 16; ++r) { const float v = c[rt][r]; const int row = 32 * rt + (r & 3) + 8 * (r >> 2) + 4 * hi;
                    if (r32 < 16) GLRL[row * 16 + r32] = v;
                    else if (r32 < 22) LF[(r32 - 16) * 64 + row] = LOG2E * log_sigmoid(v + bf); }
        }
    } else {
        asm volatile("s_waitcnt vmcnt(0)" ::: "memory"); __syncthreads();
        const int t = tid - 320;
#pragma unroll
        for (int pp = 0; pp < 2; ++pp) { const int p = t + 192 * pp, row = p / 6, h = p % 6;
#pragma unroll
            for (int which = 0; which < 2; ++which) { const bf16* src = (const bf16*)(ws + (which ? WS_FK : WS_FQ)) + (size_t)(t0 + row) * 384 + h * 64; float sacc = 0.f;
#pragma unroll
                for (int i = 0; i < 8; ++i) { const v4u a = *(const GAS v4u*)(src + 8 * i);
#pragma unroll
                    for (int e = 0; e < 4; ++e) { const float lo = bf_lo(a[e]), hh = bf_hi(a[e]); sacc += lo * lo + hh * hh; } }
                __hip_atomic_fetch_max((LAS unsigned*)(lds + P2_NRM) + which * 6 + h, __float_as_uint(sacc), __ATOMIC_RELAXED, __HIP_MEMORY_SCOPE_WORKGROUP); } }
    }
    __syncthreads();
    if (tid < 12) __hip_atomic_fetch_max((unsigned*)(ctl + CW_NMAX + tid), ((LAS unsigned*)(lds + P2_NRM))[tid], RLX_AGENT);
#pragma unroll
    for (int i = 0; i < 6; ++i) { const int q = tid + 512 * i, c = q & 63, cc = q >> 6; const v4u d = vreg[i];
        LAS unsigned short* p = (LAS unsigned short*)(lds + P2_VT) + (8 * cc) * GL_VT_PITCH + c;
        p[0 * GL_VT_PITCH] = (unsigned short)(d.x & 0xffffu); p[1 * GL_VT_PITCH] = (unsigned short)(d.x >> 16); p[2 * GL_VT_PITCH] = (unsigned short)(d.y & 0xffffu); p[3 * GL_VT_PITCH] = (unsigned short)(d.y >> 16);
        p[4 * GL_VT_PITCH] = (unsigned short)(d.z & 0xffffu); p[5 * GL_VT_PITCH] = (unsigned short)(d.z >> 16); p[6 * GL_VT_PITCH] = (unsigned short)(d.w & 0xffffu); p[7 * GL_VT_PITCH] = (unsigned short)(d.w >> 16); }
    LAS float* BL = (LAS float*)(lds + P2_BL);
    if (tid < 384) { const int c0 = tid < 192 ? 0 : 32; float run = 0.f;
#pragma unroll 4
        for (int c = 0; c < 32; ++c) { const LAS f32x4* g4 = (const LAS f32x4*)(GLRL + (c0 + c) * 16); float z = ba;
#pragma unroll
            for (int q = 0; q < 4; ++q) { const f32x4 g = g4[q]; z += (g.x * wc[4 * q] + g.y * wc[4 * q + 1]) + (g.z * wc[4 * q + 2] + g.w * wc[4 * q + 3]); }
            run += log_sigmoid_fast(z) * (1.f / 16.f); BL[(c0 + c) * P2_BL_PITCH + jc] = run; } }
    else if (wave == 6 || wave == 7) {
#pragma unroll
        for (int hh = 0; hh < 3; ++hh) { const int h = 3 * (wave - 6) + hh; float v = LF[h * 64 + lane];
#pragma unroll
            for (int d = 1; d < 64; d <<= 1) { const float o = __shfl_up(v, d); if (lane >= d) v += o; }
            ((float*)(ws + WS_CFL))[(size_t)h * M + t0 + lane] = v; if (lane == 63) ((float*)(ws + WS_TOT))[h * 256 + n] = v; } }
    __syncthreads();
    { LAS unsigned short* kt = (LAS unsigned short*)(lds + P2_KT); float* dec = (float*)(ws + WS_DEC) + (size_t)n * 192; float b[24];
#pragma unroll
      for (int jj = 0; jj < 24; ++jj) { const int j = 24 * wave + jj; const float half = BL[31 * P2_BL_PITCH + j]; const float bl = BL[63 * P2_BL_PITCH + j] + half;
          const float bv = BL[lane * P2_BL_PITCH + j] + (lane >= 32 ? half : 0.f); b[jj] = bv;
          const unsigned u = kk[jj >> 3][(jj & 7) >> 1]; const float kv = (jj & 1) ? bf_hi(u) : bf_lo(u);
          kt[j * GL_KT_PITCH + lane] = (unsigned short)f2bf(kv * __expf(bl - bv));
          if (lane == 63) dec[j] = __expf(bl); }
      float* gb = (float*)(ws + WS_GB) + (size_t)(t0 + lane) * 192 + 24 * wave;
#pragma unroll
      for (int i = 0; i < 6; ++i) *(f32x4*)(gb + 4 * i) = (f32x4){b[4 * i], b[4 * i + 1], b[4 * i + 2], b[4 * i + 3]}; }
    __syncthreads();
    { const int r16 = lane & 15, q4 = lane >> 4;
      float* kvt = (float*)(ws + WS_KVT) + (size_t)n * 18432;
      for (int ti = wave; ti < 72; ti += 8) { const int h = ti / 18, rem = ti % 18, vt = rem / 3, kt3 = rem % 3;
          pg8::f32x4 acc = {0.f, 0.f, 0.f, 0.f};
#pragma unroll
          for (int ks = 0; ks < 2; ++ks) {
              const bf16x8 a = *(const LAS bf16x8*)(lds + P2_VT + ((h * 96 + vt * 16 + r16) * GL_VT_PITCH + ks * 32 + 8 * q4) * 2);
              const bf16x8 bb = *(const LAS bf16x8*)(lds + P2_KT + ((h * 48 + kt3 * 16 + r16) * GL_KT_PITCH + ks * 32 + 8 * q4) * 2);
              acc = __builtin_amdgcn_mfma_f32_16x16x32_bf16(a, bb, acc, 0, 0, 0); }
#pragma unroll
          for (int r = 0; r < 4; ++r) kvt[(size_t)(h * 96 + vt * 16 + q4 * 4 + r) * 48 + kt3 * 16 + r16] = acc[r]; } }
    __syncthreads();
}
__device__ __forceinline__ void gla_scan_item(int item, int tid, unsigned char* ws) {
    const int e = item * 512 + tid, h = e / 4608, k = e % 48;
    const float* kvt = (const float*)(ws + WS_KVT) + e; const float* dec = (const float*)(ws + WS_DEC) + h * 48 + k; bf16* st = (bf16*)(ws + WS_ST) + e;
    float S = 0.f;
    for (int n0 = 0; n0 < 256; n0 += 64) { float kv[64], dc[64];
#pragma unroll
        for (int i = 0; i < 64; ++i) { kv[i] = kvt[(size_t)(n0 + i) * 18432]; dc[i] = dec[(size_t)(n0 + i) * 192]; }
#pragma unroll
        for (int i = 0; i < 64; ++i) { st[(size_t)(n0 + i) * 18432] = (bf16)f2bf(S); S = dc[i] * S + kv[i]; } }
}
constexpr int FO_AMG = 0;
constexpr int FO_VT = 49152;
constexpr int FO_QD = 98304, FO_KD = FO_QD + 24576;
constexpr int FO_AT = FO_QD;
constexpr int FO_AR1 = 49152;
constexpr int FO_AR2 = FO_AR1 + 65536;
constexpr int FO_TR = 0, FO_TR_WAVE = 32 * 528;
constexpr int FO_RED = 8 * FO_TR_WAVE, FO_RS = FO_RED + 2048;
static_assert(FO_AR2 + 16384 <= RING_BYTES && FO_KD + 24576 <= RING_BYTES && FO_RS + 256 <= RING_BYTES, "fused out-projection LDS map");
__device__ __forceinline__ void fused_out_item(LAS unsigned char* lds, int n, int tid, int wave, int lane, unsigned char* ws, const float* x, const float* gng, const float* fng, float* out) {
    typedef float f32x16 __attribute__((ext_vector_type(16)));
    asm volatile("" : "+v"(tid), "+v"(lane), "+s"(wave));
    const int t0 = 64 * n; const int r32 = lane & 31, hi = lane >> 5;
    for (int rpa = 0; rpa < NREP(40); ++rpa) {
    { const unsigned lds0 = (unsigned)(uintptr_t)(lds); const bf16* gsrc = (const bf16*)(ws + WS_GG) + (size_t)t0 * 384;
      if (lane < 48) {
#pragma unroll
          for (int i = 0; i < 8; ++i) { const int row = 8 * wave + i; glds16(gsrc + (size_t)row * 384 + 8 * (lane ^ (row & 15)), (unsigned)__builtin_amdgcn_readfirstlane(lds0 + FO_AMG + row * 768)); } } }
    bf16x8 sb[3][3];
    { const bf16* stn = (const bf16*)(ws + WS_ST) + (size_t)n * 18432 + (size_t)(wave >> 1) * 4608;
#pragma unroll
      for (int vt = 0; vt < 3; ++vt)
#pragma unroll
          for (int ks = 0; ks < 3; ++ks) sb[vt][ks] = *(const GAS bf16x8*)(stn + (32 * vt + r32) * 48 + 16 * ks + 8 * hi); }
    float gn[3];
#pragma unroll
    for (int vt = 0; vt < 3; ++vt) gn[vt] = gng[32 * vt + r32];
#pragma unroll
    for (int i = 0; i < 6; ++i) { const int q = tid + 512 * i, c = q & 63, cc = q >> 6;
        const v4u d = *(const GAS v4u*)((const bf16*)(ws + WS_GV) + (size_t)(t0 + c) * 384 + 8 * cc);
        LAS unsigned char* p = lds + FO_VT + (c & 7) * 2; const int kc = c >> 3;
#pragma unroll
        for (int e = 0; e < 8; ++e) { const int v = 8 * cc + e; const unsigned w = d[e >> 1]; const unsigned short val = (e & 1) ? (unsigned short)(w >> 16) : (unsigned short)(w & 0xffffu);
            *(LAS unsigned short*)(p + v * 128 + ((kc ^ ((v >> 1) & 7)) * 16)) = val; } }
    { const size_t row = (size_t)(t0 + lane);
      v4u qq[3], kk[3]; f32x4 bb[6];
#pragma unroll
      for (int i = 0; i < 3; ++i) { qq[i] = *(const GAS v4u*)((const bf16*)(ws + WS_GQ) + row * 192 + 24 * wave + 8 * i); kk[i] = *(const GAS v4u*)((const bf16*)(ws + WS_GK) + row * 192 + 24 * wave + 8 * i); }
#pragma unroll
      for (int i = 0; i < 6; ++i) bb[i] = *(const GAS f32x4*)((const float*)(ws + WS_GB) + row * 192 + 24 * wave + 4 * i);
      const float qs = 0.14433756729740643f;
      const int sw = (lane >> 1) & 7;
#pragma unroll
      for (int i = 0; i < 3; ++i) { v4u oq, ok;
#pragma unroll
          for (int e = 0; e < 4; ++e) { const float b0 = bb[2 * i + (e >> 1)][(2 * e) & 3], b1 = bb[2 * i + (e >> 1)][((2 * e) & 3) + 1];
              oq[e] = pk2(bf_lo(qq[i][e]) * qs * __expf(b0), bf_hi(qq[i][e]) * qs * __expf(b1)); ok[e] = pk2(bf_lo(kk[i][e]) * __expf(-b0), bf_hi(kk[i][e]) * __expf(-b1)); }
          const int ch = 3 * wave + i, chs = (ch & ~7) | ((ch & 7) ^ sw);
          *(LAS v4u*)(lds + FO_QD + lane * 384 + chs * 16) = oq; *(LAS v4u*)(lds + FO_KD + lane * 384 + chs * 16) = ok; } }
    __syncthreads();
    const int h = wave >> 1, rh = wave & 1;
    {
      f32x16 at[2] = {f32x16{}, f32x16{}}, o[3] = {f32x16{}, f32x16{}, f32x16{}};
      bf16x8 qa[3];
      { const int row = 32 * rh + r32, sw = (row >> 1) & 7;
#pragma unroll
        for (int ks = 0; ks < 3; ++ks) { const int ch = 6 * h + 2 * ks + hi; qa[ks] = *(const LAS bf16x8*)(lds + FO_QD + row * 384 + ((ch & ~7) | ((ch & 7) ^ sw)) * 16); } }
#pragma unroll
      for (int st = 0; st < 2; ++st) if (st <= rh) { const int row = 32 * st + r32, sw = (row >> 1) & 7;
#pragma unroll
          for (int ks = 0; ks < 3; ++ks) { const int ch = 6 * h + 2 * ks + hi; const bf16x8 kb = *(const LAS bf16x8*)(lds + FO_KD + row * 384 + ((ch & ~7) | ((ch & 7) ^ sw)) * 16);
              at[st] = __builtin_amdgcn_mfma_f32_32x32x16_bf16(qa[ks], kb, at[st], 0, 0, 0); } }
#pragma unroll
      for (int vt = 0; vt < 3; ++vt)
#pragma unroll
          for (int ks = 0; ks < 3; ++ks) o[vt] = __builtin_amdgcn_mfma_f32_32x32x16_bf16(qa[ks], sb[vt][ks], o[vt], 0, 0, 0);
      __syncthreads();
      LAS unsigned char* atw = lds + FO_AT + wave * 4096;
#pragma unroll
      for (int st = 0; st < 2; ++st) if (st <= rh) {
#pragma unroll
          for (int r = 0; r < 16; ++r) { const int cl = (r & 3) + 8 * (r >> 2) + 4 * hi, c = 32 * rh + cl, s = 32 * st + r32;
              *(LAS unsigned short*)(atw + cl * 128 + (((s >> 3) ^ ((cl >> 1) & 7)) * 16) + (s & 7) * 2) = (unsigned short)f2bf(s <= c ? at[st][r] : 0.f); } }
      LDS_WAIT(); asm volatile("" ::: "memory");
#pragma unroll
      for (int ks = 0; ks < 4; ++ks) if (ks < 2 * rh + 2) { const bf16x8 aa = *(const LAS bf16x8*)(atw + r32 * 128 + (((2 * ks + hi) ^ ((r32 >> 1) & 7)) * 16));
#pragma unroll
          for (int vt = 0; vt < 3; ++vt) { const int v = h * 96 + 32 * vt + r32; const bf16x8 vb = *(const LAS bf16x8*)(lds + FO_VT + v * 128 + (((2 * ks + hi) ^ ((v >> 1) & 7)) * 16));
              o[vt] = __builtin_amdgcn_mfma_f32_32x32x16_bf16(aa, vb, o[vt], 0, 0, 0); } }
#pragma unroll
      for (int r = 0; r < 16; ++r) { const float ss = half_sum(o[0][r] * o[0][r] + o[1][r] * o[1][r] + o[2][r] * o[2][r]);
          const float rstd = 1.f / sqrtf(ss * (1.f / 96.f) + EPS);
          const int rl = 32 * rh + (r & 3) + 8 * (r >> 2) + 4 * hi;
#pragma unroll
          for (int vt = 0; vt < 3; ++vt) { const int col = h * 96 + 32 * vt + r32; LAS unsigned short* ap = (LAS unsigned short*)(lds + FO_AMG + rl * 768 + (((col >> 3) ^ (rl & 15)) * 16) + (col & 7) * 2);
              const float g = __uint_as_float((unsigned)(*ap) << 16); *ap = (unsigned short)f2bf(o[vt][r] * rstd * gn[vt] * g); } }
    }
    __syncthreads();
    }
    { const unsigned lds0 = (unsigned)(uintptr_t)(lds); const bf16* mix = (const bf16*)(ws + WS_MIX) + (size_t)t0 * 1024;
#pragma unroll
      for (int i = 0; i < 8; ++i) { const int row = 8 * wave + i; const int kc = lane ^ (row & 15);
          glds16(mix + (size_t)row * 1024 + 384 + 8 * kc, (unsigned)__builtin_amdgcn_readfirstlane(lds0 + FO_AR1 + row * 1024)); }
#pragma unroll
      for (int i = 0; i < 2; ++i) { const int q = 2 * wave + i, row = 4 * q + (lane >> 4); const int kc = (lane & 15) ^ (row & 15);
          glds16(mix + (size_t)row * 1024 + 896 + 8 * kc, (unsigned)__builtin_amdgcn_readfirstlane(lds0 + FO_AR2 + q * 1024)); } }
    f32x16 acc[2][4];
#pragma unroll
    for (int rt = 0; rt < 2; ++rt)
#pragma unroll
        for (int ct = 0; ct < 4; ++ct) acc[rt][ct] = f32x16{};
    const GAS bf16x8* wf = (const GAS bf16x8*)(ws + WS_WOUTF) + (size_t)(4 * wave) * 64 * 64 + lane;
    bf16x8 bq[4][4];
    for (int rpb = 0; rpb < NREP(41); ++rpb) {
#pragma unroll
    for (int u = 0; u < 4; ++u)
#pragma unroll
        for (int ct = 0; ct < 4; ++ct) bq[u][ct] = wf[(ct * 64 + u) * 64];
    const int sw15 = r32 & 15;
#pragma unroll 1
    for (int ks0 = 0; ks0 < 64; ks0 += 4) {
        if (ks0 == 24) { asm volatile("s_waitcnt vmcnt(0)" ::: "memory"); __syncthreads(); }
#pragma unroll
        for (int u = 0; u < 4; ++u) { const int ks = ks0 + u, kc = 2 * ks + hi;
            int a_off;
            if (ks0 < 24) a_off = FO_AMG + r32 * 768 + ((kc ^ sw15) * 16);
            else if (ks0 < 56) a_off = FO_AR1 + r32 * 1024 + (((kc - 48) ^ sw15) * 16);
            else a_off = FO_AR2 + r32 * 256 + (((kc - 112) ^ sw15) * 16);
            const int rstep = ks0 < 24 ? 32 * 768 : (ks0 < 56 ? 32 * 1024 : 32 * 256);
            const bf16x8 a0 = *(const LAS bf16x8*)(lds + a_off), a1 = *(const LAS bf16x8*)(lds + a_off + rstep);
#pragma unroll
            for (int ct = 0; ct < 4; ++ct) { acc[0][ct] = __builtin_amdgcn_mfma_f32_32x32x16_bf16(a0, bq[u][ct], acc[0][ct], 0, 0, 0); acc[1][ct] = __builtin_amdgcn_mfma_f32_32x32x16_bf16(a1, bq[u][ct], acc[1][ct], 0, 0, 0); }
            if (ks + 4 < 64) {
#pragma unroll
                for (int ct = 0; ct < 4; ++ct) bq[u][ct] = wf[(ct * 64 + ks + 4) * 64]; }
        }
    }
    }
    __syncthreads();
    LAS float* tr = (LAS float*)(lds + FO_TR + wave * FO_TR_WAVE);
    LAS float* red = (LAS float*)(lds + FO_RED);
    f32x4 v[2][16];
    const int c4 = lane & 31, rsel = lane >> 5;
#pragma unroll
    for (int rt = 0; rt < 2; ++rt) {
#pragma unroll
        for (int ct = 0; ct < 4; ++ct)
#pragma unroll
            for (int r = 0; r < 16; ++r) tr[((r & 3) + 8 * (r >> 2) + 4 * hi) * 132 + 32 * ct + r32] = acc[rt][ct][r];
        LDS_WAIT(); asm volatile("" ::: "memory");
#pragma unroll
        for (int i = 0; i < 16; ++i) { const int rl = 2 * i + rsel; const size_t row = (size_t)(t0 + 32 * rt + rl);
            const f32x4 xv = __builtin_nontemporal_load((const GAS f32x4*)(x + row * 1024 + 128 * wave + 4 * c4));
            f32x4 t = *(const LAS f32x4*)(tr + rl * 132 + 4 * c4); t = t * (NREP(41) == 2 ? 0.5f : 1.0f) + xv; v[rt][i] = t;
            const float ss = half_sum((t[0] * t[0] + t[1] * t[1]) + (t[2] * t[2] + t[3] * t[3]));
            if (c4 == 0) red[(32 * rt + rl) * 8 + wave] = ss; }
        LDS_WAIT(); asm volatile("" ::: "memory");
    }
    __syncthreads();
    if (tid < 64) { float q = 0.f;
#pragma unroll
        for (int w = 0; w < 8; ++w) q += red[tid * 8 + w];
        ((LAS float*)(lds + FO_RS))[tid] = 1.0f / sqrtf(q * (1.0f / 1024.0f) + EPS); }
    __syncthreads();
    const f32x4 gv = *(const GAS f32x4*)(fng + 128 * wave + 4 * c4);
#pragma unroll
    for (int rt = 0; rt < 2; ++rt)
#pragma unroll
        for (int i = 0; i < 16; ++i) { const int rl = 32 * rt + 2 * i + rsel; const float rs = ((const LAS float*)(lds + FO_RS))[rl];
            __builtin_nontemporal_store(v[rt][i] * rs * gv, (GAS f32x4*)(out + (size_t)(t0 + rl) * 1024 + 128 * wave + 4 * c4)); }
    __syncthreads();
}


struct Args { const float* in[12]; float* out; unsigned char* ws; int ph_lo, ph_hi, li, pad; };
__global__ void __launch_bounds__(NWAVES * 64, 2) hymba_fwd(Args args) {
    extern __shared__ __attribute__((aligned(16))) unsigned char lds_raw[];
    LAS unsigned char* lds = (LAS unsigned char*)lds_raw;
    volatile LAS unsigned* MISC = (volatile LAS unsigned*)(lds + MISC_OFF);
    const int tid = threadIdx.x, lane = tid & 63, wave = __builtin_amdgcn_readfirstlane(tid >> 6);
    const int G = gridDim.x; const int bx = blockIdx.x; const int vcu = (G % 8 == 0) ? (bx % 8) * (G / 8) + bx / 8 : bx;
    unsigned char* ws = args.ws; gu32* ctl = (gu32*)(ws + WS_CTL);
    const float* x = args.in[0]; const float* mem = args.in[1]; const float* norm_g = args.in[2]; const float* w_in = args.in[3]; const float* w_up = args.in[4]; const float* b_alpha = args.in[5];
    const float* b_forget = args.in[6]; const float* gla_norm_g = args.in[7]; const float* mem_norm_g = args.in[8]; const float* w_mem_kv = args.in[9]; const float* w_out = args.in[10]; const float* final_norm_g = args.in[11];
    for (int u = tid; u < (LDS_BYTES - LDSCTL_OFF) / 4; u += NWAVES * 64) ((LAS unsigned*)(lds + LDSCTL_OFF))[u] = 0u;
    __syncthreads();
    XcdBarrier bar; bar.bar = (unsigned*)(ctl + CW_BAR); bar.x = 0; bar.st = nullptr;
    if (N_LAUNCHES != PER_PHASE) bar = xcd_barrier_post((unsigned*)(ctl + CW_BAR), MISC + 8);
#define GRID_BAR(seam) do { if (N_LAUNCHES == PER_PHASE) { if (tid == 0) __hip_atomic_store(ctl + CW_TMO, 0xBADBA0u | (unsigned)(seam), RLX_AGENT); } else { xcd_barrier(bar); } } while (0)
    const int lo = args.ph_lo, hi = args.ph_hi;
#define IN(k) (lo <= (k) && (k) < hi)
#define BOTH(k) (IN(k) && IN((k) + 1))

    if (IN(0)) { for (int rp = 0; rp < NREP(0); ++rp) p0_prologue(lds, vcu, G, tid, wave, lane, x, mem, norm_g, w_in, mem_norm_g, w_mem_kv, w_out, ws); if (BOTH(0)) GRID_BAR(0); }

    if (PROBE_DUP == 9) { for (int rb = 0; rb < 4; ++rb) GRID_BAR(9); }
    if (IN(1)) {
        for (int rp = 0; rp < NREP(1); ++rp) {
        { pg8::Gemm g{(const pg8::bf16_t*)(ws + WS_XN), (const pg8::bf16_t*)(ws + WS_WIN), M, NP, D}; pg8::StaticOrder S; S.init(M, NP, G, (int)blockIdx.x);
          pg8::EpiRoute E{ws, attn_body::C2};
          pg8::gemm_phase<pg8::EpiRoute, pg8::StaticOrder, true, true>(lds + RING_OFF, g, S, E); }
        }
        if (BOTH(1)) GRID_BAR(1);
    }

    if (IN(2)) {
        for (int rp = 0; rp < NREP(2); ++rp) {
        for (int n = vcu; n < 256; n += G) p2_chunk_item(lds, n, tid, wave, lane, ws, ctl, w_up, b_alpha, b_forget);
        }
        if (BOTH(2)) GRID_BAR(2);
    }

    if (IN(3)) {
        {
          LAS float* offt = (LAS float*)(lds + OFFT_OFF);
          float v[6];
          if (tid < 256) {
#pragma unroll
              for (int h = 0; h < 6; ++h) v[h] = ((const float*)(ws + WS_TOT))[h * 256 + tid];
#pragma unroll
              for (int d = 1; d < 64; d <<= 1) {
#pragma unroll
                  for (int h = 0; h < 6; ++h) { const float o = __shfl_up(v[h], d); if (lane >= d) v[h] += o; } }
              if (lane == 63) {
#pragma unroll
                  for (int h = 0; h < 6; ++h) ((LAS float*)(lds + RING_OFF))[h * 4 + wave] = v[h]; } }
          __syncthreads();
          if (tid < 256) {
#pragma unroll
              for (int h = 0; h < 6; ++h) { float add = 0.f; for (int w = 0; w < wave; ++w) add += ((LAS float*)(lds + RING_OFF))[h * 4 + w]; offt[h * OFFT_ROW + tid + 1] = v[h] + add; }
              offt[6 * OFFT_ROW + tid] = 0.f; if (tid < 7) offt[tid * OFFT_ROW + (tid == 6 ? 256 : 0)] = 0.f; }
          __syncthreads(); }
        for (int rp = 0; rp < NREP(3); ++rp)
        for (;;) {
            __syncthreads();
            if (tid == 0) { MISC[16] = __hip_atomic_fetch_add(ctl + CW_Q3 + 32 * rp, 1u, RLX_AGENT); MISC[17] = 0xffffu; }
            __syncthreads();
            int it = (int)MISC[16];
            { constexpr int EXTRA = PROBE_DUP == 30 ? 36 : (PROBE_DUP == 31 ? 384 : (PROBE_DUP == 32 ? 256 : 0)); if (it >= 36 + 384 + 256 + EXTRA) break;
              if (it >= 36 + 384 + 256) it = it - (36 + 384 + 256) + (PROBE_DUP == 30 ? 0 : (PROBE_DUP == 31 ? 36 : 36 + 384)); }
            if (it >= 384 && it < 420) { gla_scan_item(it - 384, tid, ws); continue; }
            int q0, NT, qoff, pitch; size_t oq, ok, ov, og; int ocol; const float* cfl; float cref; const LAS float* offp;
            if (it < 384) { const int i = it, qb = 63 - i / 6, h = i % 6; q0 = 256 * qb; NT = 4 * qb + 4; qoff = 0; pitch = 384;
                oq = WS_FQ + h * 128; ok = WS_FK + h * 128; ov = WS_FV + h * 128; og = WS_FG + h * 128; ocol = 384 + h * 64; cfl = (const float*)(ws + WS_CFL) + (size_t)h * M;
                const LAS float* offt = (const LAS float*)(lds + OFFT_OFF) + h * OFFT_ROW;
                cref = cfl[q0] + offt[4 * qb];
                const float b2 = 2.f * sqrtf(__uint_as_float(ctl[CW_NMAX + h]) * __uint_as_float(ctl[CW_NMAX + 6 + h])) + 1.0f;
                int cand = NT - 4; if (tid < NT - 4 && b2 + cref - offt[tid + 1] >= -ACP_THRESH) cand = tid;
#pragma unroll
                for (int o = 1; o < 64; o <<= 1) { const int t = __shfl_xor(cand, o); cand = t < cand ? t : cand; }
                if (lane == 0) __hip_atomic_fetch_min((LAS unsigned*)(lds + MISC_OFF) + 17, (unsigned)cand, __ATOMIC_RELAXED, __HIP_MEMORY_SCOPE_WORKGROUP);
                __syncthreads();
                const int t_lo = (int)MISC[17] & ~1;
                NT -= t_lo; ok += (size_t)t_lo * 64 * 384 * 2; ov += (size_t)t_lo * 64 * 384 * 2; cfl += t_lo * 64; offp = offt + t_lo; }
            else { const int i = it - 36 - 384, qb = i >> 2, h = i & 3; q0 = 256 * qb; NT = 4; qoff = 1 << 24; pitch = 256;
                oq = WS_MQ + h * 128; ok = WS_MK + h * 128; ov = WS_MV + h * 128; og = WS_MG + h * 128; ocol = 768 + h * 64; cfl = (const float*)(ws + WS_ZERO); cref = 0.f; offp = (const LAS float*)(lds + OFFT_OFF) + 6 * OFFT_ROW; }
            attn_body::attn_unit<8, 1024, true, true>(q0, NT, qoff, pitch, pitch, pitch, (const attn_body::bf16*)(ws + oq), (const attn_body::bf16*)(ws + ok), (const attn_body::bf16*)(ws + ov),
                (const attn_body::bf16*)(ws + og), (attn_body::bf16*)(ws + WS_MIX) + ocol, cfl, offp, cref, (char*)lds_raw + RING_OFF);
        }
        if (BOTH(3)) GRID_BAR(3);
    }

    if (IN(4)) {
        for (int rp = 0; rp < NREP(4); ++rp)
        for (int n = vcu; n < 256; n += G) fused_out_item(lds, n, tid, wave, lane, ws, x, gla_norm_g, final_norm_g, args.out);
    }
#undef IN
#undef BOTH
}

extern "C" void kernel_launch(void* const* d_in, const int* in_sizes, int n_in, void* d_out, int out_size, void* d_ws, size_t ws_size, hipStream_t stream) {
    static int grid = 0;
    if (grid == 0) {
        if (n_in != 12 || in_sizes[0] != M * D || out_size != M * D || ws_size < WS_END) { fprintf(stderr, "kernel_launch: unexpected shapes (n_in %d, in0 %d, out %d, ws %zu); nothing launched\n", n_in, n_in > 0 ? in_sizes[0] : -1, out_size, ws_size); grid = -1; return; }
        int dev = 0, cus = 0, per_cu = 0;
        if (hipGetDevice(&dev) != hipSuccess || hipDeviceGetAttribute(&cus, hipDeviceAttributeMultiprocessorCount, dev) != hipSuccess) { fprintf(stderr, "kernel_launch: device query failed\n"); grid = -1; return; }
        if (hipFuncSetAttribute((const void*)hymba_fwd, hipFuncAttributeMaxDynamicSharedMemorySize, LDS_BYTES) != hipSuccess) { fprintf(stderr, "kernel_launch: hipFuncSetAttribute failed\n"); grid = -1; return; }
        if (hipOccupancyMaxActiveBlocksPerMultiprocessor(&per_cu, (const void*)hymba_fwd, NWAVES * 64, LDS_BYTES) != hipSuccess || per_cu < 1) { fprintf(stderr, "kernel_launch: occupancy query reports %d workgroups per CU; nothing launched\n", per_cu); (void)hipGetLastError(); grid = -1; return; }
        grid = cus;
        if (grid != 256) fprintf(stderr, "kernel_launch: launching %d workgroups; the fused final phase needs exactly 256\n", grid);
    }
    if (grid < 0) return;
    if (hipMemsetAsync((char*)d_ws + WS_CTL, 0, CTL_ZERO_BYTES, stream) != hipSuccess) { fprintf(stderr, "kernel_launch: hipMemsetAsync failed\n"); return; }
    Args a{};
    for (int i = 0; i < 12; ++i) a.in[i] = (const float*)d_in[i];
    a.out = (float*)d_out; a.ws = (unsigned char*)d_ws;
    for (int li = 0; li < N_LAUNCHES; ++li) {
        a.ph_lo = (N_LAUNCHES == PER_PHASE) ? li : 0; a.ph_hi = (N_LAUNCHES == PER_PHASE) ? li + 1 : PER_PHASE; a.li = li;
        hipLaunchKernelGGL(hymba_fwd, dim3(grid), dim3(NWAVES * 64), LDS_BYTES, stream, a);
        const hipError_t le = hipPeekAtLastError();
        if (le != hipSuccess) { fprintf(stderr, "kernel_launch: launch %d failed: %s\n", li, hipGetErrorName(le)); break; }
    }
}
```

```cpp
#include <hip/hip_runtime.h>
#include <cstdio>
#include <cstdint>
namespace pg8 {
#define PG8_LAS __attribute__((address_space(3)))
typedef unsigned short bf16_t;
typedef short bf16x8 __attribute__((ext_vector_type(8)));
typedef float f32x4 __attribute__((ext_vector_type(4)));
typedef unsigned u32x4 __attribute__((ext_vector_type(4)));
constexpr int BM = 256, BK = 64, HALF = 128, HTB = HALF * BK * 2  , STAGE_BYTES = 8 * HTB, NXCD = 8, WGM = 8;

__host__ __device__ __forceinline__ int lds_byte(int r, int c) { const int st = (r >> 4) * 2 + (c >> 5), rr = r & 15, cc = c & 31, ob = rr * 64 + cc * 2; return st * 1024 + (ob ^ (((ob >> 9) & 1) << 5)); }
__host__ __device__ __forceinline__ void stage_rc(int b, int& R, int& C) { const int st = b / 1024, sb = b % 1024, swz = sb ^ (((sb >> 9) & 1) << 5); R = (st >> 1) * 16 + swz / 64; C = (st & 1) * 32 + (swz % 64) / 2; }
__host__ __device__ __forceinline__ int perm32(int rho) { const int n = rho >> 4, i = rho & 15; return 8 * (i >> 2) + 4 * n + (i & 3); }

struct Unit { int pm, pn; };
struct Gemm { const bf16_t* A; const bf16_t* Bt; int M, N, K; };

struct StaticOrder {
    int nM, nN, nwg, G, c;
    __host__ __device__ void init(int M, int N, int G_, int c_) { nM = M / BM; nN = N / BM; nwg = nM * nN; G = G_; c = c_; }
    __host__ __device__ bool next(int i, Unit& u) const {
        const long L = (long)i * G + c; if (L >= nwg) return false;
        int wgid = (int)L; { const int q = nwg / NXCD, r = nwg % NXCD, xcd = wgid % NXCD, off = wgid / NXCD; wgid = (xcd < r ? xcd * (q + 1) : r * (q + 1) + (xcd - r) * q) + off; }
        const int nig = WGM * nN, gid = wgid / nig, fm = gid * WGM, gsz = (nM - fm) < WGM ? (nM - fm) : WGM;
        u.pm = fm + ((wgid % nig) % gsz); u.pn = (wgid % nig) / gsz; return true;
    }
    __device__ __forceinline__ void a_ready(const Unit&) const {}
    __device__ __forceinline__ void done(const Unit&) const {}
};


__device__ __forceinline__ unsigned cvt_pk_bf16(float lo, float hi) { unsigned r; asm volatile("v_cvt_pk_bf16_f32 %0, %1, %2" : "=v"(r) : "v"(lo), "v"(hi)); return r; }
typedef float f32x2 __attribute__((ext_vector_type(2)));

struct EpiBf16 {
    static constexpr bool PERM = true, AFTER_DRAIN = false;
    bf16_t* O; int ldc; int split_cols; size_t split_stride;
    __device__ __forceinline__ void operator()(const f32x4 (&acc)[2][2][4][2], const Unit& u, int wr, int wc, int fr, int fq) const {
        const int row0 = u.pm * BM + wr * 64 + fr; int colt = u.pn * BM; bf16_t* base = O;
        if (split_cols) { const int t = colt / split_cols; base += (size_t)t * split_stride; colt -= t * split_cols; }
        const int col0 = colt + wc * 32 + 8 * fq;
#pragma unroll
        for (int ai = 0; ai < 2; ++ai)
#pragma unroll
            for (int m = 0; m < 4; ++m) { bf16_t* rowp = base + (size_t)(row0 + ai * HALF + m * 16) * ldc + col0;
#pragma unroll
                for (int bj = 0; bj < 2; ++bj) { const f32x4 v0 = acc[ai][bj][m][0], v1 = acc[ai][bj][m][1];
                    u32x4 w; w.x = cvt_pk_bf16(v0[0], v0[1]); w.y = cvt_pk_bf16(v0[2], v0[3]); w.z = cvt_pk_bf16(v1[0], v1[1]); w.w = cvt_pk_bf16(v1[2], v1[3]);
                    *(u32x4*)(rowp + bj * HALF) = w; } }
    }
};

struct RouteTab { unsigned char* ws; };
struct Route { bf16_t* base; int pitch, col, mode; };
struct EpiRoute {
    static constexpr bool PERM = true, AFTER_DRAIN = false;
    unsigned char* ws; float qscale;
    __device__ __forceinline__ Route route(int g32) const;
    __device__ __forceinline__ void operator()(const f32x4 (&acc)[2][2][4][2], const Unit& u, int wr, int wc, int fr, int fq) const {
        const int row0 = u.pm * BM + wr * 64 + fr;
#pragma unroll
        for (int bj = 0; bj < 2; ++bj) {
            const Route R = route(8 * u.pn + 4 * bj + wc);
            if (R.mode == 4) continue;
            if (R.mode == 3) {
                float* glr = (float*)R.base; float* ffg = glr + (size_t)16384 * 16;
#pragma unroll
                for (int ai = 0; ai < 2; ++ai)
#pragma unroll
                    for (int m = 0; m < 4; ++m) { const size_t row = (size_t)(row0 + ai * HALF + m * 16);
                        const f32x4 v0 = acc[ai][bj][m][0], v1 = acc[ai][bj][m][1];
                        if (fq < 2) { *(f32x4*)(glr + row * 16 + 8 * fq) = v0; *(f32x4*)(glr + row * 16 + 8 * fq + 4) = v1; }
                        else if (fq == 2) { *(f32x4*)(ffg + row * 8) = v0; *(f32x4*)(ffg + row * 8 + 4) = v1; } }
                continue;
            }
            const float sc = R.mode == 1 ? qscale : 1.f;
#pragma unroll
            for (int ai = 0; ai < 2; ++ai)
#pragma unroll
                for (int m = 0; m < 4; ++m) { bf16_t* rowp = R.base + (size_t)(row0 + ai * HALF + m * 16) * R.pitch + R.col + 8 * fq;
                    f32x4 v0 = acc[ai][bj][m][0], v1 = acc[ai][bj][m][1];
                    if (R.mode == 2) {
#pragma unroll
                        for (int e = 0; e < 4; ++e) { v0[e] = v0[e] * __builtin_amdgcn_rcpf(1.f + __builtin_amdgcn_exp2f(-1.4426950408889634f * v0[e])); v1[e] = v1[e] * __builtin_amdgcn_rcpf(1.f + __builtin_amdgcn_exp2f(-1.4426950408889634f * v1[e])); }
                    } else { v0 = v0 * sc; v1 = v1 * sc; }
                    u32x4 w; w.x = cvt_pk_bf16(v0[0], v0[1]); w.y = cvt_pk_bf16(v0[2], v0[3]); w.z = cvt_pk_bf16(v1[0], v1[1]); w.w = cvt_pk_bf16(v1[2], v1[3]);
                    asm volatile("global_store_dwordx4 %0, %1, off sc0 sc1\n\ts_nop 1" :: "v"(rowp), "v"(w) : "memory"); }
        }
    }
};

struct PanelSumSq {
    unsigned* xbuf;
    unsigned* cnt;
    unsigned* tmo;
    float eps; unsigned code;
    __device__ __forceinline__ bool run(const f32x4 (&v)[2][2][4][2], const Unit& u, int wr, int wc, int fr, int fq, PG8_LAS unsigned char* lds, int wid, int lane) const {
        PG8_LAS float* P = (PG8_LAS float*)lds;
        PG8_LAS float* S = (PG8_LAS float*)(lds + 8192);
        PG8_LAS unsigned* flag = (PG8_LAS unsigned*)(lds + 8192 + 2048);
#pragma unroll
        for (int ai = 0; ai < 2; ++ai)
#pragma unroll
            for (int m = 0; m < 4; ++m) {
                float q = 0.f;
#pragma unroll
                for (int bj = 0; bj < 2; ++bj)
#pragma unroll
                    for (int n = 0; n < 2; ++n) { const f32x4 d = v[ai][bj][m][n]; q += (d[0] * d[0] + d[1] * d[1]) + (d[2] * d[2] + d[3] * d[3]); }
                q += __shfl_xor(q, 16); q += __shfl_xor(q, 32);
                if (fq == 0) P[(ai * HALF + wr * 64 + m * 16 + fr) * 4 + wc] = q;
            }
        asm volatile("s_waitcnt lgkmcnt(0)" ::: "memory"); __builtin_amdgcn_s_barrier(); asm volatile("" ::: "memory");
        const int row = wid * 32 + (lane & 31);
        if (lane < 32) {
            const float q = (P[row * 4 + 0] + P[row * 4 + 1]) + (P[row * 4 + 2] + P[row * 4 + 3]);
            unsigned* slot = xbuf + ((size_t)(u.pm * BM + row) * 4 + u.pn);
            __hip_atomic_store(slot, __float_as_uint(q), __ATOMIC_RELAXED, __HIP_MEMORY_SCOPE_AGENT);
        }
        asm volatile("s_waitcnt vmcnt(0)" ::: "memory");
        if (lane == 0) __hip_atomic_fetch_add(cnt + 64 * u.pm, 1u, __ATOMIC_RELAXED, __HIP_MEMORY_SCOPE_AGENT);
        if (wid == 0) {
            bool dead = false; const unsigned long long t0 = __builtin_amdgcn_s_memrealtime(); const unsigned want = 8u * 4u;
            for (;;) {
                if ((unsigned)__builtin_amdgcn_readfirstlane(__hip_atomic_load(cnt + 64 * u.pm, __ATOMIC_RELAXED, __HIP_MEMORY_SCOPE_AGENT)) >= want) break;
                if (__builtin_amdgcn_s_memrealtime() - t0 > 2000000ull) {
                    if (lane == 0) { unsigned expect = 0u; __hip_atomic_compare_exchange_strong(tmo + 1, &expect, code | (unsigned)(u.pm & 0xff), __ATOMIC_RELAXED, __ATOMIC_RELAXED, __HIP_MEMORY_SCOPE_AGENT);
                                     __hip_atomic_store(tmo, 1u, __ATOMIC_RELAXED, __HIP_MEMORY_SCOPE_AGENT); }
                    dead = true; break; }
                __builtin_amdgcn_s_sleep(2);
            }
            __builtin_amdgcn_fence(__ATOMIC_ACQUIRE, "agent");
            if (lane == 0) flag[0] = dead ? 1u : 0u;
        }
        asm volatile("s_waitcnt vmcnt(0) lgkmcnt(0)" ::: "memory"); __builtin_amdgcn_s_barrier(); asm volatile("" ::: "memory");
        const bool bad = flag[0] != 0u;
        if (lane < 32) {
            const unsigned* slot = xbuf + (size_t)(u.pm * BM + row) * 4; float q = 0.f;
#pragma unroll
            for (int t = 0; t < 4; ++t) q += __uint_as_float(__hip_atomic_load(slot + t, __ATOMIC_RELAXED, __HIP_MEMORY_SCOPE_AGENT));
            S[row] = 1.0f / sqrtf(q * (1.0f / 1024.0f) + eps);
        }
        asm volatile("s_waitcnt lgkmcnt(0)" ::: "memory"); __builtin_amdgcn_s_barrier(); asm volatile("" ::: "memory");
        return bad;
    }
};
struct EpiNormRes {
    static constexpr bool PERM = false, AFTER_DRAIN = true;
    const float* base; float* out; int ldc; const float* gain; PanelSumSq st; unsigned poison;
    __device__ __forceinline__ void fused(f32x4 (&acc)[2][2][4][2], const Unit& u, int wr, int wc, int fr, int fq, PG8_LAS unsigned char* lds, int wid, int lane) const {
        const PG8_LAS float* S = (const PG8_LAS float*)(lds + 8192);
        const int col0 = u.pn * BM + wc * 32 + 4 * fq;
#pragma unroll
        for (int ai = 0; ai < 2; ++ai)
#pragma unroll
            for (int m = 0; m < 4; ++m) { const size_t off = (size_t)(u.pm * BM + ai * HALF + wr * 64 + m * 16 + fr) * ldc + col0;
#pragma unroll
                for (int bj = 0; bj < 2; ++bj)
#pragma unroll
                    for (int n = 0; n < 2; ++n) acc[ai][bj][m][n] += *(const f32x4*)(base + off + bj * HALF + n * 16);
                asm volatile("" : "+v"(acc[ai][0][m][0]), "+v"(acc[ai][0][m][1]), "+v"(acc[ai][1][m][0]), "+v"(acc[ai][1][m][1]));
                if (m & 1) asm volatile("" ::: "memory"); }
        const bool bad = st.run(acc, u, wr, wc, fr, fq, lds, wid, lane) || poison != 0u;
        const float qnan = __builtin_nanf("");
        f32x4 gv[2][2];
#pragma unroll
        for (int bj = 0; bj < 2; ++bj)
#pragma unroll
            for (int n = 0; n < 2; ++n) gv[bj][n] = *(const f32x4*)(gain + col0 + bj * HALF + n * 16);
#pragma unroll
        for (int ai = 0; ai < 2; ++ai)
#pragma unroll
            for (int m = 0; m < 4; ++m) { const int r = ai * HALF + wr * 64 + m * 16 + fr; const float sr = S[r]; const size_t off = (size_t)(u.pm * BM + r) * ldc + col0;
#pragma unroll
                for (int bj = 0; bj < 2; ++bj)
#pragma unroll
                    for (int n = 0; n < 2; ++n) { f32x4 o = acc[ai][bj][m][n] * sr * gv[bj][n];
                        if (bad) o = (f32x4){qnan, qnan, qnan, qnan}; *(f32x4*)(out + off + bj * HALF + n * 16) = o; } }
    }
};

template <class Epi, class Sched, bool ALIGN_EPI = false, bool SP2 = false>
__device__ __forceinline__ void gemm_phase(PG8_LAS unsigned char* lds, const Gemm g, const Sched& S, const Epi& E) {
    const int tid = threadIdx.x, wid = __builtin_amdgcn_readfirstlane(tid >> 6), lane = tid & 63, wr = wid >> 2, wc = wid & 3, fr = lane & 15, fq = lane >> 4;
    const int K = g.K, nt = K / BK;
    unsigned voffA[2], voffB[2];
#pragma unroll
    for (int i = 0; i < 2; ++i) { int R, C; stage_rc(tid * 16 + i * 8192, R, C); const int Rb = Epi::PERM ? ((R & ~31) + perm32(R & 31)) : R;
        voffA[i] = (unsigned)(R * K + C) * 2u; voffB[i] = (unsigned)(Rb * K + C) * 2u; }
    const size_t kstep = (size_t)(BK * 2);
    const size_t hstep = (size_t)HALF * K * 2;
    const size_t tstep = 2 * hstep;
    const unsigned ldsw = (unsigned)wid * 1024u;
    const int aoff = lds_byte(wr * 64 + fr, fq * 8), boff = lds_byte(wc * 32 + fr, fq * 8);
#define PG8_SA(b, h) (((b) * 2 + (h)) * HTB)
#define PG8_SB(b, h) ((4 + (b) * 2 + (h)) * HTB)
#define PG8_STAGE(bufoff, gbase, voff) do { _Pragma("unroll") for (int _i = 0; _i < 2; ++_i) \
        __builtin_amdgcn_global_load_lds((const unsigned*)((const char*)(gbase) + (voff)[_i]), (PG8_LAS unsigned*)(lds + (bufoff) + ldsw + _i * 8192), 16, 0, 0); } while (0)
#define PG8_LDA(dst, b, h) do { _Pragma("unroll") for (int m = 0; m < 4; ++m) _Pragma("unroll") for (int k = 0; k < 2; ++k) dst[m][k] = *(const PG8_LAS bf16x8*)(lds + PG8_SA(b, h) + aoff + m * 2048 + k * 1024); } while (0)
#define PG8_LDB(dst, b, h) do { _Pragma("unroll") for (int n = 0; n < 2; ++n) _Pragma("unroll") for (int k = 0; k < 2; ++k) dst[n][k] = *(const PG8_LAS bf16x8*)(lds + PG8_SB(b, h) + boff + n * 2048 + k * 1024); } while (0)
#define PG8_MMA(ai, bj, At, Bt) do { __builtin_amdgcn_s_setprio(1); _Pragma("unroll") for (int m = 0; m < 4; ++m) _Pragma("unroll") for (int n = 0; n < 2; ++n) _Pragma("unroll") for (int k = 0; k < 2; ++k) \
        acc[ai][bj][m][n] = __builtin_amdgcn_mfma_f32_16x16x32_bf16(Bt[n][k], At[m][k], acc[ai][bj][m][n], 0, 0, 0); __builtin_amdgcn_s_setprio(0); } while (0)
#define PG8_WAIT_V(n) asm volatile("s_waitcnt vmcnt(" #n ")" ::: "memory")
#define PG8_WAIT_L(n) asm volatile("s_waitcnt lgkmcnt(" #n ")" ::: "memory")
#define PG8_BAR __builtin_amdgcn_s_barrier()
#define PG8_SCHED __builtin_amdgcn_sched_barrier(0)
    Unit cur, nxt; int ui = 0;
    if (!S.next(0, cur)) return;
    f32x4 acc[2][2][4][2];
#pragma unroll
    for (int a = 0; a < 2; ++a)
#pragma unroll
        for (int b = 0; b < 2; ++b)
#pragma unroll
            for (int m = 0; m < 4; ++m)
#pragma unroll
                for (int n = 0; n < 2; ++n) acc[a][b][m][n] = (f32x4){0.f, 0.f, 0.f, 0.f};
    bf16x8 At[4][2], B0[2][2], B1[2][2];
    const char* cA = (const char*)g.A + (size_t)cur.pm * tstep; const char* cB = (const char*)g.Bt + (size_t)cur.pn * tstep;
    S.a_ready(cur);
    if constexpr (SP2) {
        PG8_STAGE(PG8_SB(0, 0), cB, voffB); PG8_STAGE(PG8_SB(0, 1), cB + hstep, voffB); PG8_STAGE(PG8_SA(0, 0), cA, voffA); PG8_STAGE(PG8_SA(0, 1), cA + hstep, voffA);
        if (wr == 1) PG8_BAR;
        PG8_WAIT_V(2); PG8_BAR;
        PG8_STAGE(PG8_SB(1, 0), cB + kstep, voffB); PG8_STAGE(PG8_SA(1, 0), cA + kstep, voffA); PG8_STAGE(PG8_SB(1, 1), cB + hstep + kstep, voffB);
        PG8_WAIT_V(6); PG8_BAR;
    } else {
        PG8_STAGE(PG8_SB(0, 0), cB, voffB); PG8_STAGE(PG8_SA(0, 0), cA, voffA); PG8_STAGE(PG8_SB(0, 1), cB + hstep, voffB); PG8_STAGE(PG8_SA(0, 1), cA + hstep, voffA);
        if (wr == 1) PG8_BAR;
        PG8_WAIT_V(4); PG8_BAR;
        PG8_STAGE(PG8_SB(1, 0), cB + kstep, voffB); PG8_STAGE(PG8_SA(1, 0), cA + kstep, voffA); PG8_STAGE(PG8_SB(1, 1), cB + hstep + kstep, voffB);
        PG8_WAIT_V(6); PG8_BAR;
    }
    for (;;) {
        const bool has_next = S.next(ui + 1, nxt);
        const char* nA = has_next ? (const char*)g.A + (size_t)nxt.pm * tstep : cA; const char* nB = has_next ? (const char*)g.Bt + (size_t)nxt.pn * tstep : cB;
        for (int t = 0; t < nt; t += 2) {
            const bool last = (t == nt - 2);
            const char* a1 = cA + (size_t)(t + 1) * kstep;
            const char* a2 = last ? nA : cA + (size_t)(t + 2) * kstep; const char* b2 = last ? nB : cB + (size_t)(t + 2) * kstep;
            const char* a3 = a2 + kstep; const char* b3 = b2 + kstep;
            if (last && has_next) S.a_ready(nxt);
            if constexpr (SP2) {
            PG8_LDB(B0, 0, 0); PG8_LDB(B1, 0, 1); PG8_SCHED; PG8_LDA(At, 0, 0); PG8_STAGE(PG8_SA(1, 1), a1 + hstep, voffA);
            PG8_WAIT_V(8); PG8_WAIT_L(0); PG8_BAR; PG8_MMA(0, 0, At, B0); PG8_MMA(0, 1, At, B1); PG8_BAR; PG8_SCHED;
            PG8_LDA(At, 0, 1); PG8_STAGE(PG8_SB(0, 0), b2, voffB); PG8_STAGE(PG8_SB(0, 1), b2 + hstep, voffB); PG8_STAGE(PG8_SA(0, 0), a2, voffA);
            PG8_WAIT_V(8); PG8_WAIT_L(0); PG8_BAR; PG8_MMA(1, 0, At, B0); PG8_MMA(1, 1, At, B1); PG8_BAR; PG8_SCHED;
            PG8_LDB(B0, 1, 0); PG8_LDB(B1, 1, 1); PG8_SCHED; PG8_LDA(At, 1, 0); PG8_STAGE(PG8_SA(0, 1), a2 + hstep, voffA);
            PG8_WAIT_V(8); PG8_WAIT_L(0); PG8_BAR; PG8_MMA(0, 0, At, B0); PG8_MMA(0, 1, At, B1); PG8_BAR; PG8_SCHED;
            PG8_LDA(At, 1, 1); PG8_STAGE(PG8_SB(1, 0), b3, voffB); PG8_STAGE(PG8_SB(1, 1), b3 + hstep, voffB); PG8_STAGE(PG8_SA(1, 0), a3, voffA);
            PG8_WAIT_V(8); PG8_WAIT_L(0); PG8_BAR; PG8_MMA(1, 0, At, B0); PG8_MMA(1, 1, At, B1); PG8_BAR; PG8_SCHED;
            } else {
            PG8_LDB(B0, 0, 0); PG8_SCHED; PG8_LDA(At, 0, 0); PG8_STAGE(PG8_SA(1, 1), a1 + hstep, voffA);
            PG8_WAIT_L(8); PG8_BAR; PG8_WAIT_L(0); PG8_MMA(0, 0, At, B0); PG8_BAR; PG8_SCHED;
            PG8_LDB(B1, 0, 1); PG8_STAGE(PG8_SB(0, 0), b2, voffB);
            PG8_BAR; PG8_WAIT_L(0); PG8_MMA(0, 1, At, B1); PG8_BAR;
            PG8_LDA(At, 0, 1); PG8_STAGE(PG8_SA(0, 0), a2, voffA);
            PG8_BAR; PG8_WAIT_L(0); PG8_MMA(1, 0, At, B0); PG8_BAR; PG8_SCHED;
            PG8_STAGE(PG8_SB(0, 1), b2 + hstep, voffB);
            PG8_WAIT_V(6); PG8_BAR; PG8_MMA(1, 1, At, B1); PG8_BAR;
            PG8_LDB(B0, 1, 0); PG8_SCHED; PG8_LDA(At, 1, 0); PG8_STAGE(PG8_SA(0, 1), a2 + hstep, voffA);
            PG8_WAIT_L(8); PG8_BAR; PG8_WAIT_L(0); PG8_MMA(0, 0, At, B0); PG8_BAR; PG8_SCHED;
            PG8_LDB(B1, 1, 1); PG8_STAGE(PG8_SB(1, 0), b3, voffB);
            PG8_BAR; PG8_WAIT_L(0); PG8_MMA(0, 1, At, B1); PG8_BAR;
            PG8_LDA(At, 1, 1); PG8_STAGE(PG8_SA(1, 0), a3, voffA);
            PG8_BAR; PG8_WAIT_L(0); PG8_MMA(1, 0, At, B0); PG8_BAR; PG8_SCHED;
            PG8_STAGE(PG8_SB(1, 1), b3 + hstep, voffB);
            PG8_WAIT_V(6); PG8_BAR; PG8_MMA(1, 1, At, B1); PG8_BAR;
            }
        }
        if constexpr (ALIGN_EPI) { if (wr == 0) PG8_BAR; }
        if constexpr (!Epi::AFTER_DRAIN) { E(acc, cur, wr, wc, fr, fq); S.done(cur); }
        if (!has_next) break;
#pragma unroll
        for (int a = 0; a < 2; ++a)
#pragma unroll
            for (int b = 0; b < 2; ++b)
#pragma unroll
                for (int m = 0; m < 4; ++m)
#pragma unroll
                    for (int n = 0; n < 2; ++n) acc[a][b][m][n] = (f32x4){0.f, 0.f, 0.f, 0.f};
        cur = nxt; cA = nA; cB = nB; ++ui;
        if constexpr (ALIGN_EPI) { if (wr == 1) PG8_BAR; }
    }
    PG8_WAIT_V(0);
    if constexpr (!ALIGN_EPI) { if (wr == 0) PG8_BAR; }
    PG8_BAR;
    if constexpr (Epi::AFTER_DRAIN) { E.fused(acc, cur, wr, wc, fr, fq, lds, wid, lane); S.done(cur); }
#undef PG8_SA
#undef PG8_SB
#undef PG8_STAGE
#undef PG8_LDA
#undef PG8_LDB
#undef PG8_MMA
#undef PG8_WAIT_V
#undef PG8_WAIT_L
#undef PG8_BAR
#undef PG8_SCHED
}
}

#include <hip/hip_bf16.h>
#include <cmath>
namespace attn_body {
using bf16=__hip_bfloat16;
using bf16x8=__attribute__((ext_vector_type(8)))short;
using s16x4=__attribute__((ext_vector_type(4)))short;
using f32x16=__attribute__((ext_vector_type(16)))float;
using u32x4=__attribute__((ext_vector_type(4)))unsigned;
using f32x4_t=__attribute__((ext_vector_type(4)))float;
constexpr int D=64;
constexpr int NW=8,QBLK=32,QB=QBLK*NW,KVBLK=64;
constexpr int ATTN_UNIT_ROWS=QB;
__device__ __forceinline__ int crow(int r,int hi){return (r&3)+8*(r>>2)+4*hi;}
#define SBAR() __builtin_amdgcn_sched_barrier(0)
__device__ __forceinline__ void cmask(f32x16&p0,f32x16&p1,int jb,int qrel,int hi){
  const float NEG=-INFINITY; int kb=64*jb+4*hi;
  #pragma unroll
  for(int r=0;r<16;++r){int kv=kb+(r&3)+8*(r>>2); if(kv>qrel)p0[r]=NEG; if(kv+32>qrel)p1[r]=NEG;}
}

constexpr int NSLOT=3, SLOTB=8192;
constexpr int LDS_K=0, LDS_V=NSLOT*SLOTB, LDS_WS=2*NSLOT*SLOTB, LDS_OST=LDS_WS+NW*64*4, LDS_BIAS=LDS_OST+NW*4096, MAXKEYS=16384, LDS_BYTES=LDS_BIAS+MAXKEYS*4;
constexpr float C2=0.125f*1.4426950408889634f;
__device__ __forceinline__ void glds16(const void*gsrc,unsigned lds_dst){unsigned keep;
  asm volatile("s_mov_b32 %0, m0\n\ts_mov_b32 m0, %2\n\ts_nop 0\n\tglobal_load_lds_dwordx4 %1, off\n\ts_mov_b32 m0, %0":"=&s"(keep):"v"(gsrc),"s"(lds_dst):"memory");}
__device__ __forceinline__ float max3f(float a,float b,float c){float r;asm("v_max3_f32 %0, %1, %2, %3":"=v"(r):"v"(a),"v"(b),"v"(c));return r;}
__device__ __forceinline__ float max2f(float a,float b){float r;asm("v_max_f32_e32 %0, %1, %2":"=v"(r):"v"(a),"v"(b));return r;}
__device__ __forceinline__ float fadd_s(float a,float b){float r;asm("v_add_f32_e32 %0, %1, %2":"=v"(r):"v"(a),"v"(b));return r;}
__device__ __forceinline__ float fsub_s(float a,float b){float r;asm("v_sub_f32_e32 %0, %1, %2":"=v"(r):"v"(a),"v"(b));return r;}
typedef float f32x2_t __attribute__((ext_vector_type(2))); typedef __bf16 bf16x2_t __attribute__((ext_vector_type(2)));
__device__ __forceinline__ unsigned cvtpk_s(float lo,float hi){f32x2_t v={lo,hi};bf16x2_t b=__builtin_convertvector(v,bf16x2_t);return __builtin_bit_cast(unsigned,b);}
#define WAIT_BAR(N) asm volatile("s_waitcnt vmcnt(" #N ") lgkmcnt(0)\n\ts_barrier":::"memory")

__device__ __forceinline__ void qkt(f32x16&p0,f32x16&p1,const char*Kslot,const bf16x8*qr,const f32x16&negm,int r32,int hi){
  const char*kb=Kslot+hi*1024+r32*16;
  #pragma unroll
  for(int d0=0;d0<4;++d0){
    const bf16x8 b0=*reinterpret_cast<const bf16x8*>(kb+d0*2048);
    const bf16x8 b1=*reinterpret_cast<const bf16x8*>(kb+d0*2048+512);
    if(d0==0){p0=__builtin_amdgcn_mfma_f32_32x32x16_bf16(b0,qr[0],negm,0,0,0);p1=__builtin_amdgcn_mfma_f32_32x32x16_bf16(b1,qr[0],negm,0,0,0);}
    else{p0=__builtin_amdgcn_mfma_f32_32x32x16_bf16(b0,qr[d0],p0,0,0,0);p1=__builtin_amdgcn_mfma_f32_32x32x16_bf16(b1,qr[d0],p1,0,0,0);}}
}
typedef __attribute__((address_space(3))) const char* lds_cptr;
typedef short v4i16_t __attribute__((ext_vector_type(4)));
__device__ __forceinline__ void kload8(bf16x8*kf,lds_cptr kp){
  kf[0]=*(const __attribute__((address_space(3))) bf16x8*)(kp);      kf[1]=*(const __attribute__((address_space(3))) bf16x8*)(kp+512);
  kf[2]=*(const __attribute__((address_space(3))) bf16x8*)(kp+2048); kf[3]=*(const __attribute__((address_space(3))) bf16x8*)(kp+2560);
  kf[4]=*(const __attribute__((address_space(3))) bf16x8*)(kp+4096); kf[5]=*(const __attribute__((address_space(3))) bf16x8*)(kp+4608);
  kf[6]=*(const __attribute__((address_space(3))) bf16x8*)(kp+6144); kf[7]=*(const __attribute__((address_space(3))) bf16x8*)(kp+6656);
}
__device__ __forceinline__ void kload2(bf16x8*kf,lds_cptr kp,int j){ kf[2*j]=*(const __attribute__((address_space(3))) bf16x8*)(kp+j*2048); kf[2*j+1]=*(const __attribute__((address_space(3))) bf16x8*)(kp+j*2048+512); }
__device__ __forceinline__ s16x4 vtr(lds_cptr p){ return __builtin_bit_cast(s16x4,__builtin_amdgcn_ds_read_tr16_b64_v4i16((__attribute__((address_space(3))) v4i16_t*)p)); }
__device__ __forceinline__ float rowmax(const f32x16&p0,const f32x16&p1){
  float a=max3f(p0[0],p0[1],p1[0]),b=max3f(p0[2],p0[3],p1[1]);a=max3f(a,p1[2],p1[3]);
  #pragma unroll
  for(int r=4;r<16;r+=4){a=max3f(a,p0[r],p0[r+1]);b=max3f(b,p0[r+2],p0[r+3]);a=max3f(a,p1[r],p1[r+1]);b=max3f(b,p1[r+2],p1[r+3]);}
  const float m=max2f(a,b);
  auto rr=__builtin_amdgcn_permlane32_swap(__float_as_uint(m),__float_as_uint(m),false,false);
  return max2f(__uint_as_float(rr[0]),__uint_as_float(rr[1]));
}
__device__ __forceinline__ void pv(f32x16*o,int vb,bf16x8 pa0,bf16x8 pa1,bf16x8 pa2,bf16x8 pa3){
  #pragma unroll
  for(int d0=0;d0<2;++d0){s16x4 lo[4],hi[4];
    #pragma unroll
    for(int ks=0;ks<4;++ks){
      asm volatile("ds_read_b64_tr_b16 %0,%1 offset:%c2":"=&v"(lo[ks]):"v"(vb),"i"(d0*4096+ks*1024):"memory");
      asm volatile("ds_read_b64_tr_b16 %0,%1 offset:%c2":"=&v"(hi[ks]):"v"(vb),"i"(d0*4096+ks*1024+512):"memory");}
    asm volatile("s_waitcnt lgkmcnt(0)":::"memory");SBAR();
    #define PK(k) (bf16x8){lo[k][0],lo[k][1],lo[k][2],lo[k][3],hi[k][0],hi[k][1],hi[k][2],hi[k][3]}
    o[d0]=__builtin_amdgcn_mfma_f32_32x32x16_bf16(pa0,PK(0),o[d0],0,0,0);
    o[d0]=__builtin_amdgcn_mfma_f32_32x32x16_bf16(pa1,PK(1),o[d0],0,0,0);
    o[d0]=__builtin_amdgcn_mfma_f32_32x32x16_bf16(pa2,PK(2),o[d0],0,0,0);
    o[d0]=__builtin_amdgcn_mfma_f32_32x32x16_bf16(pa3,PK(3),o[d0],0,0,0);
    #undef PK
  }
}

#ifndef ATTN_STORE16
#define ATTN_STORE16(p,v) (*(u32x4*)(p)=(v))
#endif
template<int THRL,int PO,bool MASK,bool BIAS> __device__ __forceinline__ void attn_unit(int q0,int NT,int qoff,int PQ,int PKV,int PG,const bf16*Qh,const bf16*__restrict__ Kh,const bf16*__restrict__ Vh,const bf16*__restrict__ Gh,bf16*Oh,const float*__restrict__ cfl,const __attribute__((address_space(3))) float* offp,float cref,char*shm){
  int tid=threadIdx.x; asm volatile("":"+v"(tid)); const int lane=tid&63,r32=lane&31,hi=lane>>5; const int wid=__builtin_amdgcn_readfirstlane(tid>>6);
  const bf16*Qw=Qh+(long)(q0+wid*QBLK)*PQ;
  const unsigned lds0=(unsigned)(uintptr_t)shm;
  float*wsf=(float*)(shm+LDS_WS)+wid*64;
  const bf16*ksrc=Kh+(long)lane*PKV+wid*8;
  const bf16*vsrc=Vh+(long)(16*(wid&3)+(lane>>2))*PKV+(wid>>2)*32+(lane&3)*8;
  const unsigned kdst=lds0+LDS_K+wid*1024, vdst=lds0+LDS_V+wid*1024;
  #define DMA_K(t,slot) glds16(ksrc+(long)(t)*KVBLK*PKV,(unsigned)__builtin_amdgcn_readfirstlane(kdst+(slot)))
  #define DMA_V(t,slot) glds16(vsrc+(long)(t)*KVBLK*PKV,(unsigned)__builtin_amdgcn_readfirstlane(vdst+(slot)))
  const int vb0=(int)(lds0+LDS_V)+((lane>>4)&1)*32+(lane&3)*8+(4*hi+((lane&15)>>2))*64;
  const char*Kbase=shm+LDS_K; bf16x8 kf[8];
  const lds_cptr shm3=(lds_cptr)shm; const lds_cptr kp0=shm3+LDS_K+hi*1024+r32*16; const lds_cptr vp0=shm3+LDS_V+((lane>>4)&1)*32+(lane&3)*8+(4*hi+((lane&15)>>2))*64;
  typedef __attribute__((address_space(3))) const f32x4_t* lds_f4p; const lds_f4p biasp=(lds_f4p)(shm3+LDS_BIAS+16*hi);
  if(BIAS){ __attribute__((address_space(3))) float* bw=(__attribute__((address_space(3))) float*)(shm3+LDS_BIAS); for(int i=tid;i<NT*KVBLK;i+=NW*64) bw[i]=cref-(cfl[i]+offp[i>>6]); }
  DMA_K(0,0);DMA_V(0,0);DMA_K(1,SLOTB);
  bf16x8 qr[4];
  #pragma unroll
  for(int d0=0;d0<4;++d0)qr[d0]=*reinterpret_cast<const bf16x8*>(&Qw[(long)r32*PQ+d0*16+hi*8]);
  float mhat=0.f,l_reg=0.f;f32x16 o[2];o[0]=f32x16{};o[1]=f32x16{};const f32x16 zero16=f32x16{};
  const int qrel=wid*QBLK+r32+qoff;
  #define CMASK(P0,P1,t) do{ if(MASK){int jb_=(t)-(NT-4); if(jb_>=0)cmask(P0,P1,jb_,qrel,hi);} }while(0)
  #define ADDB(P0,P1,t) do{ if(BIAS){ _Pragma("unroll") for(int g_=0;g_<4;++g_){ const f32x4_t b0_=biasp[(t)*16+2*g_], b1_=biasp[(t)*16+8+2*g_]; \
      P0[4*g_]+=b0_[0];P0[4*g_+1]+=b0_[1];P0[4*g_+2]+=b0_[2];P0[4*g_+3]+=b0_[3]; P1[4*g_]+=b1_[0];P1[4*g_+1]+=b1_[1];P1[4*g_+2]+=b1_[2];P1[4*g_+3]+=b1_[3]; SBAR(); } } }while(0)
  bool resc=false;
  #define START(P0,P1) do{ const float rm=rowmax(P0,P1); resc=false; \
    { const float dl=rm; mhat=fadd_s(mhat,dl); \
      _Pragma("unroll") for(int r=0;r<16;++r){P0[r]=fsub_s(P0[r],dl);P1[r]=fsub_s(P1[r],dl);} } \
    _Pragma("unroll") for(int r=0;r<16;++r)P0[r]=__builtin_amdgcn_exp2f(P0[r]); }while(0)
  #define RESC() do{ if(resc){ asm volatile("s_waitcnt lgkmcnt(0)":::"memory"); \
      _Pragma("unroll") for(int d_=0;d_<2;++d_) _Pragma("unroll") for(int r=0;r<16;++r)o[d_][r]*=wsf[crow(r,hi)]; } }while(0)
  f32x16 pA0,pA1,pB0,pB1;
  int sl_prev=0,sl_cur=0,sl_next=SLOTB;
  #define ROT() do{sl_prev=sl_cur;sl_cur=sl_next;sl_next=(sl_next==(NSLOT-1)*SLOTB)?0:sl_next+SLOTB;}while(0)
  DMA_K(2,2*SLOTB);
  WAIT_BAR(3);
  qkt(pA0,pA1,Kbase,qr,zero16,r32,hi);asm volatile("s_nop 15\n\ts_nop 7":"+v"(pA0),"+v"(pA1));CMASK(pA0,pA1,0);ADDB(pA0,pA1,0);
  START(pA0,pA1);
  _Pragma("unroll") for(int r=0;r<16;++r)pA1[r]=__builtin_amdgcn_exp2f(pA1[r]);
  WAIT_BAR(0);
  DMA_K(3,0);DMA_V(1,SLOTB);
  ROT();
  kload8(kf,kp0+sl_cur);
  WAIT_BAR(2);
  s16x4 vlo[8],vhi[8]; u32x4 pw0,pw1,pw2,pw3;
  #define PKW(P,B) cvtpk_s(P[B],P[B+1])
  #define PAF(k) __builtin_bit_cast(bf16x8,pw##k)
  #define VFR(i) (bf16x8){vlo[i][0],vlo[i][1],vlo[i][2],vlo[i][3],vhi[i][0],vhi[i][1],vhi[i][2],vhi[i][3]}
  #define PIN(x) asm volatile("":"+v"(x))
  #define MX3(a,b,c) __builtin_fmaxf(__builtin_fmaxf((a),(b)),(c))
  #define GAPA(MF,A0,A1,A2,A3,W0,W1,PW) do{ MF; sacc+=A0; sacc+=A1; sacc+=A2; sacc+=A3; PIN(sacc); W0; W1; PIN(PW); SBAR(); }while(0)
  #define EX(v) __builtin_amdgcn_exp2f(v)
  #define GAPB(MF,X,B) do{ MF; X[B]=EX(X[B]); X[B+1]=EX(X[B+1]); X[B+2]=EX(X[B+2]); X[B+3]=EX(X[B+3]); PIN(X); SBAR(); }while(0)
  #define VRD(i) do{ vlo[i]=vtr(vp_+(((i)>>2)*4096+((i)&3)*1024)); vhi[i]=vtr(vp_+(((i)>>2)*4096+((i)&3)*1024+512)); }while(0)
  #define KRD(G,j) do{ if(G){ kload2(kf,kp0+sl_next,j); SBAR(); } }while(0)
  #define STEP(C0,C1,P0,P1,t,GK,GV,GL) do{ SBAR(); \
    const lds_cptr vp_=vp0+sl_prev; \
    VRD(0); SBAR(); float sacc=(P0[0]+P0[1]); \
    GAPA(C0=__builtin_amdgcn_mfma_f32_32x32x16_bf16(kf[0],qr[0],zero16,0,0,0), P0[2],P0[3],P0[4],P0[5],     pw0[0]=PKW(P0,0), pw0[1]=PKW(P0,2), pw0); \
    VRD(4); SBAR(); GAPA(C1=__builtin_amdgcn_mfma_f32_32x32x16_bf16(kf[1],qr[0],zero16,0,0,0), P0[6],P0[7],P0[8],P0[9],     pw0[2]=PKW(P0,4), pw0[3]=PKW(P0,6), pw0); \
    VRD(1); SBAR(); GAPA(C0=__builtin_amdgcn_mfma_f32_32x32x16_bf16(kf[2],qr[1],C0,0,0,0),   P0[10],P0[11],P0[12],P0[13], pw1[0]=PKW(P0,8), pw1[1]=PKW(P0,10), pw1); \
    VRD(5); SBAR(); GAPA(C1=__builtin_amdgcn_mfma_f32_32x32x16_bf16(kf[3],qr[1],C1,0,0,0),   P0[14],P0[15],P1[0],P1[1],   pw1[2]=PKW(P0,12),pw1[3]=PKW(P0,14), pw1); \
    VRD(2); SBAR(); GAPA(C0=__builtin_amdgcn_mfma_f32_32x32x16_bf16(kf[4],qr[2],C0,0,0,0),   P1[2],P1[3],P1[4],P1[5],     pw2[0]=PKW(P1,0), pw2[1]=PKW(P1,2), pw2); \
    VRD(6); SBAR(); GAPA(C1=__builtin_amdgcn_mfma_f32_32x32x16_bf16(kf[5],qr[2],C1,0,0,0),   P1[6],P1[7],P1[8],P1[9],     pw2[2]=PKW(P1,4), pw2[3]=PKW(P1,6), pw2); \
    VRD(3); SBAR(); GAPA(C0=__builtin_amdgcn_mfma_f32_32x32x16_bf16(kf[6],qr[3],C0,0,0,0),   P1[10],P1[11],P1[12],P1[13], pw3[0]=PKW(P1,8), pw3[1]=PKW(P1,10), pw3); \
    VRD(7); SBAR(); GAPA(C1=__builtin_amdgcn_mfma_f32_32x32x16_bf16(kf[7],qr[3],C1,0,0,0),   P1[14],P1[15],0.f,0.f,       pw3[2]=PKW(P1,12),pw3[3]=PKW(P1,14), pw3); \
    l_reg+=sacc; \
    if(GK){DMA_K((t)+3,sl_cur);} if(GV){DMA_V((t)+1,sl_next);} \
    CMASK(C0,C1,t); ADDB(C0,C1,t); \
    { float a=MX3(C0[0],C0[1],C1[0]),b=MX3(C0[2],C0[3],C1[1]); a=MX3(a,C1[2],C1[3]); \
      _Pragma("unroll") for(int r=4;r<16;r+=4){a=MX3(a,C0[r],C0[r+1]);b=MX3(b,C0[r+2],C0[r+3]);a=MX3(a,C1[r],C1[r+1]);b=MX3(b,C1[r+2],C1[r+3]);} \
      float rm=__builtin_fmaxf(a,b); { auto rr=__builtin_amdgcn_permlane32_swap(__float_as_uint(rm),__float_as_uint(rm),false,false); rm=__builtin_fmaxf(__uint_as_float(rr[0]),__uint_as_float(rr[1])); } \
      resc=false; rm-=mhat; \
      if(__builtin_expect(__any(rm>(float)THRL),0)){ const float dl=__builtin_fmaxf(rm,0.f); mhat+=dl; \
        const float f=__builtin_amdgcn_exp2f(-dl); l_reg*=f; if(hi==0)wsf[r32]=f; resc=true; } \
      _Pragma("unroll") for(int r=0;r<16;++r){C0[r]-=mhat;C1[r]-=mhat;} } \
    SBAR(); \
    GAPB(o[0]=__builtin_amdgcn_mfma_f32_32x32x16_bf16(PAF(0),VFR(0),o[0],0,0,0), C0,0); \
    GAPB(o[1]=__builtin_amdgcn_mfma_f32_32x32x16_bf16(PAF(0),VFR(4),o[1],0,0,0), C0,4); \
    KRD(GL,0); GAPB(o[0]=__builtin_amdgcn_mfma_f32_32x32x16_bf16(PAF(1),VFR(1),o[0],0,0,0), C0,8); \
    KRD(GL,1); GAPB(o[1]=__builtin_amdgcn_mfma_f32_32x32x16_bf16(PAF(1),VFR(5),o[1],0,0,0), C0,12); \
    KRD(GL,2); GAPB(o[0]=__builtin_amdgcn_mfma_f32_32x32x16_bf16(PAF(2),VFR(2),o[0],0,0,0), C1,0); \
    KRD(GL,3); GAPB(o[1]=__builtin_amdgcn_mfma_f32_32x32x16_bf16(PAF(2),VFR(6),o[1],0,0,0), C1,4); \
    GAPB(o[0]=__builtin_amdgcn_mfma_f32_32x32x16_bf16(PAF(3),VFR(3),o[0],0,0,0), C1,8); \
    GAPB(o[1]=__builtin_amdgcn_mfma_f32_32x32x16_bf16(PAF(3),VFR(7),o[1],0,0,0), C1,12); \
    }while(0)
  int t=1;
  #undef CMASK
  #define CMASK(P0,P1,t) do{}while(0)
  for(;t+5<NT;t+=2){
    STEP(pB0,pB1,pA0,pA1,t,true,true,true);     WAIT_BAR(2); RESC(); ROT();
    STEP(pA0,pA1,pB0,pB1,t+1,true,true,true);   WAIT_BAR(2); RESC(); ROT();
  }
  #undef CMASK
  #define CMASK(P0,P1,t) do{ if(MASK){int jb_=(t)-(NT-4); if(jb_>=0)cmask(P0,P1,jb_,qrel,hi);} }while(0)
  #define ENDW(tt) do{ if((tt)+3<NT){WAIT_BAR(2);} else if((tt)+2<NT){WAIT_BAR(1);} else {WAIT_BAR(0);} }while(0)
  for(;t+1<NT;t+=2){
    STEP(pB0,pB1,pA0,pA1,t,(t+3<NT),(t+1<NT),(t+1<NT));       ENDW(t);   RESC(); ROT();
    STEP(pA0,pA1,pB0,pB1,t+1,(t+4<NT),(t+2<NT),(t+2<NT));     ENDW(t+1); RESC(); ROT();
  }
  STEP(pB0,pB1,pA0,pA1,NT-1,false,false,false); RESC();
  { float sacc=pB0[0]+pB0[1]; _Pragma("unroll") for(int r=2;r<16;++r)sacc+=pB0[r]; _Pragma("unroll") for(int r=0;r<16;++r)sacc+=pB1[r]; l_reg+=sacc;
    pw0=(u32x4){PKW(pB0,0),PKW(pB0,2),PKW(pB0,4),PKW(pB0,6)};pw1=(u32x4){PKW(pB0,8),PKW(pB0,10),PKW(pB0,12),PKW(pB0,14)};pw2=(u32x4){PKW(pB1,0),PKW(pB1,2),PKW(pB1,4),PKW(pB1,6)};pw3=(u32x4){PKW(pB1,8),PKW(pB1,10),PKW(pB1,12),PKW(pB1,14)};
    SBAR(); pv(o,vb0+sl_cur,PAF(0),PAF(1),PAF(2),PAF(3)); }
  #undef PKW
  #undef PAF
  #undef VFR
  #undef PIN
  #undef MX3
  #undef GAPA
  #undef GAPB
  #undef EX
  #undef VRD
  #undef KRD
  #undef STEP
  #undef ENDW
  {auto rr=__builtin_amdgcn_permlane32_swap(__float_as_uint(l_reg),__float_as_uint(l_reg),false,false);l_reg=__uint_as_float(rr[0])+__uint_as_float(rr[1]);}
  if(hi==0)wsf[32+r32]=l_reg;asm volatile("s_waitcnt lgkmcnt(0)":::"memory");
  float rli[16];
  #pragma unroll
  for(int r=0;r<16;++r)rli[r]=__builtin_amdgcn_rcpf(wsf[32+crow(r,hi)]);
  bf16*Ow=Oh+(long)(q0+wid*QBLK)*PO; const bf16*Gw=Gh+(long)(q0+wid*QBLK)*PG;
  u32x4 gt[4];
  #pragma unroll
  for(int i=0;i<4;++i)gt[i]=*(const u32x4*)(Gw+(long)(i*8+(lane>>3))*PG+(lane&7)*8);
  { bf16*stg=(bf16*)(shm+LDS_OST)+wid*2048;
    #pragma unroll
    for(int r=0;r<16;++r){const int orow=crow(r,hi);
      #pragma unroll
      for(int d0=0;d0<2;++d0)stg[orow*64+d0*32+r32]=__float2bfloat16(o[d0][r]*rli[r]);}
    asm volatile("s_waitcnt lgkmcnt(0)":::"memory");
    #pragma unroll
    for(int i=0;i<4;++i){const int row=i*8+(lane>>3),ch=lane&7; const u32x4 v=*(const u32x4*)(stg+row*64+ch*8); u32x4 w;
      #pragma unroll
      for(int e=0;e<4;++e){ const float a0=__uint_as_float(v[e]<<16)*__uint_as_float(gt[i][e]<<16), a1=__uint_as_float(v[e]&0xffff0000u)*__uint_as_float(gt[i][e]&0xffff0000u); w[e]=cvtpk_s(a0,a1); }
      ATTN_STORE16(Ow+(long)row*PO+ch*8,w);} }
  asm volatile("s_waitcnt lgkmcnt(0)\n\ts_barrier":::"memory");
  #undef DMA_K
  #undef DMA_V
  #undef CMASK
  #undef START
  #undef RESC
  #undef ADDB
  #undef ROT
}
constexpr int ATTN_LDS_BYTES=LDS_BYTES;
#undef SBAR
#undef WAIT_BAR
}

constexpr int NWAVES = 8;
#ifndef MK_N_LAUNCHES
#define MK_N_LAUNCHES 1
#endif
#ifndef PROBE_DUP
#define PROBE_DUP -1
#endif
#ifndef PROBE_T
#define PROBE_T -1
#endif
#ifndef PROBE_T2
#define PROBE_T2 (PROBE_T + 1)
#endif
#define STAMPW(k, w) do { if (PROBE_T >= 0 && blockIdx.x == 0 && tid == 64 * (w)) ((volatile LAS unsigned long long*)(lds + 153600 + 7424))[k] = __builtin_amdgcn_s_memrealtime(); } while (0)
#define STAMP(k) do { if (PROBE_T >= 0 && blockIdx.x == 0 && tid == 0) ((volatile LAS unsigned long long*)(lds + 153600 + 7424))[k] = __builtin_amdgcn_s_memrealtime(); } while (0)
#define NREP(k) ((PROBE_DUP == (k)) ? 2 : 1)
constexpr int PER_PHASE = 5;
constexpr int N_LAUNCHES = MK_N_LAUNCHES;

constexpr int M = 16384, D = 1024;
constexpr int IN_COLS = 3222, NP = 3072;
constexpr int MEM_LEN = 256;
constexpr float EPS = 1e-6f;
constexpr float LOG2E = 1.4426950408889634f;
constexpr size_t MiB = 1u << 20;
constexpr size_t WS_CTL = 0, CTL_ZERO_BYTES = 1 * MiB;
constexpr size_t WS_ZERO = 512 * 1024;
constexpr size_t WS_WIN = 2 * MiB;
constexpr size_t WS_WOUTF = 9 * MiB;
constexpr size_t WS_WSF = 11 * MiB;
constexpr size_t WS_MK = 12 * MiB + 512 * 1024, WS_MV = WS_MK + 128 * 1024;
constexpr size_t WS_X = 13 * MiB;
constexpr size_t WS_XN = 16 * MiB;
constexpr size_t WS_FQ = 48 * MiB, WS_FK = 60 * MiB, WS_FV = 72 * MiB, WS_FG = 84 * MiB;
constexpr size_t WS_MQ = 96 * MiB, WS_MG = 104 * MiB;
constexpr size_t WS_GQ = 112 * MiB, WS_GK = 118 * MiB;
constexpr size_t WS_GV = 124 * MiB, WS_GG = 136 * MiB;
constexpr size_t WS_GLR = 148 * MiB;
constexpr size_t WS_FFG = 149 * MiB;
constexpr size_t WS_CFL = 149 * MiB + 512 * 1024;
constexpr size_t WS_TOT = 149 * MiB + 512 * 1024 + 6 * 16384 * 4;
constexpr size_t WS_KVT = 150 * MiB;
constexpr size_t WS_DEC = 168 * MiB;
constexpr size_t WS_ST = 169 * MiB;
constexpr size_t WS_MIX = 192 * MiB;
constexpr size_t WS_GB = 224 * MiB;
constexpr size_t WS_END = 240 * MiB;
static_assert(WS_GLR + (size_t)M * 16 * 4 == WS_FFG, "g_lr | f_fg adjacency (EpiRoute mode 3)");
constexpr int CW_TMO = 0, CW_CODE = 1;
constexpr int CW_Q3 = 64;
constexpr int CW_NMAX = 128;
constexpr float ACP_THRESH = 50.f;
constexpr int CW_BAR = 4096;
constexpr int CW_SEAM = 16384;
static_assert((CW_SEAM + 2 * 64 * 64) * 4 <= (int)CTL_ZERO_BYTES, "CTL words inside the memset region");
constexpr int RING_OFF = 0, RING_BYTES = 151552;
constexpr int LDSCTL_OFF = RING_BYTES, MISC_OFF = LDSCTL_OFF + 320;
constexpr int OFFT_OFF = 153600, OFFT_ROW = 257;
constexpr int LDS_BYTES = 153600 + 8 * 1024;
static_assert(MISC_OFF + 128 <= OFFT_OFF && LDS_BYTES <= 163840 && attn_body::ATTN_LDS_BYTES <= RING_BYTES && pg8::STAGE_BYTES <= RING_BYTES, "LDS map");

#define GAS __attribute__((address_space(1)))
#define LAS __attribute__((address_space(3)))
typedef unsigned short bf16;
typedef unsigned v4u __attribute__((ext_vector_type(4)));
typedef float f32x4 __attribute__((ext_vector_type(4)));
typedef short bf16x8 __attribute__((ext_vector_type(8)));
typedef GAS unsigned gu32;
typedef GAS unsigned long long gu64;
#define RLX_AGENT __ATOMIC_RELAXED, __HIP_MEMORY_SCOPE_AGENT
#define LDS_WAIT() asm volatile("s_waitcnt lgkmcnt(0)" ::: "memory")
#define VM_WAIT() asm volatile("s_waitcnt vmcnt(0)" ::: "memory")
__device__ __forceinline__ unsigned long long rt() { return __builtin_amdgcn_s_memrealtime(); }
__device__ __forceinline__ unsigned f2bf(float f) { unsigned u = __builtin_bit_cast(unsigned, f); return (u + 0x7fffu + ((u >> 16) & 1u)) >> 16; }
__device__ __forceinline__ unsigned pk2(float lo, float hi) { return f2bf(lo) | (f2bf(hi) << 16); }

#define XB_TMO      128
#define XB_XCNT(j)  (256  + 64 * (j))
#define XB_XSUB(j)  (1280 + 64 * (j))
#define XB_XGEN(j)  (2304 + 64 * (j))
#define XB_TOP      3328
#define XB_TOPGEN   3392
#define XCD_BAR_WORDS 3456
#define XB_SPIN_CAP (1u << 18)

__device__ __forceinline__ unsigned xb_ld(unsigned* p)              { return __hip_atomic_load(p, __ATOMIC_RELAXED, __HIP_MEMORY_SCOPE_AGENT); }
__device__ __forceinline__ unsigned xb_add(unsigned* p, unsigned v) { return __hip_atomic_fetch_add(p, v, __ATOMIC_RELAXED, __HIP_MEMORY_SCOPE_AGENT); }
__device__ __forceinline__ unsigned xb_xcc_id() { return (unsigned)__builtin_amdgcn_s_getreg((3 << 11) | 20) & 0xFu; }
#define XB_SPIN(cond, bar) do { unsigned _sp = 0; while (cond) { __builtin_amdgcn_s_sleep(1); \
    if ((++_sp & 255u) == 0u) { if (xb_ld(&(bar)[XB_TMO])) break; if (_sp > XB_SPIN_CAP) { atomicAdd(&(bar)[XB_TMO], 1u); break; } } } } while (0)

struct XcdBarrier {
    unsigned* bar; unsigned x;
    volatile LAS unsigned* st;
};

__device__ __forceinline__ XcdBarrier xcd_barrier_post(unsigned* bar, volatile LAS unsigned* st) {
    XcdBarrier b; b.bar = bar; b.x = xb_xcc_id(); b.st = st;
    if (threadIdx.x == 0) (void)xb_add(&bar[XB_XCNT(b.x)], 1u);
    return b;
}
__device__ __forceinline__ void xcd_barrier_complete(unsigned* bar, unsigned x, unsigned& nloc, unsigned& nx) {
    const unsigned G = gridDim.x * gridDim.y * gridDim.z;
    unsigned sum, cnt, mine, sp = 0u;
    for (;;) {
        sum = 0u; cnt = 0u; mine = 0u;
#pragma unroll
        for (unsigned j = 0; j < 16; ++j) { const unsigned c = xb_ld(&bar[XB_XCNT(j)]); sum += c; cnt += (c > 0u) ? 1u : 0u; mine = (j == x) ? c : mine; }
        if (sum == G) break;
        __builtin_amdgcn_s_sleep(1);
        if ((++sp & 255u) == 0u) { if (xb_ld(&bar[XB_TMO])) break; if (sp > XB_SPIN_CAP) { atomicAdd(&bar[XB_TMO], 1u); break; } }
    }
    nloc = mine > 0u ? mine : 1u; nx = cnt > 0u ? cnt : 1u;
}

__device__ __forceinline__ void xcd_barrier(const XcdBarrier& b) {
    asm volatile("s_waitcnt vmcnt(0)" ::: "memory");
    __syncthreads();
    if (threadIdx.x == 0) {
        unsigned* bar = b.bar;
        __builtin_amdgcn_s_waitcnt(0);
        unsigned nloc = b.st[0], nx = b.st[1];
        if (nloc == 0u) { xcd_barrier_complete(bar, b.x, nloc, nx); b.st[0] = nloc; b.st[1] = nx; }
        const unsigned old = xb_add(&bar[XB_XSUB(b.x)], 1u);
        const unsigned gen = old / nloc;
        if (old + 1u == (gen + 1u) * nloc) {
            __builtin_amdgcn_fence(__ATOMIC_RELEASE, "agent");
            asm volatile("s_waitcnt vmcnt(0)" ::: "memory");
            const unsigned og = xb_add(&bar[XB_TOP], 1u);
            const unsigned tg = og / nx;
            if (og + 1u == (tg + 1u) * nx) xb_add(&bar[XB_TOPGEN], 1u);
            else XB_SPIN(xb_ld(&bar[XB_TOPGEN]) == tg, bar);
            __builtin_amdgcn_fence(__ATOMIC_ACQUIRE, "agent");
            xb_add(&bar[XB_XGEN(b.x)], 1u);
            asm volatile("s_waitcnt vmcnt(0)" ::: "memory");
        } else {
            XB_SPIN(xb_ld(&bar[XB_XGEN(b.x)]) == gen, bar);
            __builtin_amdgcn_fence(__ATOMIC_ACQUIRE, "agent");
            asm volatile("s_waitcnt vmcnt(0)" ::: "memory");
        }
    }
    __syncthreads();
}


__device__ __forceinline__ pg8::Route pg8::EpiRoute::route(int g32) const {
    Route R; R.mode = 0; R.col = 0; R.pitch = 384; size_t off;
    if (g32 < 12) { off = WS_FQ; R.col = g32 * 32; R.mode = 1; }
    else if (g32 < 24) { off = WS_FK; R.col = (g32 - 12) * 32; }
    else if (g32 < 36) { off = WS_FV; R.col = (g32 - 24) * 32; }
    else if (g32 < 48) { off = WS_FG; R.col = (g32 - 36) * 32; R.mode = 2; }
    else if (g32 < 56) { off = WS_MQ; R.col = (g32 - 48) * 32; R.pitch = 256; R.mode = 1; }
    else if (g32 < 64) { off = WS_MG; R.col = (g32 - 56) * 32; R.pitch = 256; R.mode = 2; }
    else if (g32 < 70) { off = WS_GQ; R.col = (g32 - 64) * 32; R.pitch = 192; }
    else if (g32 < 76) { off = WS_GK; R.col = (g32 - 70) * 32; R.pitch = 192; }
    else if (g32 < 88) { off = WS_GV; R.col = (g32 - 76) * 32; }
    else { off = WS_GG; R.col = (g32 - 88) * 32; R.mode = 2; }
    R.base = (bf16_t*)(ws + off); return R;
}

template <int CTRL> __device__ __forceinline__ float dppf(float x) { return __builtin_bit_cast(float, __builtin_amdgcn_mov_dpp(__builtin_bit_cast(int, x), CTRL, 0xf, 0xf, true)); }
__device__ __forceinline__ float half_sum(float v) {
    v += dppf<0xB1>(v); v += dppf<0x4E>(v); v += dppf<0x141>(v); v += dppf<0x140>(v);
    auto s = __builtin_amdgcn_permlane16_swap(__float_as_uint(v), __float_as_uint(v), false, false);
    return __uint_as_float(s[0]) + __uint_as_float(s[1]);
}
__device__ __forceinline__ float wave_sum(float v) {
#pragma unroll
    for (int o = 1; o < 64; o <<= 1) v += __shfl_xor(v, o);
    return v;
}
__device__ __forceinline__ void p0_transpose_item(const float* W, int K, int N, bf16* WT, int n0, int nv, int drow0, int k0, LAS float* scr, int lane) {
    float tv[32];
#pragma unroll
    for (int i = 0; i < 32; ++i) { const int kk = 2 * i + (lane >> 5), nn = lane & 31; tv[i] = W[(size_t)(k0 + kk) * N + n0 + (nn < nv ? nn : 0)]; }
#pragma unroll
    for (int i = 0; i < 32; ++i) { const int kk = 2 * i + (lane >> 5), nn = lane & 31; scr[kk * 33 + nn] = nn < nv ? tv[i] : 0.f; }
    LDS_WAIT(); asm volatile("" ::: "memory");
    const int c = lane & 7;
#pragma unroll
    for (int j = 0; j < 4; ++j) { const int n = (lane >> 3) + 8 * j; const LAS float* s = scr + (8 * c) * 33 + n;
        v4u o; o.x = pk2(s[0 * 33], s[1 * 33]); o.y = pk2(s[2 * 33], s[3 * 33]); o.z = pk2(s[4 * 33], s[5 * 33]); o.w = pk2(s[6 * 33], s[7 * 33]);
        if (n < nv) *(GAS v4u*)(WT + (size_t)(drow0 + n) * K + k0 + 8 * c) = o; }
    LDS_WAIT(); asm volatile("" ::: "memory");
}
__device__ __forceinline__ void rms_row_to_bf16(const float* xrow, const float* g, bf16* orow, int lane) {
    const GAS f32x4* xr = (const GAS f32x4*)xrow + lane; const GAS f32x4* gr = (const GAS f32x4*)g + lane;
    f32x4 v[4]; float s = 0.f;
#pragma unroll
    for (int j = 0; j < 4; ++j) { v[j] = xr[64 * j]; s += (v[j].x * v[j].x + v[j].y * v[j].y) + (v[j].z * v[j].z + v[j].w * v[j].w); }
    const float rstd = 1.f / sqrtf(wave_sum(s) * (1.f / D) + EPS);
    GAS unsigned long long* o8 = (GAS unsigned long long*)orow + lane;
#pragma unroll
    for (int j = 0; j < 4; ++j) { const f32x4 gg = gr[64 * j]; o8[64 * j] = (unsigned long long)pk2(v[j].x * rstd * gg.x, v[j].y * rstd * gg.y) | ((unsigned long long)pk2(v[j].z * rstd * gg.z, v[j].w * rstd * gg.w) << 32); }
}
__device__ __forceinline__ void p0_mem_kv(LAS unsigned char* lds, int b, int tid, int wave, int lane, const float* mem, const float* g, const float* w, unsigned char* ws) {
    const int rg = b >> 3, cg = b & 7, c = tid & 63, col = 64 * cg + c;
    LAS float* ML = (LAS float*)lds;
    LAS float* red = ML + 8 * 1024; LAS float* sq = red + 8 * 8 * 64;
    { float ss = 0.f;
#pragma unroll
      for (int i = 0; i < 4; ++i) { const f32x4 m = *(const GAS f32x4*)(mem + (size_t)(8 * rg + wave) * D + 256 * i + 4 * lane); const f32x4 gg = *(const GAS f32x4*)(g + 256 * i + 4 * lane);
          ss += (m.x * m.x + m.y * m.y) + (m.z * m.z + m.w * m.w); *(LAS f32x4*)(ML + wave * 1024 + 256 * i + 4 * lane) = m * gg; }
      ss = wave_sum(ss); if (lane == 0) sq[wave] = ss; }
    __syncthreads();
    float acc[8];
#pragma unroll
    for (int r = 0; r < 8; ++r) acc[r] = 0.f;
    const float* wp = w + (size_t)(128 * wave) * 512 + col;
    float wall[128];
#pragma unroll
    for (int k = 0; k < 128; ++k) wall[k] = wp[(size_t)k * 512];
#pragma unroll
    for (int k4 = 0; k4 < 32; ++k4) { float wv[4];
#pragma unroll
        for (int j = 0; j < 4; ++j) wv[j] = wall[4 * k4 + j];
#pragma unroll
        for (int r = 0; r < 8; ++r) { const f32x4 m = *(const LAS f32x4*)(ML + r * 1024 + 128 * wave + 4 * k4); acc[r] += (m.x * wv[0] + m.y * wv[1]) + (m.z * wv[2] + m.w * wv[3]); } }
#pragma unroll
    for (int r = 0; r < 8; ++r) red[(wave * 8 + r) * 64 + c] = acc[r];
    __syncthreads();
    { const int r = tid >> 6; float a = 0.f;
#pragma unroll
      for (int wv = 0; wv < 8; ++wv) a += red[(wv * 8 + r) * 64 + c];
      const float o = a / sqrtf(sq[r] * (1.f / D) + EPS);
      bf16* dst = (bf16*)(ws + (col < 256 ? WS_MK : WS_MV)) + (size_t)(8 * rg + r) * 256 + (col & 255);
      *dst = (bf16)f2bf(o); }
    __syncthreads();
}
__device__ __forceinline__ void p0_prologue(LAS unsigned char* lds, int vcu, int G, int tid, int wave, int lane, const float* x, const float* mem, const float* norm_g, const float* w_in, const float* mem_norm_g,
                                            const float* w_mem_kv, const float* w_out, unsigned char* ws) {
    LAS float* scr = (LAS float*)(lds + RING_OFF + wave * 16384);
    const int gw = vcu * 4 + (wave & 3), NGW = G * 4;
    constexpr int NB_IN = 96, I_IN = NB_IN * 16, I_OUT = 32 * 16, I_SK = 5 * 16, NITEMS = I_IN + I_OUT + I_SK;
    int nwi = 0;
    if (wave >= 4)
    for (int it = gw; it < NITEMS; it += NGW) {
        STAMPW(40 + nwi, 4); ++nwi;
        if (it < I_IN) {
            const int nb = it >> 4, kb = it & 15; int src, width, dst, b = nb;
            if (b < 6) { src = 0; width = 192; dst = 2048; }
            else if ((b -= 6) < 6) { src = 192; width = 192; dst = 2240; }
            else if ((b -= 6) < 12) { src = 384; width = 384; dst = 2432; }
            else if ((b -= 12) < 8) { src = 784; width = 256; dst = 2816; }
            else if ((b -= 8) < 12) { src = 1168; width = 384; dst = 0; }
            else if ((b -= 12) < 12) { src = 1552; width = 384; dst = 384; }
            else if ((b -= 12) < 12) { src = 1936; width = 384; dst = 768; }
            else if ((b -= 12) < 12) { src = 2326; width = 384; dst = 1152; }
            else if ((b -= 12) < 8) { src = 2710; width = 256; dst = 1536; }
            else { b -= 8; src = 2966; width = 256; dst = 1792; }
            const int nv = (width - 32 * b) < 32 ? (width - 32 * b) : 32;
            p0_transpose_item(w_in, D, IN_COLS, (bf16*)(ws + WS_WIN), src + 32 * b, nv, dst + 32 * b, 64 * kb, scr, lane);
        } else if (it < I_IN + I_OUT) { const int r = it - I_IN, nt = r >> 4, kq = r & 15;
#pragma unroll
            for (int u = 0; u < 4; ++u) { const int ks = 4 * kq + u; const float* src = w_out + (size_t)(16 * ks + 8 * (lane >> 5)) * D + 32 * nt + (lane & 31);
                v4u o; o.x = pk2(src[0 * D], src[1 * D]); o.y = pk2(src[2 * D], src[3 * D]); o.z = pk2(src[4 * D], src[5 * D]); o.w = pk2(src[6 * D], src[7 * D]);
                *((GAS v4u*)(ws + WS_WOUTF) + (size_t)(nt * 64 + ks) * 64 + lane) = o; }
        } else { const int r = it - I_IN - I_OUT, ct = r >> 4, kq = r & 15; const int r32 = lane & 31;
            int col = -1; if (ct < 4) col = 784 + 256 + 32 * ct + r32; else if (r32 < 16) col = 768 + r32; else if (r32 < 22) col = 2320 + (r32 - 16);
#pragma unroll
            for (int u = 0; u < 4; ++u) { const int ks = 4 * kq + u; const float* src = w_in + (size_t)(16 * ks + 8 * (lane >> 5)) * IN_COLS + (col < 0 ? 0 : col);
                v4u o; o.x = pk2(src[0 * IN_COLS], src[1 * IN_COLS]); o.y = pk2(src[2 * IN_COLS], src[3 * IN_COLS]); o.z = pk2(src[4 * IN_COLS], src[5 * IN_COLS]); o.w = pk2(src[6 * IN_COLS], src[7 * IN_COLS]);
                if (col < 0) o = (v4u){0u, 0u, 0u, 0u};
                *((GAS v4u*)(ws + WS_WSF) + (size_t)(ct * 64 + ks) * 64 + lane) = o; } }
    }
    STAMPW(27, 4);
    {
      f32x4 gg[4];
#pragma unroll
      for (int j = 0; j < 4; ++j) gg[j] = ((const GAS f32x4*)norm_g)[64 * j + lane];
      int nxb = 0;
      if (wave < 4)
      for (int m0 = 16 * gw; m0 < 16 * gw + 16; m0 += 4) { f32x4 v[4][4]; float ss[4]; STAMP(44 + nxb); ++nxb;
#pragma unroll
          for (int q = 0; q < 4; ++q) { const int m = m0 + q; const GAS f32x4* xr = (const GAS f32x4*)(x + (size_t)(m < M ? m : 0) * D) + lane;
#pragma unroll
              for (int j = 0; j < 4; ++j) v[q][j] = xr[64 * j]; }
#pragma unroll
          for (int q = 0; q < 4; ++q) { float a = 0.f;
#pragma unroll
              for (int j = 0; j < 4; ++j) a += (v[q][j].x * v[q][j].x + v[q][j].y * v[q][j].y) + (v[q][j].z * v[q][j].z + v[q][j].w * v[q][j].w);
              ss[q] = a; }
#pragma unroll
          for (int q = 0; q < 4; ++q) { float a = half_sum(ss[q]); auto t = __builtin_amdgcn_permlane32_swap(__float_as_uint(a), __float_as_uint(a), false, false); ss[q] = __uint_as_float(t[0]) + __uint_as_float(t[1]); }
#pragma unroll
          for (int q = 0; q < 4; ++q) { const int m = m0 + q; if (m < M) { const float rstd = 1.f / sqrtf(ss[q] * (1.f / D) + EPS);
              GAS unsigned long long* o8 = (GAS unsigned long long*)((bf16*)(ws + WS_XN) + (size_t)m * D) + lane;
#pragma unroll
              for (int j = 0; j < 4; ++j) { const unsigned long long w8 = (unsigned long long)pk2(v[q][j].x * rstd * gg[j].x, v[q][j].y * rstd * gg[j].y) | ((unsigned long long)pk2(v[q][j].z * rstd * gg[j].z, v[q][j].w * rstd * gg[j].w) << 32);
                  o8[64 * j] = w8; } } } } }
    STAMP(21);
    for (int rq = 0; rq < NREP(52); ++rq)
    for (int b = vcu; b < 256; b += G) p0_mem_kv(lds, b, tid, wave, lane, mem, mem_norm_g, w_mem_kv, ws);
}
__device__ __forceinline__ void nan_rows_f32(int vcu, int G, int wave, int lane, float* out) {
    const int gw = vcu * NWAVES + wave, NGW = G * NWAVES; const float q = __builtin_nanf("");
    for (int m = gw; m < M; m += NGW) { GAS f32x4* o = (GAS f32x4*)(out + (size_t)m * D) + lane;
#pragma unroll
        for (int j = 0; j < 4; ++j) o[64 * j] = (f32x4){q, q, q, q}; }
}
__device__ __forceinline__ void glds16(const void* gsrc, unsigned lds_dst) { unsigned keep;
    asm volatile("s_mov_b32 %0, m0\n\ts_mov_b32 m0, %2\n\ts_nop 0\n\tglobal_load_lds_dwordx4 %1, off\n\ts_mov_b32 m0, %0" : "=&s"(keep) : "v"(gsrc), "s"(lds_dst) : "memory"); }
__device__ __forceinline__ float log_sigmoid(float z) { return fminf(z, 0.f) - log1pf(__expf(-fabsf(z))); }
__device__ __forceinline__ float log_sigmoid_fast(float z) { const float t = __builtin_amdgcn_exp2f(-LOG2E * fabsf(z)); return fminf(z, 0.f) - 0.6931471805599453f * __builtin_amdgcn_logf(1.f + t); }
__device__ __forceinline__ float bf_lo(unsigned u) { return __uint_as_float(u << 16); }
__device__ __forceinline__ float bf_hi(unsigned u) { return __uint_as_float(u & 0xffff0000u); }
__device__ __forceinline__ void gla_cum_decay(float (&b)[24], const float* glr_row, const LAS float* w_up, const LAS float* b_alpha, int w, int lane) {
    f32x4 g4[4];
#pragma unroll
    for (int i = 0; i < 4; ++i) g4[i] = *(const f32x4*)(glr_row + 4 * i);
#pragma unroll
    for (int jj = 0; jj < 24; ++jj) { const int j = 24 * w + jj; float z = b_alpha[j];
#pragma unroll
        for (int r = 0; r < 16; ++r) z += g4[r >> 2][r & 3] * w_up[r * 192 + j];
        float v = log_sigmoid(z) * (1.f / 16.f);
#pragma unroll
        for (int d = 1; d < 64; d <<= 1) { const float o = __shfl_up(v, d); if (lane >= d) v += o; }
        b[jj] = v; }
}
constexpr int GL_VT = 0, GL_VT_PITCH = 72, GL_VT_BYTES = 384 * GL_VT_PITCH * 2;
constexpr int GL_KT = GL_VT_BYTES, GL_KT_PITCH = 72, GL_KT_BYTES = 192 * GL_KT_PITCH * 2;
constexpr int GL_QD = GL_VT_BYTES, GL_QD_PITCH = 200, GL_QD_BYTES = 64 * GL_QD_PITCH * 2;
constexpr int GL_KD = GL_QD + GL_QD_BYTES;
constexpr int GL_AT = GL_QD, GL_AT_PITCH = 72, GL_AT_WAVE = 32 * GL_AT_PITCH * 2;
constexpr int GL_W = 112 * 1024, GL_BA = GL_W + 16 * 192 * 4;
static_assert(GL_KD + GL_QD_BYTES <= GL_W && GL_KT + GL_KT_BYTES <= GL_W && GL_BA + 192 * 4 <= RING_BYTES && GL_AT + 8 * GL_AT_WAVE <= GL_KD + GL_QD_BYTES + 65536 && GL_AT + 8 * GL_AT_WAVE <= RING_BYTES, "GLA LDS map");
__device__ __forceinline__ void gla_stage_vt(LAS unsigned char* lds, const bf16* GV, int t0, int tid, const float* w_up, const float* b_alpha) {
    for (int i = tid; i < 16 * 192 / 4; i += 512) ((LAS f32x4*)(lds + GL_W))[i] = ((const GAS f32x4*)w_up)[i];
    if (tid < 48) ((LAS f32x4*)(lds + GL_BA))[tid] = ((const GAS f32x4*)b_alpha)[tid];
#pragma unroll
    for (int i = 0; i < 6; ++i) { const int q = tid + 512 * i, c = q & 63, cc = q >> 6;
        const v4u d = *(const GAS v4u*)(GV + (size_t)(t0 + c) * 384 + 8 * cc);
        LAS unsigned short* p = (LAS unsigned short*)(lds + GL_VT) + (8 * cc) * GL_VT_PITCH + c;
        p[0 * GL_VT_PITCH] = (unsigned short)(d.x & 0xffffu); p[1 * GL_VT_PITCH] = (unsigned short)(d.x >> 16); p[2 * GL_VT_PITCH] = (unsigned short)(d.y & 0xffffu); p[3 * GL_VT_PITCH] = (unsigned short)(d.y >> 16);
        p[4 * GL_VT_PITCH] = (unsigned short)(d.z & 0xffffu); p[5 * GL_VT_PITCH] = (unsigned short)(d.z >> 16); p[6 * GL_VT_PITCH] = (unsigned short)(d.w & 0xffffu); p[7 * GL_VT_PITCH] = (unsigned short)(d.w >> 16); }
}
constexpr int P2_VT = 0, P2_KT = GL_VT_BYTES, P2_BL = P2_KT + GL_KT_BYTES, P2_BL_PITCH = 193;
constexpr int P2_GLR = 133 * 1024, P2_LF = P2_GLR + 4096, P2_NRM = P2_LF + 1536;
static_assert(P2_BL + 64 * P2_BL_PITCH * 4 <= P2_GLR && P2_NRM + 64 <= RING_BYTES, "P2 LDS map");
__device__ __forceinline__ void p2_chunk_item(LAS unsigned char* lds, int n, int tid, int wave, int lane, unsigned char* ws, gu32* ctl, const float* w_up, const float* b_alpha, const float* b_forget) {
    typedef float f32x16 __attribute__((ext_vector_type(16)));
    asm volatile("" : "+v"(tid), "+v"(lane), "+s"(wave));
    const int t0 = 64 * n, r32 = lane & 31, hi = lane >> 5;
    STAMP(15);
    { const unsigned lds0 = (unsigned)(uintptr_t)(lds); const bf16* xn = (const bf16*)(ws + WS_XN) + (size_t)t0 * 1024;
#pragma unroll
      for (int i = 0; i < 16; ++i) { const int p = 16 * wave + i, row = p >> 1, half = p & 1; const int kc = 64 * half + (lane ^ (row & 15));
          glds16(xn + (size_t)row * 1024 + 8 * kc, (unsigned)__builtin_amdgcn_readfirstlane(lds0 + row * 2048 + half * 1024)); } }
    if (tid < 12) ((LAS unsigned*)(lds + P2_NRM))[tid] = 0u;
    v4u vreg[6];
#pragma unroll
    for (int i = 0; i < 6; ++i) { const int q = tid + 512 * i, c = q & 63, cc = q >> 6; vreg[i] = *(const GAS v4u*)((const bf16*)(ws + WS_GV) + (size_t)(t0 + c) * 384 + 8 * cc); }
    v4u kk[3];
#pragma unroll
    for (int i = 0; i < 3; ++i) kk[i] = *(const GAS v4u*)((const bf16*)(ws + WS_GK) + (size_t)(t0 + lane) * 192 + 24 * wave + 8 * i);
    const int jc = tid < 192 ? tid : tid - 192;
    float wc[16]; float ba = 0.f;
    if (tid < 384) { ba = b_alpha[jc];
#pragma unroll
        for (int r = 0; r < 16; ++r) wc[r] = w_up[r * 192 + jc]; }
    LAS float* GLRL = (LAS float*)(lds + P2_GLR); LAS float* LF = (LAS float*)(lds + P2_LF);
    if (wave < 5) {
        f32x16 c[2] = {f32x16{}, f32x16{}};
        const GAS bf16x8* bp = (const GAS bf16x8*)(ws + WS_WSF) + (size_t)(wave * 64) * 64 + lane;
        bf16x8 bq[16];
        const int rot = 2 * (int)((blockIdx.x >> 3) & 31);
#pragma unroll
        for (int u = 0; u < 16; ++u) bq[u] = bp[((rot + u) & 63) * 64];
        asm volatile("s_waitcnt vmcnt(0)" ::: "memory"); __syncthreads();
        STAMP(16);
        const int sw = r32 & 15;
#pragma unroll 1
        for (int ks0 = 0; ks0 < 64; ks0 += 16) {
#pragma unroll
            for (int u = 0; u < 16; ++u) { const int ks = (ks0 + u + rot) & 63; const int off = r32 * 2048 + (((2 * ks + hi) ^ sw) * 16);
                const bf16x8 a0 = *(const LAS bf16x8*)(lds + off), a1 = *(const LAS bf16x8*)(lds + off + 32 * 2048);
                c[0] = __builtin_amdgcn_mfma_f32_32x32x16_bf16(a0, bq[u], c[0], 0, 0, 0); c[1] = __builtin_amdgcn_mfma_f32_32x32x16_bf16(a1, bq[u], c[1], 0, 0, 0);
                bq[u] = bp[((ks + 16) & 63) * 64]; } }
        STAMP(22);
        if (wave < 4) {
#pragma unroll
            for (int rt = 0; rt < 2; ++rt)
#pragma unroll
                for (int r = 0; r < 16; ++r) { const float v = c[rt][r]; const int row = 32 * rt + (r & 3) + 8 * (r >> 2) + 4 * hi;
                    ((bf16*)(ws + WS_GG))[(size_t)(t0 + row) * 384 + 256 + 32 * wave + r32] = (bf16)f2bf(v * __builtin_amdgcn_rcpf(1.f + __builtin_amdgcn_exp2f(-LOG2E * v))); }
            STAMP(23);
        } else {
            const float bf = r32 >= 16 && r32 < 22 ? b_forget[r32 - 16] : 0.f;
#pragma unroll
            for (int rt = 0; rt < 2; ++rt)
#pragma unroll
                for (int r = 0; r < 16; ++r) { const float v = c[rt][r]; const int row = 32 * rt + (r & 3) + 8 * (r >> 2) + 4 * hi;
                    if (r32 < 16) GLRL[row * 16 + r32] = v;
                    else if (r32 < 22) LF[(r32 - 16) * 64 + row] = LOG2E * log_sigmoid_fast(v + bf); }
        }
    } else {
        asm volatile("s_waitcnt vmcnt(0)" ::: "memory"); __syncthreads();
        const int t = tid - 320, rp4 = t / 48, pc = t % 48, h = pc >> 3;
        float mq = 0.f, mk = 0.f;
#pragma unroll 4
        for (int pass = 0; pass < 16; ++pass) { const size_t row = (size_t)(t0 + 4 * pass + rp4);
            const v4u a = *(const GAS v4u*)((const bf16*)(ws + WS_FQ) + row * 384 + 8 * pc), b = *(const GAS v4u*)((const bf16*)(ws + WS_FK) + row * 384 + 8 * pc);
            float sq = 0.f, sk = 0.f;
#pragma unroll
            for (int e = 0; e < 4; ++e) { const float ql = bf_lo(a[e]), qh = bf_hi(a[e]), kl = bf_lo(b[e]), kh = bf_hi(b[e]); sq += ql * ql + qh * qh; sk += kl * kl + kh * kh; }
            sq += dppf<0xB1>(sq); sq += dppf<0x4E>(sq); sq += dppf<0x141>(sq);
            sk += dppf<0xB1>(sk); sk += dppf<0x4E>(sk); sk += dppf<0x141>(sk);
            mq = fmaxf(mq, sq); mk = fmaxf(mk, sk); }
        if ((t & 7) == 0) { __hip_atomic_fetch_max((LAS unsigned*)(lds + P2_NRM) + h, __float_as_uint(mq), __ATOMIC_RELAXED, __HIP_MEMORY_SCOPE_WORKGROUP);
                            __hip_atomic_fetch_max((LAS unsigned*)(lds + P2_NRM) + 6 + h, __float_as_uint(mk), __ATOMIC_RELAXED, __HIP_MEMORY_SCOPE_WORKGROUP); }
    }
    __syncthreads();
    STAMP(17);
    if (tid < 12) __hip_atomic_fetch_max((unsigned*)(ctl + CW_NMAX + tid), ((LAS unsigned*)(lds + P2_NRM))[tid], RLX_AGENT);
#pragma unroll
    for (int i = 0; i < 6; ++i) { const int q = tid + 512 * i, c = q & 63, cc = q >> 6; const v4u d = vreg[i];
        LAS unsigned short* p = (LAS unsigned short*)(lds + P2_VT) + (8 * cc) * GL_VT_PITCH + c;
        p[0 * GL_VT_PITCH] = (unsigned short)(d.x & 0xffffu); p[1 * GL_VT_PITCH] = (unsigned short)(d.x >> 16); p[2 * GL_VT_PITCH] = (unsigned short)(d.y & 0xffffu); p[3 * GL_VT_PITCH] = (unsigned short)(d.y >> 16);
        p[4 * GL_VT_PITCH] = (unsigned short)(d.z & 0xffffu); p[5 * GL_VT_PITCH] = (unsigned short)(d.z >> 16); p[6 * GL_VT_PITCH] = (unsigned short)(d.w & 0xffffu); p[7 * GL_VT_PITCH] = (unsigned short)(d.w >> 16); }
    LAS float* BL = (LAS float*)(lds + P2_BL);
    if (tid < 384) { const int c0 = tid < 192 ? 0 : 32; float run = 0.f;
#pragma unroll 4
        for (int c = 0; c < 32; ++c) { const LAS f32x4* g4 = (const LAS f32x4*)(GLRL + (c0 + c) * 16); float z = ba;
#pragma unroll
            for (int q = 0; q < 4; ++q) { const f32x4 g = g4[q]; z += (g.x * wc[4 * q] + g.y * wc[4 * q + 1]) + (g.z * wc[4 * q + 2] + g.w * wc[4 * q + 3]); }
            run += log_sigmoid_fast(z) * (1.f / 16.f); BL[(c0 + c) * P2_BL_PITCH + jc] = run; } }
    else if (wave == 6 || wave == 7) {
#pragma unroll
        for (int hh = 0; hh < 3; ++hh) { const int h = 3 * (wave - 6) + hh; float v = LF[h * 64 + lane];
#pragma unroll
            for (int d = 1; d < 64; d <<= 1) { const float o = __shfl_up(v, d); if (lane >= d) v += o; }
            ((float*)(ws + WS_CFL))[(size_t)h * M + t0 + lane] = v; if (lane == 63) ((float*)(ws + WS_TOT))[h * 256 + n] = v; } }
    __syncthreads();
    STAMP(18);
    { LAS unsigned short* kt = (LAS unsigned short*)(lds + P2_KT); float* dec = (float*)(ws + WS_DEC) + (size_t)n * 192; float b[24];
#pragma unroll
      for (int jj = 0; jj < 24; ++jj) { const int j = 24 * wave + jj; const float half = BL[31 * P2_BL_PITCH + j]; const float bl = BL[63 * P2_BL_PITCH + j] + half;
          const float bv = BL[lane * P2_BL_PITCH + j] + (lane >= 32 ? half : 0.f); b[jj] = bv;
          const unsigned u = kk[jj >> 3][(jj & 7) >> 1]; const float kv = (jj & 1) ? bf_hi(u) : bf_lo(u);
          kt[j * GL_KT_PITCH + lane] = (unsigned short)f2bf(kv * __expf(bl - bv));
          if (lane == 63) dec[j] = __expf(bl); }
      float* gb = (float*)(ws + WS_GB) + (size_t)(t0 + lane) * 192 + 24 * wave;
#pragma unroll
      for (int i = 0; i < 6; ++i) *(f32x4*)(gb + 4 * i) = (f32x4){b[4 * i], b[4 * i + 1], b[4 * i + 2], b[4 * i + 3]}; }
    __syncthreads();
    STAMP(19);
    { const int r16 = lane & 15, q4 = lane >> 4;
      float* kvt = (float*)(ws + WS_KVT) + (size_t)n * 18432;
      for (int ti = wave; ti < 72; ti += 8) { const int h = ti / 18, rem = ti % 18, vt = rem / 3, kt3 = rem % 3;
          pg8::f32x4 acc = {0.f, 0.f, 0.f, 0.f};
#pragma unroll
          for (int ks = 0; ks < 2; ++ks) {
              const bf16x8 a = *(const LAS bf16x8*)(lds + P2_VT + ((h * 96 + vt * 16 + r16) * GL_VT_PITCH + ks * 32 + 8 * q4) * 2);
              const bf16x8 bb = *(const LAS bf16x8*)(lds + P2_KT + ((h * 48 + kt3 * 16 + r16) * GL_KT_PITCH + ks * 32 + 8 * q4) * 2);
              acc = __builtin_amdgcn_mfma_f32_16x16x32_bf16(a, bb, acc, 0, 0, 0); }
#pragma unroll
          for (int r = 0; r < 4; ++r) kvt[(size_t)(h * 96 + vt * 16 + q4 * 4 + r) * 48 + kt3 * 16 + r16] = acc[r]; } }
    __syncthreads();
}
__device__ __forceinline__ void gla_scan_item(int item, int tid, unsigned char* ws) {
    const int e = item * 512 + tid, h = e / 4608, k = e % 48;
    const float* kvt = (const float*)(ws + WS_KVT) + e; const float* dec = (const float*)(ws + WS_DEC) + h * 48 + k; bf16* st = (bf16*)(ws + WS_ST) + e;
    float S = 0.f;
    for (int n0 = 0; n0 < 256; n0 += 64) { float kv[64], dc[64];
#pragma unroll
        for (int i = 0; i < 64; ++i) { kv[i] = kvt[(size_t)(n0 + i) * 18432]; dc[i] = dec[(size_t)(n0 + i) * 192]; }
#pragma unroll
        for (int i = 0; i < 64; ++i) { st[(size_t)(n0 + i) * 18432] = (bf16)f2bf(S); S = dc[i] * S + kv[i]; } }
}
constexpr int FO_AMG = 0;
constexpr int FO_VT = 49152;
constexpr int FO_QD = 98304, FO_KD = FO_QD + 24576;
constexpr int FO_AT = FO_QD;
constexpr int FO_AR1 = 49152;
constexpr int FO_AR2 = FO_AR1 + 65536;
constexpr int FO_TR = 0, FO_TR_WAVE = 32 * 528;
constexpr int FO_RED = 8 * FO_TR_WAVE, FO_RS = FO_RED + 2048;
static_assert(FO_AR2 + 16384 <= RING_BYTES && FO_KD + 24576 <= RING_BYTES && FO_RS + 256 <= RING_BYTES, "fused out-projection LDS map");
__device__ __forceinline__ void fused_out_item(LAS unsigned char* lds, int n, int tid, int wave, int lane, unsigned char* ws, const float* x, const float* gng, const float* fng, float* out) {
    typedef float f32x16 __attribute__((ext_vector_type(16)));
    asm volatile("" : "+v"(tid), "+v"(lane), "+s"(wave));
    const int t0 = 64 * n; const int r32 = lane & 31, hi = lane >> 5;
    STAMP(10);
    for (int rpa = 0; rpa < NREP(40); ++rpa) {
    { const unsigned lds0 = (unsigned)(uintptr_t)(lds); const bf16* gsrc = (const bf16*)(ws + WS_GG) + (size_t)t0 * 384;
      if (lane < 48) {
#pragma unroll
          for (int i = 0; i < 8; ++i) { const int row = 8 * wave + i; glds16(gsrc + (size_t)row * 384 + 8 * (lane ^ (row & 15)), (unsigned)__builtin_amdgcn_readfirstlane(lds0 + FO_AMG + row * 768)); } } }
    bf16x8 sb[3][3];
    { const bf16* stn = (const bf16*)(ws + WS_ST) + (size_t)n * 18432 + (size_t)(wave >> 1) * 4608;
#pragma unroll
      for (int vt = 0; vt < 3; ++vt)
#pragma unroll
          for (int ks = 0; ks < 3; ++ks) sb[vt][ks] = *(const GAS bf16x8*)(stn + (32 * vt + r32) * 48 + 16 * ks + 8 * hi); }
    float gn[3];
#pragma unroll
    for (int vt = 0; vt < 3; ++vt) gn[vt] = gng[32 * vt + r32];
#pragma unroll
    for (int i = 0; i < 6; ++i) { const int q = tid + 512 * i, c = q & 63, cc = q >> 6;
        const v4u d = *(const GAS v4u*)((const bf16*)(ws + WS_GV) + (size_t)(t0 + c) * 384 + 8 * cc);
        LAS unsigned char* p = lds + FO_VT + (c & 7) * 2; const int kc = c >> 3;
#pragma unroll
        for (int e = 0; e < 8; ++e) { const int v = 8 * cc + e; const unsigned w = d[e >> 1]; const unsigned short val = (e & 1) ? (unsigned short)(w >> 16) : (unsigned short)(w & 0xffffu);
            *(LAS unsigned short*)(p + v * 128 + ((kc ^ ((v >> 1) & 7)) * 16)) = val; } }
    { const size_t row = (size_t)(t0 + lane);
      v4u qq[3], kk[3]; f32x4 bb[6];
#pragma unroll
      for (int i = 0; i < 3; ++i) { qq[i] = *(const GAS v4u*)((const bf16*)(ws + WS_GQ) + row * 192 + 24 * wave + 8 * i); kk[i] = *(const GAS v4u*)((const bf16*)(ws + WS_GK) + row * 192 + 24 * wave + 8 * i); }
#pragma unroll
      for (int i = 0; i < 6; ++i) bb[i] = *(const GAS f32x4*)((const float*)(ws + WS_GB) + row * 192 + 24 * wave + 4 * i);
      const float qs = 0.14433756729740643f;
      const int sw = (lane >> 1) & 7;
#pragma unroll
      for (int i = 0; i < 3; ++i) { v4u oq, ok;
#pragma unroll
          for (int e = 0; e < 4; ++e) { const float b0 = bb[2 * i + (e >> 1)][(2 * e) & 3], b1 = bb[2 * i + (e >> 1)][((2 * e) & 3) + 1];
              oq[e] = pk2(bf_lo(qq[i][e]) * qs * __expf(b0), bf_hi(qq[i][e]) * qs * __expf(b1)); ok[e] = pk2(bf_lo(kk[i][e]) * __expf(-b0), bf_hi(kk[i][e]) * __expf(-b1)); }
          const int ch = 3 * wave + i, chs = (ch & ~7) | ((ch & 7) ^ sw);
          *(LAS v4u*)(lds + FO_QD + lane * 384 + chs * 16) = oq; *(LAS v4u*)(lds + FO_KD + lane * 384 + chs * 16) = ok; } }
    __syncthreads();
    STAMP(25);
    const int h = wave >> 1, rh = wave & 1;
    {
      f32x16 at[2] = {f32x16{}, f32x16{}}, o[3] = {f32x16{}, f32x16{}, f32x16{}};
      bf16x8 qa[3];
      { const int row = 32 * rh + r32, sw = (row >> 1) & 7;
#pragma unroll
        for (int ks = 0; ks < 3; ++ks) { const int ch = 6 * h + 2 * ks + hi; qa[ks] = *(const LAS bf16x8*)(lds + FO_QD + row * 384 + ((ch & ~7) | ((ch & 7) ^ sw)) * 16); } }
#pragma unroll
      for (int st = 0; st < 2; ++st) if (st <= rh) { const int row = 32 * st + r32, sw = (row >> 1) & 7;
#pragma unroll
          for (int ks = 0; ks < 3; ++ks) { const int ch = 6 * h + 2 * ks + hi; const bf16x8 kb = *(const LAS bf16x8*)(lds + FO_KD + row * 384 + ((ch & ~7) | ((ch & 7) ^ sw)) * 16);
              at[st] = __builtin_amdgcn_mfma_f32_32x32x16_bf16(qa[ks], kb, at[st], 0, 0, 0); } }
#pragma unroll
      for (int vt = 0; vt < 3; ++vt)
#pragma unroll
          for (int ks = 0; ks < 3; ++ks) o[vt] = __builtin_amdgcn_mfma_f32_32x32x16_bf16(qa[ks], sb[vt][ks], o[vt], 0, 0, 0);
      __syncthreads();
      STAMP(26);
      LAS unsigned char* atw = lds + FO_AT + wave * 4096;
#pragma unroll
      for (int st = 0; st < 2; ++st) if (st <= rh) {
#pragma unroll
          for (int r = 0; r < 16; ++r) { const int cl = (r & 3) + 8 * (r >> 2) + 4 * hi, c = 32 * rh + cl, s = 32 * st + r32;
              *(LAS unsigned short*)(atw + cl * 128 + (((s >> 3) ^ ((cl >> 1) & 7)) * 16) + (s & 7) * 2) = (unsigned short)f2bf(s <= c ? at[st][r] : 0.f); } }
      LDS_WAIT(); asm volatile("" ::: "memory");
#pragma unroll
      for (int ks = 0; ks < 4; ++ks) if (ks < 2 * rh + 2) { const bf16x8 aa = *(const LAS bf16x8*)(atw + r32 * 128 + (((2 * ks + hi) ^ ((r32 >> 1) & 7)) * 16));
#pragma unroll
          for (int vt = 0; vt < 3; ++vt) { const int v = h * 96 + 32 * vt + r32; const bf16x8 vb = *(const LAS bf16x8*)(lds + FO_VT + v * 128 + (((2 * ks + hi) ^ ((v >> 1) & 7)) * 16));
              o[vt] = __builtin_amdgcn_mfma_f32_32x32x16_bf16(aa, vb, o[vt], 0, 0, 0); } }
#pragma unroll
      for (int r = 0; r < 16; ++r) { const float ss = half_sum(o[0][r] * o[0][r] + o[1][r] * o[1][r] + o[2][r] * o[2][r]);
          const float rstd = 1.f / sqrtf(ss * (1.f / 96.f) + EPS);
          const int rl = 32 * rh + (r & 3) + 8 * (r >> 2) + 4 * hi;
#pragma unroll
          for (int vt = 0; vt < 3; ++vt) { const int col = h * 96 + 32 * vt + r32; LAS unsigned short* ap = (LAS unsigned short*)(lds + FO_AMG + rl * 768 + (((col >> 3) ^ (rl & 15)) * 16) + (col & 7) * 2);
              const float g = __uint_as_float((unsigned)(*ap) << 16); *ap = (unsigned short)f2bf(o[vt][r] * rstd * gn[vt] * g); } }
    }
    __syncthreads();
    }
    STAMP(11);
    { const unsigned lds0 = (unsigned)(uintptr_t)(lds); const bf16* mix = (const bf16*)(ws + WS_MIX) + (size_t)t0 * 1024;
#pragma unroll
      for (int i = 0; i < 8; ++i) { const int row = 8 * wave + i; const int kc = lane ^ (row & 15);
          glds16(mix + (size_t)row * 1024 + 384 + 8 * kc, (unsigned)__builtin_amdgcn_readfirstlane(lds0 + FO_AR1 + row * 1024)); }
#pragma unroll
      for (int i = 0; i < 2; ++i) { const int q = 2 * wave + i, row = 4 * q + (lane >> 4); const int kc = (lane & 15) ^ (row & 15);
          glds16(mix + (size_t)row * 1024 + 896 + 8 * kc, (unsigned)__builtin_amdgcn_readfirstlane(lds0 + FO_AR2 + q * 1024)); } }
    f32x16 acc[2][4];
#pragma unroll
    for (int rt = 0; rt < 2; ++rt)
#pragma unroll
        for (int r = 0; r < 16; ++r) { const float* xr = x + (size_t)(t0 + 32 * rt + (r & 3) + 8 * (r >> 2) + 4 * hi) * 1024 + 128 * wave + r32;
#pragma unroll
            for (int ct = 0; ct < 4; ++ct) acc[rt][ct][r] = xr[32 * ct]; }
    const GAS bf16x8* wf = (const GAS bf16x8*)(ws + WS_WOUTF) + (size_t)(4 * wave) * 64 * 64 + lane;
    bf16x8 bq[4][4];
    for (int rpb = 0; rpb < NREP(41); ++rpb) {
    const int rot = 4 * (int)((blockIdx.x >> 3) & 15);
#pragma unroll
    for (int u = 0; u < 4; ++u)
#pragma unroll
        for (int ct = 0; ct < 4; ++ct) bq[u][ct] = wf[(ct * 64 + ((rot + u) & 63)) * 64];
    const int sw15 = r32 & 15;
    asm volatile("s_waitcnt vmcnt(0)" ::: "memory"); __syncthreads();
    STAMP(24);
#pragma unroll 1
    for (int j0 = 0; j0 < 64; j0 += 4) { const int ks0 = (j0 + rot) & 63;
#pragma unroll
        for (int u = 0; u < 4; ++u) { const int ks = ks0 + u, kc = 2 * ks + hi;
            int a_off;
            if (ks0 < 24) a_off = FO_AMG + r32 * 768 + ((kc ^ sw15) * 16);
            else if (ks0 < 56) a_off = FO_AR1 + r32 * 1024 + (((kc - 48) ^ sw15) * 16);
            else a_off = FO_AR2 + r32 * 256 + (((kc - 112) ^ sw15) * 16);
            const int rstep = ks0 < 24 ? 32 * 768 : (ks0 < 56 ? 32 * 1024 : 32 * 256);
            const bf16x8 a0 = *(const LAS bf16x8*)(lds + a_off), a1 = *(const LAS bf16x8*)(lds + a_off + rstep);
#pragma unroll
            for (int ct = 0; ct < 4; ++ct) { acc[0][ct] = __builtin_amdgcn_mfma_f32_32x32x16_bf16(a0, bq[u][ct], acc[0][ct], 0, 0, 0); acc[1][ct] = __builtin_amdgcn_mfma_f32_32x32x16_bf16(a1, bq[u][ct], acc[1][ct], 0, 0, 0); }
#pragma unroll
            for (int ct = 0; ct < 4; ++ct) bq[u][ct] = wf[(ct * 64 + ((ks + 4) & 63)) * 64];
        }
    }
    }
    STAMP(12);
    __syncthreads();
    LAS float* tr = (LAS float*)(lds + FO_TR + wave * FO_TR_WAVE);
    LAS float* red = (LAS float*)(lds + FO_RED);
    f32x4 v[2][16];
    const int c4 = lane & 31, rsel = lane >> 5;
#pragma unroll
    for (int rt = 0; rt < 2; ++rt) {
#pragma unroll
        for (int ct = 0; ct < 4; ++ct)
#pragma unroll
            for (int r = 0; r < 16; ++r) tr[((r & 3) + 8 * (r >> 2) + 4 * hi) * 132 + 32 * ct + r32] = acc[rt][ct][r];
        LDS_WAIT(); asm volatile("" ::: "memory");
#pragma unroll
        for (int i = 0; i < 16; ++i) { const int rl = 2 * i + rsel;
            const f32x4 t = *(const LAS f32x4*)(tr + rl * 132 + 4 * c4); v[rt][i] = t;
            const float ss = half_sum((t[0] * t[0] + t[1] * t[1]) + (t[2] * t[2] + t[3] * t[3]));
            if (c4 == 0) red[(32 * rt + rl) * 8 + wave] = ss; }
        LDS_WAIT(); asm volatile("" ::: "memory");
    }
    STAMP(13);
    __syncthreads();
    if (tid < 64) { float q = 0.f;
#pragma unroll
        for (int w = 0; w < 8; ++w) q += red[tid * 8 + w];
        ((LAS float*)(lds + FO_RS))[tid] = 1.0f / sqrtf(q * (1.0f / 1024.0f) + EPS); }
    __syncthreads();
    const f32x4 gv = *(const GAS f32x4*)(fng + 128 * wave + 4 * c4);
#pragma unroll
    for (int rt = 0; rt < 2; ++rt)
#pragma unroll
        for (int i = 0; i < 16; ++i) { const int rl = 32 * rt + 2 * i + rsel; const float rs = ((const LAS float*)(lds + FO_RS))[rl];
            __builtin_nontemporal_store(v[rt][i] * rs * gv, (GAS f32x4*)(out + (size_t)(t0 + rl) * 1024 + 128 * wave + 4 * c4)); }
    __syncthreads();
}


struct Args { const float* in[12]; float* out; unsigned char* ws; int ph_lo, ph_hi, li, pad; };
__global__ void __launch_bounds__(NWAVES * 64, 2) hymba_fwd(Args args) {
    extern __shared__ __attribute__((aligned(16))) unsigned char lds_raw[];
    LAS unsigned char* lds = (LAS unsigned char*)lds_raw;
    volatile LAS unsigned* MISC = (volatile LAS unsigned*)(lds + MISC_OFF);
    const int tid = threadIdx.x, lane = tid & 63, wave = __builtin_amdgcn_readfirstlane(tid >> 6);
    const int G = gridDim.x; const int bx = blockIdx.x; const int vcu = (G % 8 == 0) ? (bx % 8) * (G / 8) + bx / 8 : bx;
    unsigned char* ws = args.ws; gu32* ctl = (gu32*)(ws + WS_CTL);
    const float* x = args.in[0]; const float* mem = args.in[1]; const float* norm_g = args.in[2]; const float* w_in = args.in[3]; const float* w_up = args.in[4]; const float* b_alpha = args.in[5];
    const float* b_forget = args.in[6]; const float* gla_norm_g = args.in[7]; const float* mem_norm_g = args.in[8]; const float* w_mem_kv = args.in[9]; const float* w_out = args.in[10]; const float* final_norm_g = args.in[11];
    for (int u = tid; u < (LDS_BYTES - LDSCTL_OFF) / 4; u += NWAVES * 64) ((LAS unsigned*)(lds + LDSCTL_OFF))[u] = 0u;
    __syncthreads();
    XcdBarrier bar; bar.bar = (unsigned*)(ctl + CW_BAR); bar.x = 0; bar.st = nullptr;
    if (N_LAUNCHES != PER_PHASE) bar = xcd_barrier_post((unsigned*)(ctl + CW_BAR), MISC + 8);
#define GRID_BAR(seam) do { if (N_LAUNCHES == PER_PHASE) { if (tid == 0) __hip_atomic_store(ctl + CW_TMO, 0xBADBA0u | (unsigned)(seam), RLX_AGENT); } else { xcd_barrier(bar); } } while (0)
    const int lo = args.ph_lo, hi = args.ph_hi;
#define IN(k) (lo <= (k) && (k) < hi)
#define BOTH(k) (IN(k) && IN((k) + 1))

    STAMP(0);
    if (IN(0)) { for (int rp = 0; rp < NREP(0); ++rp) p0_prologue(lds, vcu, G, tid, wave, lane, x, mem, norm_g, w_in, mem_norm_g, w_mem_kv, w_out, ws); STAMP(1); if (BOTH(0)) GRID_BAR(0); STAMP(2); }

    if (PROBE_DUP == 9) { for (int rb = 0; rb < 4; ++rb) GRID_BAR(9); }
    if (IN(1)) {
        for (int rp = 0; rp < NREP(1); ++rp) {
        { pg8::Gemm g{(const pg8::bf16_t*)(ws + WS_XN), (const pg8::bf16_t*)(ws + WS_WIN), M, NP, D}; pg8::StaticOrder S; S.init(M, NP, G, (int)blockIdx.x);
          pg8::EpiRoute E{ws, attn_body::C2};
          pg8::gemm_phase<pg8::EpiRoute, pg8::StaticOrder, true, true>(lds + RING_OFF, g, S, E); }
        }
        STAMP(3); if (BOTH(1)) GRID_BAR(1); STAMP(4);
    }

    if (IN(2)) {
        for (int rp = 0; rp < NREP(2); ++rp) {
        for (int n = vcu; n < 256; n += G) p2_chunk_item(lds, n, tid, wave, lane, ws, ctl, w_up, b_alpha, b_forget);
        }
        STAMP(5); if (BOTH(2)) GRID_BAR(2); STAMP(6);
    }

    if (IN(3)) {
        {
          LAS float* offt = (LAS float*)(lds + OFFT_OFF);
          float v[6];
          if (tid < 256) {
#pragma unroll
              for (int h = 0; h < 6; ++h) v[h] = ((const float*)(ws + WS_TOT))[h * 256 + tid];
#pragma unroll
              for (int d = 1; d < 64; d <<= 1) {
#pragma unroll
                  for (int h = 0; h < 6; ++h) { const float o = __shfl_up(v[h], d); if (lane >= d) v[h] += o; } }
              if (lane == 63) {
#pragma unroll
                  for (int h = 0; h < 6; ++h) ((LAS float*)(lds + RING_OFF))[h * 4 + wave] = v[h]; } }
          __syncthreads();
          if (tid < 256) {
#pragma unroll
              for (int h = 0; h < 6; ++h) { float add = 0.f; for (int w = 0; w < wave; ++w) add += ((LAS float*)(lds + RING_OFF))[h * 4 + w]; offt[h * OFFT_ROW + tid + 1] = v[h] + add; }
              offt[6 * OFFT_ROW + tid] = 0.f; if (tid < 7) offt[tid * OFFT_ROW + (tid == 6 ? 256 : 0)] = 0.f; }
          __syncthreads(); }
        int nit = 0;
        for (int rp = 0; rp < NREP(3); ++rp)
        for (;;) {
            if (nit < 3) STAMP(30 + 3 * nit);
            __syncthreads();
            if (tid == 0) { MISC[16] = __hip_atomic_fetch_add(ctl + CW_Q3 + 32 * rp, 1u, RLX_AGENT); MISC[17] = 0xffffu; }
            __syncthreads();
            int it = (int)MISC[16];
            { constexpr int EXTRA = PROBE_DUP == 30 ? 36 : (PROBE_DUP == 31 ? 384 : (PROBE_DUP == 32 ? 256 : 0)); if (it >= 36 + 384 + 256 + EXTRA) break;
              if (it >= 36 + 384 + 256) it = it - (36 + 384 + 256) + (PROBE_DUP == 30 ? 0 : (PROBE_DUP == 31 ? 36 : 36 + 384)); }
            if (it >= 384 && it < 420) { gla_scan_item(it - 384, tid, ws); continue; }
            int q0, NT, qoff, pitch; size_t oq, ok, ov, og; int ocol; const float* cfl; float cref; const LAS float* offp;
            if (it < 384) { const int i = it, qb = 63 - i / 6, h = i % 6; q0 = 256 * qb; NT = 4 * qb + 4; qoff = 0; pitch = 384;
                oq = WS_FQ + h * 128; ok = WS_FK + h * 128; ov = WS_FV + h * 128; og = WS_FG + h * 128; ocol = 384 + h * 64; cfl = (const float*)(ws + WS_CFL) + (size_t)h * M;
                const LAS float* offt = (const LAS float*)(lds + OFFT_OFF) + h * OFFT_ROW;
                cref = cfl[q0] + offt[4 * qb];
                const float b2 = 2.f * sqrtf(__uint_as_float(ctl[CW_NMAX + h]) * __uint_as_float(ctl[CW_NMAX + 6 + h])) + 1.0f;
                int cand = NT - 4; if (tid < NT - 4 && b2 + cref - offt[tid + 1] >= -ACP_THRESH) cand = tid;
#pragma unroll
                for (int o = 1; o < 64; o <<= 1) { const int t = __shfl_xor(cand, o); cand = t < cand ? t : cand; }
                if (lane == 0) __hip_atomic_fetch_min((LAS unsigned*)(lds + MISC_OFF) + 17, (unsigned)cand, __ATOMIC_RELAXED, __HIP_MEMORY_SCOPE_WORKGROUP);
                __syncthreads();
                const int t_lo = (int)MISC[17] & ~1;
                NT -= t_lo; ok += (size_t)t_lo * 64 * 384 * 2; ov += (size_t)t_lo * 64 * 384 * 2; cfl += t_lo * 64; offp = offt + t_lo; }
            else { const int i = it - 36 - 384, qb = i >> 2, h = i & 3; q0 = 256 * qb; NT = 4; qoff = 1 << 24; pitch = 256;
                oq = WS_MQ + h * 128; ok = WS_MK + h * 128; ov = WS_MV + h * 128; og = WS_MG + h * 128; ocol = 768 + h * 64; cfl = (const float*)(ws + WS_ZERO); cref = 0.f; offp = (const LAS float*)(lds + OFFT_OFF) + 6 * OFFT_ROW; }
            if (nit < 3) STAMP(31 + 3 * nit);
            if (PROBE_T >= 0 && blockIdx.x == 0 && tid == 0 && nit < 3) ((volatile LAS unsigned*)(lds + 153600 + 7424 + 320))[nit] = (unsigned)it * 1000u + (unsigned)NT;
            attn_body::attn_unit<8, 1024, true, true>(q0, NT, qoff, pitch, pitch, pitch, (const attn_body::bf16*)(ws + oq), (const attn_body::bf16*)(ws + ok), (const attn_body::bf16*)(ws + ov),
                (const attn_body::bf16*)(ws + og), (attn_body::bf16*)(ws + WS_MIX) + ocol, cfl, offp, cref, (char*)lds_raw + RING_OFF);
            if (nit < 3) STAMP(32 + 3 * nit);
            ++nit;
        }
        STAMP(7); if (BOTH(3)) GRID_BAR(3); STAMP(8);
    }

    if (IN(4)) {
#ifdef P4_STAGGER_TICKS
        if (vcu & 1) { const unsigned long long t0 = __builtin_amdgcn_s_memrealtime(); while (__builtin_amdgcn_s_memrealtime() - t0 < P4_STAGGER_TICKS) __builtin_amdgcn_s_sleep(8); }
#endif
        for (int rp = 0; rp < NREP(4); ++rp)
        for (int n = vcu; n < 256; n += G) fused_out_item(lds, n, tid, wave, lane, ws, x, gla_norm_g, final_norm_g, args.out);
    }
    STAMP(9);
    if (PROBE_T >= 0) { GRID_BAR(9); STAMP(39); }
    if (PROBE_T >= 0 && blockIdx.x == 0 && tid == 0) { volatile LAS unsigned long long* ts = (volatile LAS unsigned long long*)(lds + 153600 + 7424);
#ifdef PROBE_V
        const unsigned long long d = 800ull * (((volatile LAS unsigned*)(lds + 153600 + 7424 + 320))[PROBE_V] % 1000u);
#else
        const unsigned long long d = 8ull * (ts[PROBE_T2] - ts[PROBE_T]);
#endif
        const unsigned long long t0 = __builtin_amdgcn_s_memrealtime();
        while (__builtin_amdgcn_s_memrealtime() - t0 < d) __builtin_amdgcn_s_sleep(8); }
#undef IN
#undef BOTH
}

extern "C" void kernel_launch(void* const* d_in, const int* in_sizes, int n_in, void* d_out, int out_size, void* d_ws, size_t ws_size, hipStream_t stream) {
    static int grid = 0;
    if (grid == 0) {
        if (n_in != 12 || in_sizes[0] != M * D || out_size != M * D || ws_size < WS_END) { fprintf(stderr, "kernel_launch: unexpected shapes (n_in %d, in0 %d, out %d, ws %zu); nothing launched\n", n_in, n_in > 0 ? in_sizes[0] : -1, out_size, ws_size); grid = -1; return; }
        int dev = 0, cus = 0, per_cu = 0;
        if (hipGetDevice(&dev) != hipSuccess || hipDeviceGetAttribute(&cus, hipDeviceAttributeMultiprocessorCount, dev) != hipSuccess) { fprintf(stderr, "kernel_launch: device query failed\n"); grid = -1; return; }
        if (hipFuncSetAttribute((const void*)hymba_fwd, hipFuncAttributeMaxDynamicSharedMemorySize, LDS_BYTES) != hipSuccess) { fprintf(stderr, "kernel_launch: hipFuncSetAttribute failed\n"); grid = -1; return; }
        if (hipOccupancyMaxActiveBlocksPerMultiprocessor(&per_cu, (const void*)hymba_fwd, NWAVES * 64, LDS_BYTES) != hipSuccess || per_cu < 1) { fprintf(stderr, "kernel_launch: occupancy query reports %d workgroups per CU; nothing launched\n", per_cu); (void)hipGetLastError(); grid = -1; return; }
        grid = cus;
        if (grid != 256) fprintf(stderr, "kernel_launch: launching %d workgroups; the fused final phase needs exactly 256\n", grid);
    }
    if (grid < 0) return;
    if (hipMemsetAsync((char*)d_ws + WS_CTL, 0, CTL_ZERO_BYTES, stream) != hipSuccess) { fprintf(stderr, "kernel_launch: hipMemsetAsync failed\n"); return; }
    Args a{};
    for (int i = 0; i < 12; ++i) a.in[i] = (const float*)d_in[i];
    a.out = (float*)d_out; a.ws = (unsigned char*)d_ws;
    for (int li = 0; li < N_LAUNCHES; ++li) {
        a.ph_lo = (N_LAUNCHES == PER_PHASE) ? li : 0; a.ph_hi = (N_LAUNCHES == PER_PHASE) ? li + 1 : PER_PHASE; a.li = li;
        hipLaunchKernelGGL(hymba_fwd, dim3(grid), dim3(NWAVES * 64), LDS_BYTES, stream, a);
        const hipError_t le = hipPeekAtLastError();
        if (le != hipSuccess) { fprintf(stderr, "kernel_launch: launch %d failed: %s\n", li, hipGetErrorName(le)); break; }
    }
}
```

```cpp
#include <hip/hip_runtime.h>
#include <cstdio>
#include <cstdint>
namespace pg8 {
#define PG8_LAS __attribute__((address_space(3)))
typedef unsigned short bf16_t;
typedef short bf16x8 __attribute__((ext_vector_type(8)));
typedef float f32x4 __attribute__((ext_vector_type(4)));
typedef unsigned u32x4 __attribute__((ext_vector_type(4)));
constexpr int BM = 256, BK = 64, HALF = 128, HTB = HALF * BK * 2  , STAGE_BYTES = 8 * HTB, NXCD = 8, WGM = 8;

__host__ __device__ __forceinline__ int lds_byte(int r, int c) { const int st = (r >> 4) * 2 + (c >> 5), rr = r & 15, cc = c & 31, ob = rr * 64 + cc * 2; return st * 1024 + (ob ^ (((ob >> 9) & 1) << 5)); }
__host__ __device__ __forceinline__ void stage_rc(int b, int& R, int& C) { const int st = b / 1024, sb = b % 1024, swz = sb ^ (((sb >> 9) & 1) << 5); R = (st >> 1) * 16 + swz / 64; C = (st & 1) * 32 + (swz % 64) / 2; }
__host__ __device__ __forceinline__ int perm32(int rho) { const int n = rho >> 4, i = rho & 15; return 8 * (i >> 2) + 4 * n + (i & 3); }

struct Unit { int pm, pn; };
struct Gemm { const bf16_t* A; const bf16_t* Bt; int M, N, K; };

struct StaticOrder {
    int nM, nN, nwg, G, c;
    __host__ __device__ void init(int M, int N, int G_, int c_) { nM = M / BM; nN = N / BM; nwg = nM * nN; G = G_; c = c_; }
    __host__ __device__ bool next(int i, Unit& u) const {
        const long L = (long)i * G + c; if (L >= nwg) return false;
        int wgid = (int)L; { const int q = nwg / NXCD, r = nwg % NXCD, xcd = wgid % NXCD, off = wgid / NXCD; wgid = (xcd < r ? xcd * (q + 1) : r * (q + 1) + (xcd - r) * q) + off; }
        const int nig = WGM * nN, gid = wgid / nig, fm = gid * WGM, gsz = (nM - fm) < WGM ? (nM - fm) : WGM;
        u.pm = fm + ((wgid % nig) % gsz); u.pn = (wgid % nig) / gsz; return true;
    }
    __device__ __forceinline__ void a_ready(const Unit&) const {}
    __device__ __forceinline__ void done(const Unit&) const {}
};


__device__ __forceinline__ unsigned cvt_pk_bf16(float lo, float hi) { unsigned r; asm volatile("v_cvt_pk_bf16_f32 %0, %1, %2" : "=v"(r) : "v"(lo), "v"(hi)); return r; }
typedef float f32x2 __attribute__((ext_vector_type(2)));

struct EpiBf16 {
    static constexpr bool PERM = true, AFTER_DRAIN = false;
    bf16_t* O; int ldc; int split_cols; size_t split_stride;
    __device__ __forceinline__ void operator()(const f32x4 (&acc)[2][2][4][2], const Unit& u, int wr, int wc, int fr, int fq) const {
        const int row0 = u.pm * BM + wr * 64 + fr; int colt = u.pn * BM; bf16_t* base = O;
        if (split_cols) { const int t = colt / split_cols; base += (size_t)t * split_stride; colt -= t * split_cols; }
        const int col0 = colt + wc * 32 + 8 * fq;
#pragma unroll
        for (int ai = 0; ai < 2; ++ai)
#pragma unroll
            for (int m = 0; m < 4; ++m) { bf16_t* rowp = base + (size_t)(row0 + ai * HALF + m * 16) * ldc + col0;
#pragma unroll
                for (int bj = 0; bj < 2; ++bj) { const f32x4 v0 = acc[ai][bj][m][0], v1 = acc[ai][bj][m][1];
                    u32x4 w; w.x = cvt_pk_bf16(v0[0], v0[1]); w.y = cvt_pk_bf16(v0[2], v0[3]); w.z = cvt_pk_bf16(v1[0], v1[1]); w.w = cvt_pk_bf16(v1[2], v1[3]);
                    *(u32x4*)(rowp + bj * HALF) = w; } }
    }
};

struct RouteTab { unsigned char* ws; };
struct Route { bf16_t* base; int pitch, col, mode; };
struct EpiRoute {
    static constexpr bool PERM = true, AFTER_DRAIN = false;
    unsigned char* ws; float qscale;
    __device__ __forceinline__ Route route(int g32) const;
    __device__ __forceinline__ void operator()(const f32x4 (&acc)[2][2][4][2], const Unit& u, int wr, int wc, int fr, int fq) const {
        const int row0 = u.pm * BM + wr * 64 + fr;
#pragma unroll
        for (int bj = 0; bj < 2; ++bj) {
            const Route R = route(8 * u.pn + 4 * bj + wc);
            if (R.mode == 4) continue;
            if (R.mode == 3) {
                float* glr = (float*)R.base; float* ffg = glr + (size_t)16384 * 16;
#pragma unroll
                for (int ai = 0; ai < 2; ++ai)
#pragma unroll
                    for (int m = 0; m < 4; ++m) { const size_t row = (size_t)(row0 + ai * HALF + m * 16);
                        const f32x4 v0 = acc[ai][bj][m][0], v1 = acc[ai][bj][m][1];
                        if (fq < 2) { *(f32x4*)(glr + row * 16 + 8 * fq) = v0; *(f32x4*)(glr + row * 16 + 8 * fq + 4) = v1; }
                        else if (fq == 2) { *(f32x4*)(ffg + row * 8) = v0; *(f32x4*)(ffg + row * 8 + 4) = v1; } }
                continue;
            }
            const float sc = R.mode == 1 ? qscale : 1.f;
#pragma unroll
            for (int ai = 0; ai < 2; ++ai)
#pragma unroll
                for (int m = 0; m < 4; ++m) { bf16_t* rowp = R.base + (size_t)(row0 + ai * HALF + m * 16) * R.pitch + R.col + 8 * fq;
                    f32x4 v0 = acc[ai][bj][m][0], v1 = acc[ai][bj][m][1];
                    if (R.mode == 2) {
#pragma unroll
                        for (int e = 0; e < 4; ++e) { v0[e] = v0[e] * __builtin_amdgcn_rcpf(1.f + __builtin_amdgcn_exp2f(-1.4426950408889634f * v0[e])); v1[e] = v1[e] * __builtin_amdgcn_rcpf(1.f + __builtin_amdgcn_exp2f(-1.4426950408889634f * v1[e])); }
                    } else { v0 = v0 * sc; v1 = v1 * sc; }
                    u32x4 w; w.x = cvt_pk_bf16(v0[0], v0[1]); w.y = cvt_pk_bf16(v0[2], v0[3]); w.z = cvt_pk_bf16(v1[0], v1[1]); w.w = cvt_pk_bf16(v1[2], v1[3]);
                    asm volatile("global_store_dwordx4 %0, %1, off sc0 sc1\n\ts_nop 1" :: "v"(rowp), "v"(w) : "memory"); }
        }
    }
};

struct PanelSumSq {
    unsigned* xbuf;
    unsigned* cnt;
    unsigned* tmo;
    float eps; unsigned code;
    __device__ __forceinline__ bool run(const f32x4 (&v)[2][2][4][2], const Unit& u, int wr, int wc, int fr, int fq, PG8_LAS unsigned char* lds, int wid, int lane) const {
        PG8_LAS float* P = (PG8_LAS float*)lds;
        PG8_LAS float* S = (PG8_LAS float*)(lds + 8192);
        PG8_LAS unsigned* flag = (PG8_LAS unsigned*)(lds + 8192 + 2048);
#pragma unroll
        for (int ai = 0; ai < 2; ++ai)
#pragma unroll
            for (int m = 0; m < 4; ++m) {
                float q = 0.f;
#pragma unroll
                for (int bj = 0; bj < 2; ++bj)
#pragma unroll
                    for (int n = 0; n < 2; ++n) { const f32x4 d = v[ai][bj][m][n]; q += (d[0] * d[0] + d[1] * d[1]) + (d[2] * d[2] + d[3] * d[3]); }
                q += __shfl_xor(q, 16); q += __shfl_xor(q, 32);
                if (fq == 0) P[(ai * HALF + wr * 64 + m * 16 + fr) * 4 + wc] = q;
            }
        asm volatile("s_waitcnt lgkmcnt(0)" ::: "memory"); __builtin_amdgcn_s_barrier(); asm volatile("" ::: "memory");
        const int row = wid * 32 + (lane & 31);
        if (lane < 32) {
            const float q = (P[row * 4 + 0] + P[row * 4 + 1]) + (P[row * 4 + 2] + P[row * 4 + 3]);
            unsigned* slot = xbuf + ((size_t)(u.pm * BM + row) * 4 + u.pn);
            __hip_atomic_store(slot, __float_as_uint(q), __ATOMIC_RELAXED, __HIP_MEMORY_SCOPE_AGENT);
        }
        asm volatile("s_waitcnt vmcnt(0)" ::: "memory");
        if (lane == 0) __hip_atomic_fetch_add(cnt + 64 * u.pm, 1u, __ATOMIC_RELAXED, __HIP_MEMORY_SCOPE_AGENT);
        if (wid == 0) {
            bool dead = false; const unsigned long long t0 = __builtin_amdgcn_s_memrealtime(); const unsigned want = 8u * 4u;
            for (;;) {
                if ((unsigned)__builtin_amdgcn_readfirstlane(__hip_atomic_load(cnt + 64 * u.pm, __ATOMIC_RELAXED, __HIP_MEMORY_SCOPE_AGENT)) >= want) break;
                if (__builtin_amdgcn_s_memrealtime() - t0 > 2000000ull) {
                    if (lane == 0) { unsigned expect = 0u; __hip_atomic_compare_exchange_strong(tmo + 1, &expect, code | (unsigned)(u.pm & 0xff), __ATOMIC_RELAXED, __ATOMIC_RELAXED, __HIP_MEMORY_SCOPE_AGENT);
                                     __hip_atomic_store(tmo, 1u, __ATOMIC_RELAXED, __HIP_MEMORY_SCOPE_AGENT); }
                    dead = true; break; }
                __builtin_amdgcn_s_sleep(2);
            }
            __builtin_amdgcn_fence(__ATOMIC_ACQUIRE, "agent");
            if (lane == 0) flag[0] = dead ? 1u : 0u;
        }
        asm volatile("s_waitcnt vmcnt(0) lgkmcnt(0)" ::: "memory"); __builtin_amdgcn_s_barrier(); asm volatile("" ::: "memory");
        const bool bad = flag[0] != 0u;
        if (lane < 32) {
            const unsigned* slot = xbuf + (size_t)(u.pm * BM + row) * 4; float q = 0.f;
#pragma unroll
            for (int t = 0; t < 4; ++t) q += __uint_as_float(__hip_atomic_load(slot + t, __ATOMIC_RELAXED, __HIP_MEMORY_SCOPE_AGENT));
            S[row] = 1.0f / sqrtf(q * (1.0f / 1024.0f) + eps);
        }
        asm volatile("s_waitcnt lgkmcnt(0)" ::: "memory"); __builtin_amdgcn_s_barrier(); asm volatile("" ::: "memory");
        return bad;
    }
};
struct EpiNormRes {
    static constexpr bool PERM = false, AFTER_DRAIN = true;
    const float* base; float* out; int ldc; const float* gain; PanelSumSq st; unsigned poison;
    __device__ __forceinline__ void fused(f32x4 (&acc)[2][2][4][2], const Unit& u, int wr, int wc, int fr, int fq, PG8_LAS unsigned char* lds, int wid, int lane) const {
        const PG8_LAS float* S = (const PG8_LAS float*)(lds + 8192);
        const int col0 = u.pn * BM + wc * 32 + 4 * fq;
#pragma unroll
        for (int ai = 0; ai < 2; ++ai)
#pragma unroll
            for (int m = 0; m < 4; ++m) { const size_t off = (size_t)(u.pm * BM + ai * HALF + wr * 64 + m * 16 + fr) * ldc + col0;
#pragma unroll
                for (int bj = 0; bj < 2; ++bj)
#pragma unroll
                    for (int n = 0; n < 2; ++n) acc[ai][bj][m][n] += *(const f32x4*)(base + off + bj * HALF + n * 16);
                asm volatile("" : "+v"(acc[ai][0][m][0]), "+v"(acc[ai][0][m][1]), "+v"(acc[ai][1][m][0]), "+v"(acc[ai][1][m][1]));
                if (m & 1) asm volatile("" ::: "memory"); }
        const bool bad = st.run(acc, u, wr, wc, fr, fq, lds, wid, lane) || poison != 0u;
        const float qnan = __builtin_nanf("");
        f32x4 gv[2][2];
#pragma unroll
        for (int bj = 0; bj < 2; ++bj)
#pragma unroll
            for (int n = 0; n < 2; ++n) gv[bj][n] = *(const f32x4*)(gain + col0 + bj * HALF + n * 16);
#pragma unroll
        for (int ai = 0; ai < 2; ++ai)
#pragma unroll
            for (int m = 0; m < 4; ++m) { const int r = ai * HALF + wr * 64 + m * 16 + fr; const float sr = S[r]; const size_t off = (size_t)(u.pm * BM + r) * ldc + col0;
#pragma unroll
                for (int bj = 0; bj < 2; ++bj)
#pragma unroll
                    for (int n = 0; n < 2; ++n) { f32x4 o = acc[ai][bj][m][n] * sr * gv[bj][n];
                        if (bad) o = (f32x4){qnan, qnan, qnan, qnan}; *(f32x4*)(out + off + bj * HALF + n * 16) = o; } }
    }
};

template <class Epi, class Sched, bool ALIGN_EPI = false, bool SP2 = false>
__device__ __forceinline__ void gemm_phase(PG8_LAS unsigned char* lds, const Gemm g, const Sched& S, const Epi& E) {
    const int tid = threadIdx.x, wid = __builtin_amdgcn_readfirstlane(tid >> 6), lane = tid & 63, wr = wid >> 2, wc = wid & 3, fr = lane & 15, fq = lane >> 4;
    const int K = g.K, nt = K / BK;
    unsigned voffA[2], voffB[2];
#pragma unroll
    for (int i = 0; i < 2; ++i) { int R, C; stage_rc(tid * 16 + i * 8192, R, C); const int Rb = Epi::PERM ? ((R & ~31) + perm32(R & 31)) : R;
        voffA[i] = (unsigned)(R * K + C) * 2u; voffB[i] = (unsigned)(Rb * K + C) * 2u; }
    const size_t kstep = (size_t)(BK * 2);
    const size_t hstep = (size_t)HALF * K * 2;
    const size_t tstep = 2 * hstep;
    const unsigned ldsw = (unsigned)wid * 1024u;
    const int aoff = lds_byte(wr * 64 + fr, fq * 8), boff = lds_byte(wc * 32 + fr, fq * 8);
#define PG8_SA(b, h) (((b) * 2 + (h)) * HTB)
#define PG8_SB(b, h) ((4 + (b) * 2 + (h)) * HTB)
#define PG8_STAGE(bufoff, gbase, voff) do { _Pragma("unroll") for (int _i = 0; _i < 2; ++_i) \
        __builtin_amdgcn_global_load_lds((const unsigned*)((const char*)(gbase) + (voff)[_i]), (PG8_LAS unsigned*)(lds + (bufoff) + ldsw + _i * 8192), 16, 0, 0); } while (0)
#define PG8_LDA(dst, b, h) do { _Pragma("unroll") for (int m = 0; m < 4; ++m) _Pragma("unroll") for (int k = 0; k < 2; ++k) dst[m][k] = *(const PG8_LAS bf16x8*)(lds + PG8_SA(b, h) + aoff + m * 2048 + k * 1024); } while (0)
#define PG8_LDB(dst, b, h) do { _Pragma("unroll") for (int n = 0; n < 2; ++n) _Pragma("unroll") for (int k = 0; k < 2; ++k) dst[n][k] = *(const PG8_LAS bf16x8*)(lds + PG8_SB(b, h) + boff + n * 2048 + k * 1024); } while (0)
#define PG8_MMA(ai, bj, At, Bt) do { __builtin_amdgcn_s_setprio(1); _Pragma("unroll") for (int m = 0; m < 4; ++m) _Pragma("unroll") for (int n = 0; n < 2; ++n) _Pragma("unroll") for (int k = 0; k < 2; ++k) \
        acc[ai][bj][m][n] = __builtin_amdgcn_mfma_f32_16x16x32_bf16(Bt[n][k], At[m][k], acc[ai][bj][m][n], 0, 0, 0); __builtin_amdgcn_s_setprio(0); } while (0)
#define PG8_WAIT_V(n) asm volatile("s_waitcnt vmcnt(" #n ")" ::: "memory")
#define PG8_WAIT_L(n) asm volatile("s_waitcnt lgkmcnt(" #n ")" ::: "memory")
#define PG8_BAR __builtin_amdgcn_s_barrier()
#define PG8_SCHED __builtin_amdgcn_sched_barrier(0)
    Unit cur, nxt; int ui = 0;
    if (!S.next(0, cur)) return;
    f32x4 acc[2][2][4][2];
#pragma unroll
    for (int a = 0; a < 2; ++a)
#pragma unroll
        for (int b = 0; b < 2; ++b)
#pragma unroll
            for (int m = 0; m < 4; ++m)
#pragma unroll
                for (int n = 0; n < 2; ++n) acc[a][b][m][n] = (f32x4){0.f, 0.f, 0.f, 0.f};
    bf16x8 At[4][2], B0[2][2], B1[2][2];
    const char* cA = (const char*)g.A + (size_t)cur.pm * tstep; const char* cB = (const char*)g.Bt + (size_t)cur.pn * tstep;
    S.a_ready(cur);
    if constexpr (SP2) {
        PG8_STAGE(PG8_SB(0, 0), cB, voffB); PG8_STAGE(PG8_SB(0, 1), cB + hstep, voffB); PG8_STAGE(PG8_SA(0, 0), cA, voffA); PG8_STAGE(PG8_SA(0, 1), cA + hstep, voffA);
        if (wr == 1) PG8_BAR;
        PG8_WAIT_V(2); PG8_BAR;
        PG8_STAGE(PG8_SB(1, 0), cB + kstep, voffB); PG8_STAGE(PG8_SA(1, 0), cA + kstep, voffA); PG8_STAGE(PG8_SB(1, 1), cB + hstep + kstep, voffB);
        PG8_WAIT_V(6); PG8_BAR;
    } else {
        PG8_STAGE(PG8_SB(0, 0), cB, voffB); PG8_STAGE(PG8_SA(0, 0), cA, voffA); PG8_STAGE(PG8_SB(0, 1), cB + hstep, voffB); PG8_STAGE(PG8_SA(0, 1), cA + hstep, voffA);
        if (wr == 1) PG8_BAR;
        PG8_WAIT_V(4); PG8_BAR;
        PG8_STAGE(PG8_SB(1, 0), cB + kstep, voffB); PG8_STAGE(PG8_SA(1, 0), cA + kstep, voffA); PG8_STAGE(PG8_SB(1, 1), cB + hstep + kstep, voffB);
        PG8_WAIT_V(6); PG8_BAR;
    }
    for (;;) {
        const bool has_next = S.next(ui + 1, nxt);
        const char* nA = has_next ? (const char*)g.A + (size_t)nxt.pm * tstep : cA; const char* nB = has_next ? (const char*)g.Bt + (size_t)nxt.pn * tstep : cB;
        for (int t = 0; t < nt; t += 2) {
            const bool last = (t == nt - 2);
            const char* a1 = cA + (size_t)(t + 1) * kstep;
            const char* a2 = last ? nA : cA + (size_t)(t + 2) * kstep; const char* b2 = last ? nB : cB + (size_t)(t + 2) * kstep;
            const char* a3 = a2 + kstep; const char* b3 = b2 + kstep;
            if (last && has_next) S.a_ready(nxt);
            if constexpr (SP2) {
            PG8_LDB(B0, 0, 0); PG8_LDB(B1, 0, 1); PG8_SCHED; PG8_LDA(At, 0, 0); PG8_STAGE(PG8_SA(1, 1), a1 + hstep, voffA);
            PG8_WAIT_V(8); PG8_WAIT_L(0); PG8_BAR; PG8_MMA(0, 0, At, B0); PG8_MMA(0, 1, At, B1); PG8_BAR; PG8_SCHED;
            PG8_LDA(At, 0, 1); PG8_STAGE(PG8_SB(0, 0), b2, voffB); PG8_STAGE(PG8_SB(0, 1), b2 + hstep, voffB); PG8_STAGE(PG8_SA(0, 0), a2, voffA);
            PG8_WAIT_V(8); PG8_WAIT_L(0); PG8_BAR; PG8_MMA(1, 0, At, B0); PG8_MMA(1, 1, At, B1); PG8_BAR; PG8_SCHED;
            PG8_LDB(B0, 1, 0); PG8_LDB(B1, 1, 1); PG8_SCHED; PG8_LDA(At, 1, 0); PG8_STAGE(PG8_SA(0, 1), a2 + hstep, voffA);
            PG8_WAIT_V(8); PG8_WAIT_L(0); PG8_BAR; PG8_MMA(0, 0, At, B0); PG8_MMA(0, 1, At, B1); PG8_BAR; PG8_SCHED;
            PG8_LDA(At, 1, 1); PG8_STAGE(PG8_SB(1, 0), b3, voffB); PG8_STAGE(PG8_SB(1, 1), b3 + hstep, voffB); PG8_STAGE(PG8_SA(1, 0), a3, voffA);
            PG8_WAIT_V(8); PG8_WAIT_L(0); PG8_BAR; PG8_MMA(1, 0, At, B0); PG8_MMA(1, 1, At, B1); PG8_BAR; PG8_SCHED;
            } else {
            PG8_LDB(B0, 0, 0); PG8_SCHED; PG8_LDA(At, 0, 0); PG8_STAGE(PG8_SA(1, 1), a1 + hstep, voffA);
            PG8_WAIT_L(8); PG8_BAR; PG8_WAIT_L(0); PG8_MMA(0, 0, At, B0); PG8_BAR; PG8_SCHED;
            PG8_LDB(B1, 0, 1); PG8_STAGE(PG8_SB(0, 0), b2, voffB);
            PG8_BAR; PG8_WAIT_L(0); PG8_MMA(0, 1, At, B1); PG8_BAR;
            PG8_LDA(At, 0, 1); PG8_STAGE(PG8_SA(0, 0), a2, voffA);
            PG8_BAR; PG8_WAIT_L(0); PG8_MMA(1, 0, At, B0); PG8_BAR; PG8_SCHED;
            PG8_STAGE(PG8_SB(0, 1), b2 + hstep, voffB);
            PG8_WAIT_V(6); PG8_BAR; PG8_MMA(1, 1, At, B1); PG8_BAR;
            PG8_LDB(B0, 1, 0); PG8_SCHED; PG8_LDA(At, 1, 0); PG8_STAGE(PG8_SA(0, 1), a2 + hstep, voffA);
            PG8_WAIT_L(8); PG8_BAR; PG8_WAIT_L(0); PG8_MMA(0, 0, At, B0); PG8_BAR; PG8_SCHED;
            PG8_LDB(B1, 1, 1); PG8_STAGE(PG8_SB(1, 0), b3, voffB);
            PG8_BAR; PG8_WAIT_L(0); PG8_MMA(0, 1, At, B1); PG8_BAR;
            PG8_LDA(At, 1, 1); PG8_STAGE(PG8_SA(1, 0), a3, voffA);
            PG8_BAR; PG8_WAIT_L(0); PG8_MMA(1, 0, At, B0); PG8_BAR; PG8_SCHED;
            PG8_STAGE(PG8_SB(1, 1), b3 + hstep, voffB);
            PG8_WAIT_V(6); PG8_BAR; PG8_MMA(1, 1, At, B1); PG8_BAR;
            }
        }
        if constexpr (ALIGN_EPI) { if (wr == 0) PG8_BAR; }
        if constexpr (!Epi::AFTER_DRAIN) { E(acc, cur, wr, wc, fr, fq); S.done(cur); }
        if (!has_next) break;
#pragma unroll
        for (int a = 0; a < 2; ++a)
#pragma unroll
            for (int b = 0; b < 2; ++b)
#pragma unroll
                for (int m = 0; m < 4; ++m)
#pragma unroll
                    for (int n = 0; n < 2; ++n) acc[a][b][m][n] = (f32x4){0.f, 0.f, 0.f, 0.f};
        cur = nxt; cA = nA; cB = nB; ++ui;
        if constexpr (ALIGN_EPI) { if (wr == 1) PG8_BAR; }
    }
    PG8_WAIT_V(0);
    if constexpr (!ALIGN_EPI) { if (wr == 0) PG8_BAR; }
    PG8_BAR;
    if constexpr (Epi::AFTER_DRAIN) { E.fused(acc, cur, wr, wc, fr, fq, lds, wid, lane); S.done(cur); }
#undef PG8_SA
#undef PG8_SB
#undef PG8_STAGE
#undef PG8_LDA
#undef PG8_LDB
#undef PG8_MMA
#undef PG8_WAIT_V
#undef PG8_WAIT_L
#undef PG8_BAR
#undef PG8_SCHED
}
}

#include <hip/hip_bf16.h>
#include <cmath>
namespace attn_body {
using bf16=__hip_bfloat16;
using bf16x8=__attribute__((ext_vector_type(8)))short;
using s16x4=__attribute__((ext_vector_type(4)))short;
using f32x16=__attribute__((ext_vector_type(16)))float;
using u32x4=__attribute__((ext_vector_type(4)))unsigned;
using f32x4_t=__attribute__((ext_vector_type(4)))float;
constexpr int D=64;
constexpr int NW=8,QBLK=32,QB=QBLK*NW,KVBLK=64;
constexpr int ATTN_UNIT_ROWS=QB;
__device__ __forceinline__ int crow(int r,int hi){return (r&3)+8*(r>>2)+4*hi;}
#define SBAR() __builtin_amdgcn_sched_barrier(0)
__device__ __forceinline__ void cmask(f32x16&p0,f32x16&p1,int jb,int qrel,int hi){
  const float NEG=-INFINITY; int kb=64*jb+4*hi;
  #pragma unroll
  for(int r=0;r<16;++r){int kv=kb+(r&3)+8*(r>>2); if(kv>qrel)p0[r]=NEG; if(kv+32>qrel)p1[r]=NEG;}
}

constexpr int NSLOT=3, SLOTB=8192;
constexpr int LDS_K=0, LDS_V=NSLOT*SLOTB, LDS_WS=2*NSLOT*SLOTB, LDS_OST=LDS_WS+NW*64*4, LDS_BIAS=LDS_OST+NW*4096, MAXKEYS=16384, LDS_BYTES=LDS_BIAS+MAXKEYS*4;
constexpr float C2=0.125f*1.4426950408889634f;
__device__ __forceinline__ void glds16(const void*gsrc,unsigned lds_dst){unsigned keep;
  asm volatile("s_mov_b32 %0, m0\n\ts_mov_b32 m0, %2\n\ts_nop 0\n\tglobal_load_lds_dwordx4 %1, off\n\ts_mov_b32 m0, %0":"=&s"(keep):"v"(gsrc),"s"(lds_dst):"memory");}
__device__ __forceinline__ float max3f(float a,float b,float c){float r;asm("v_max3_f32 %0, %1, %2, %3":"=v"(r):"v"(a),"v"(b),"v"(c));return r;}
__device__ __forceinline__ float max2f(float a,float b){float r;asm("v_max_f32_e32 %0, %1, %2":"=v"(r):"v"(a),"v"(b));return r;}
__device__ __forceinline__ float fadd_s(float a,float b){float r;asm("v_add_f32_e32 %0, %1, %2":"=v"(r):"v"(a),"v"(b));return r;}
__device__ __forceinline__ float fsub_s(float a,float b){float r;asm("v_sub_f32_e32 %0, %1, %2":"=v"(r):"v"(a),"v"(b));return r;}
typedef float f32x2_t __attribute__((ext_vector_type(2))); typedef __bf16 bf16x2_t __attribute__((ext_vector_type(2)));
__device__ __forceinline__ unsigned cvtpk_s(float lo,float hi){f32x2_t v={lo,hi};bf16x2_t b=__builtin_convertvector(v,bf16x2_t);return __builtin_bit_cast(unsigned,b);}
#define WAIT_BAR(N) asm volatile("s_waitcnt vmcnt(" #N ") lgkmcnt(0)\n\ts_barrier":::"memory")

__device__ __forceinline__ void qkt(f32x16&p0,f32x16&p1,const char*Kslot,const bf16x8*qr,const f32x16&negm,int r32,int hi){
  const char*kb=Kslot+hi*1024+r32*16;
  #pragma unroll
  for(int d0=0;d0<4;++d0){
    const bf16x8 b0=*reinterpret_cast<const bf16x8*>(kb+d0*2048);
    const bf16x8 b1=*reinterpret_cast<const bf16x8*>(kb+d0*2048+512);
    if(d0==0){p0=__builtin_amdgcn_mfma_f32_32x32x16_bf16(b0,qr[0],negm,0,0,0);p1=__builtin_amdgcn_mfma_f32_32x32x16_bf16(b1,qr[0],negm,0,0,0);}
    else{p0=__builtin_amdgcn_mfma_f32_32x32x16_bf16(b0,qr[d0],p0,0,0,0);p1=__builtin_amdgcn_mfma_f32_32x32x16_bf16(b1,qr[d0],p1,0,0,0);}}
}
typedef __attribute__((address_space(3))) const char* lds_cptr;
typedef short v4i16_t __attribute__((ext_vector_type(4)));
__device__ __forceinline__ void kload8(bf16x8*kf,lds_cptr kp){
  kf[0]=*(const __attribute__((address_space(3))) bf16x8*)(kp);      kf[1]=*(const __attribute__((address_space(3))) bf16x8*)(kp+512);
  kf[2]=*(const __attribute__((address_space(3))) bf16x8*)(kp+2048); kf[3]=*(const __attribute__((address_space(3))) bf16x8*)(kp+2560);
  kf[4]=*(const __attribute__((address_space(3))) bf16x8*)(kp+4096); kf[5]=*(const __attribute__((address_space(3))) bf16x8*)(kp+4608);
  kf[6]=*(const __attribute__((address_space(3))) bf16x8*)(kp+6144); kf[7]=*(const __attribute__((address_space(3))) bf16x8*)(kp+6656);
}
__device__ __forceinline__ void kload2(bf16x8*kf,lds_cptr kp,int j){ kf[2*j]=*(const __attribute__((address_space(3))) bf16x8*)(kp+j*2048); kf[2*j+1]=*(const __attribute__((address_space(3))) bf16x8*)(kp+j*2048+512); }
__device__ __forceinline__ s16x4 vtr(lds_cptr p){ return __builtin_bit_cast(s16x4,__builtin_amdgcn_ds_read_tr16_b64_v4i16((__attribute__((address_space(3))) v4i16_t*)p)); }
__device__ __forceinline__ float rowmax(const f32x16&p0,const f32x16&p1){
  float a=max3f(p0[0],p0[1],p1[0]),b=max3f(p0[2],p0[3],p1[1]);a=max3f(a,p1[2],p1[3]);
  #pragma unroll
  for(int r=4;r<16;r+=4){a=max3f(a,p0[r],p0[r+1]);b=max3f(b,p0[r+2],p0[r+3]);a=max3f(a,p1[r],p1[r+1]);b=max3f(b,p1[r+2],p1[r+3]);}
  const float m=max2f(a,b);
  auto rr=__builtin_amdgcn_permlane32_swap(__float_as_uint(m),__float_as_uint(m),false,false);
  return max2f(__uint_as_float(rr[0]),__uint_as_float(rr[1]));
}
__device__ __forceinline__ void pv(f32x16*o,int vb,bf16x8 pa0,bf16x8 pa1,bf16x8 pa2,bf16x8 pa3){
  #pragma unroll
  for(int d0=0;d0<2;++d0){s16x4 lo[4],hi[4];
    #pragma unroll
    for(int ks=0;ks<4;++ks){
      asm volatile("ds_read_b64_tr_b16 %0,%1 offset:%c2":"=&v"(lo[ks]):"v"(vb),"i"(d0*4096+ks*1024):"memory");
      asm volatile("ds_read_b64_tr_b16 %0,%1 offset:%c2":"=&v"(hi[ks]):"v"(vb),"i"(d0*4096+ks*1024+512):"memory");}
    asm volatile("s_waitcnt lgkmcnt(0)":::"memory");SBAR();
    #define PK(k) (bf16x8){lo[k][0],lo[k][1],lo[k][2],lo[k][3],hi[k][0],hi[k][1],hi[k][2],hi[k][3]}
    o[d0]=__builtin_amdgcn_mfma_f32_32x32x16_bf16(pa0,PK(0),o[d0],0,0,0);
    o[d0]=__builtin_amdgcn_mfma_f32_32x32x16_bf16(pa1,PK(1),o[d0],0,0,0);
    o[d0]=__builtin_amdgcn_mfma_f32_32x32x16_bf16(pa2,PK(2),o[d0],0,0,0);
    o[d0]=__builtin_amdgcn_mfma_f32_32x32x16_bf16(pa3,PK(3),o[d0],0,0,0);
    #undef PK
  }
}

#ifndef ATTN_STORE16
#define ATTN_STORE16(p,v) asm volatile("global_store_dwordx4 %0, %1, off sc0 sc1\n\ts_nop 1" :: "v"(p), "v"(v) : "memory")
#endif
template<int THRL,int PO,bool MASK,bool BIAS> __device__ __forceinline__ void attn_unit(int q0,int NT,int qoff,int PQ,int PKV,int PG,const bf16*Qh,const bf16*__restrict__ Kh,const bf16*__restrict__ Vh,const bf16*__restrict__ Gh,bf16*Oh,const float*__restrict__ cfl,const __attribute__((address_space(3))) float* offp,float cref,unsigned*qctr,unsigned&nxt,char*shm){
  int tid=threadIdx.x; asm volatile("":"+v"(tid)); const int lane=tid&63,r32=lane&31,hi=lane>>5; const int wid=__builtin_amdgcn_readfirstlane(tid>>6);
  const bf16*Qw=Qh+(long)(q0+wid*QBLK)*PQ;
  const unsigned lds0=(unsigned)(uintptr_t)shm;
  float*wsf=(float*)(shm+LDS_WS)+wid*64;
  const bf16*ksrc=Kh+(long)lane*PKV+wid*8;
  const bf16*vsrc=Vh+(long)(16*(wid&3)+(lane>>2))*PKV+(wid>>2)*32+(lane&3)*8;
  const unsigned kdst=lds0+LDS_K+wid*1024, vdst=lds0+LDS_V+wid*1024;
  #define DMA_K(t,slot) glds16(ksrc+(long)(t)*KVBLK*PKV,(unsigned)__builtin_amdgcn_readfirstlane(kdst+(slot)))
  #define DMA_V(t,slot) glds16(vsrc+(long)(t)*KVBLK*PKV,(unsigned)__builtin_amdgcn_readfirstlane(vdst+(slot)))
  const int vb0=(int)(lds0+LDS_V)+((lane>>4)&1)*32+(lane&3)*8+(4*hi+((lane&15)>>2))*64;
  const char*Kbase=shm+LDS_K; bf16x8 kf[8];
  const lds_cptr shm3=(lds_cptr)shm; const lds_cptr kp0=shm3+LDS_K+hi*1024+r32*16; const lds_cptr vp0=shm3+LDS_V+((lane>>4)&1)*32+(lane&3)*8+(4*hi+((lane&15)>>2))*64;
  typedef __attribute__((address_space(3))) const f32x4_t* lds_f4p; const lds_f4p biasp=(lds_f4p)(shm3+LDS_BIAS+16*hi);
  DMA_K(0,0);DMA_V(0,0);DMA_K(1,SLOTB);
  bf16x8 qr[4];
  #pragma unroll
  for(int d0=0;d0<4;++d0)qr[d0]=*reinterpret_cast<const bf16x8*>(&Qw[(long)r32*PQ+d0*16+hi*8]);
  float mhat=0.f,l_reg=0.f;f32x16 o[2];o[0]=f32x16{};o[1]=f32x16{};const f32x16 zero16=f32x16{};
  const int qrel=wid*QBLK+r32+qoff;
  #define CMASK(P0,P1,t) do{ if(MASK){int jb_=(t)-(NT-4); if(jb_>=0)cmask(P0,P1,jb_,qrel,hi);} }while(0)
  #define ADDB(P0,P1,t) do{ if(BIAS){ _Pragma("unroll") for(int g_=0;g_<4;++g_){ const f32x4_t b0_=biasp[(t)*16+2*g_], b1_=biasp[(t)*16+8+2*g_]; \
      P0[4*g_]+=b0_[0];P0[4*g_+1]+=b0_[1];P0[4*g_+2]+=b0_[2];P0[4*g_+3]+=b0_[3]; P1[4*g_]+=b1_[0];P1[4*g_+1]+=b1_[1];P1[4*g_+2]+=b1_[2];P1[4*g_+3]+=b1_[3]; } SBAR(); } }while(0)
  bool resc=false;
  #define START(P0,P1) do{ const float rm=rowmax(P0,P1); resc=false; \
    { const float dl=rm; mhat=fadd_s(mhat,dl); \
      _Pragma("unroll") for(int r=0;r<16;++r){P0[r]=fsub_s(P0[r],dl);P1[r]=fsub_s(P1[r],dl);} } \
    _Pragma("unroll") for(int r=0;r<16;++r)P0[r]=__builtin_amdgcn_exp2f(P0[r]); }while(0)
  #define RESC() do{ if(resc){ asm volatile("s_waitcnt lgkmcnt(0)":::"memory"); \
      _Pragma("unroll") for(int d_=0;d_<2;++d_) _Pragma("unroll") for(int r=0;r<16;++r)o[d_][r]*=wsf[crow(r,hi)]; } }while(0)
  f32x16 pA0,pA1,pB0,pB1;
  int sl_prev=0,sl_cur=0,sl_next=SLOTB;
  #define ROT() do{sl_prev=sl_cur;sl_cur=sl_next;sl_next=(sl_next==(NSLOT-1)*SLOTB)?0:sl_next+SLOTB;}while(0)
  DMA_K(2,2*SLOTB);
  if(BIAS){ __attribute__((address_space(3))) float* bw=(__attribute__((address_space(3))) float*)(shm3+LDS_BIAS); for(int i=tid;i<NT*KVBLK;i+=NW*64) bw[i]=cref-(cfl[i]+offp[i>>6]); }
  WAIT_BAR(3);
  qkt(pA0,pA1,Kbase,qr,zero16,r32,hi);asm volatile("s_nop 15\n\ts_nop 7":"+v"(pA0),"+v"(pA1));CMASK(pA0,pA1,0);ADDB(pA0,pA1,0);
  START(pA0,pA1);
  _Pragma("unroll") for(int r=0;r<16;++r)pA1[r]=__builtin_amdgcn_exp2f(pA1[r]);
  WAIT_BAR(0);
  DMA_K(3,0);DMA_V(1,SLOTB);
  ROT();
  kload8(kf,kp0+sl_cur);
  WAIT_BAR(2);
  s16x4 vlo[8],vhi[8]; u32x4 pw0,pw1,pw2,pw3;
  #define PKW(P,B) cvtpk_s(P[B],P[B+1])
  #define PAF(k) __builtin_bit_cast(bf16x8,pw##k)
  #define VFR(i) (bf16x8){vlo[i][0],vlo[i][1],vlo[i][2],vlo[i][3],vhi[i][0],vhi[i][1],vhi[i][2],vhi[i][3]}
  #define PIN(x) asm volatile("":"+v"(x))
  #define MX3(a,b,c) __builtin_fmaxf(__builtin_fmaxf((a),(b)),(c))
  #define GAPA(MF,A0,A1,A2,A3,W0,W1,PW) do{ MF; sacc+=A0; sacc+=A1; sacc+=A2; sacc+=A3; PIN(sacc); W0; W1; PIN(PW); SBAR(); }while(0)
  #define EX(v) __builtin_amdgcn_exp2f(v)
  #define GAPB(MF,X,B) do{ MF; X[B]=EX(X[B]); X[B+1]=EX(X[B+1]); X[B+2]=EX(X[B+2]); X[B+3]=EX(X[B+3]); PIN(X); SBAR(); }while(0)
  #define VRD(i) do{ vlo[i]=vtr(vp_+(((i)>>2)*4096+((i)&3)*1024)); vhi[i]=vtr(vp_+(((i)>>2)*4096+((i)&3)*1024+512)); }while(0)
  #define KRD(G,j) do{ if(G){ kload2(kf,kp0+sl_next,j); SBAR(); } }while(0)
  #define STEP(C0,C1,P0,P1,t,GK,GV,GL) do{ SBAR(); \
    const lds_cptr vp_=vp0+sl_prev; \
    VRD(0); SBAR(); float sacc=(P0[0]+P0[1]); \
    GAPA(C0=__builtin_amdgcn_mfma_f32_32x32x16_bf16(kf[0],qr[0],zero16,0,0,0), P0[2],P0[3],P0[4],P0[5],     pw0[0]=PKW(P0,0), pw0[1]=PKW(P0,2), pw0); \
    VRD(4); SBAR(); GAPA(C1=__builtin_amdgcn_mfma_f32_32x32x16_bf16(kf[1],qr[0],zero16,0,0,0), P0[6],P0[7],P0[8],P0[9],     pw0[2]=PKW(P0,4), pw0[3]=PKW(P0,6), pw0); \
    VRD(1); SBAR(); GAPA(C0=__builtin_amdgcn_mfma_f32_32x32x16_bf16(kf[2],qr[1],C0,0,0,0),   P0[10],P0[11],P0[12],P0[13], pw1[0]=PKW(P0,8), pw1[1]=PKW(P0,10), pw1); \
    VRD(5); SBAR(); GAPA(C1=__builtin_amdgcn_mfma_f32_32x32x16_bf16(kf[3],qr[1],C1,0,0,0),   P0[14],P0[15],P1[0],P1[1],   pw1[2]=PKW(P0,12),pw1[3]=PKW(P0,14), pw1); \
    VRD(2); SBAR(); GAPA(C0=__builtin_amdgcn_mfma_f32_32x32x16_bf16(kf[4],qr[2],C0,0,0,0),   P1[2],P1[3],P1[4],P1[5],     pw2[0]=PKW(P1,0), pw2[1]=PKW(P1,2), pw2); \
    VRD(6); SBAR(); GAPA(C1=__builtin_amdgcn_mfma_f32_32x32x16_bf16(kf[5],qr[2],C1,0,0,0),   P1[6],P1[7],P1[8],P1[9],     pw2[2]=PKW(P1,4), pw2[3]=PKW(P1,6), pw2); \
    VRD(3); SBAR(); GAPA(C0=__builtin_amdgcn_mfma_f32_32x32x16_bf16(kf[6],qr[3],C0,0,0,0),   P1[10],P1[11],P1[12],P1[13], pw3[0]=PKW(P1,8), pw3[1]=PKW(P1,10), pw3); \
    VRD(7); SBAR(); GAPA(C1=__builtin_amdgcn_mfma_f32_32x32x16_bf16(kf[7],qr[3],C1,0,0,0),   P1[14],P1[15],0.f,0.f,       pw3[2]=PKW(P1,12),pw3[3]=PKW(P1,14), pw3); \
    l_reg+=sacc; \
    if(GK){DMA_K((t)+3,sl_cur);} if(GV){DMA_V((t)+1,sl_next);} \
    CMASK(C0,C1,t); ADDB(C0,C1,t); \
    { float a=MX3(C0[0],C0[1],C1[0]),b=MX3(C0[2],C0[3],C1[1]); a=MX3(a,C1[2],C1[3]); \
      _Pragma("unroll") for(int r=4;r<16;r+=4){a=MX3(a,C0[r],C0[r+1]);b=MX3(b,C0[r+2],C0[r+3]);a=MX3(a,C1[r],C1[r+1]);b=MX3(b,C1[r+2],C1[r+3]);} \
      float rm=__builtin_fmaxf(a,b); { auto rr=__builtin_amdgcn_permlane32_swap(__float_as_uint(rm),__float_as_uint(rm),false,false); rm=__builtin_fmaxf(__uint_as_float(rr[0]),__uint_as_float(rr[1])); } \
      resc=false; rm-=mhat; \
      if(__builtin_expect(__any(rm>(float)THRL),0)){ const float dl=__builtin_fmaxf(rm,0.f); mhat+=dl; \
        const float f=__builtin_amdgcn_exp2f(-dl); l_reg*=f; if(hi==0)wsf[r32]=f; resc=true; } \
      _Pragma("unroll") for(int r=0;r<16;++r){C0[r]-=mhat;C1[r]-=mhat;} } \
    SBAR(); \
    GAPB(o[0]=__builtin_amdgcn_mfma_f32_32x32x16_bf16(PAF(0),VFR(0),o[0],0,0,0), C0,0); \
    GAPB(o[1]=__builtin_amdgcn_mfma_f32_32x32x16_bf16(PAF(0),VFR(4),o[1],0,0,0), C0,4); \
    KRD(GL,0); GAPB(o[0]=__builtin_amdgcn_mfma_f32_32x32x16_bf16(PAF(1),VFR(1),o[0],0,0,0), C0,8); \
    KRD(GL,1); GAPB(o[1]=__builtin_amdgcn_mfma_f32_32x32x16_bf16(PAF(1),VFR(5),o[1],0,0,0), C0,12); \
    KRD(GL,2); GAPB(o[0]=__builtin_amdgcn_mfma_f32_32x32x16_bf16(PAF(2),VFR(2),o[0],0,0,0), C1,0); \
    KRD(GL,3); GAPB(o[1]=__builtin_amdgcn_mfma_f32_32x32x16_bf16(PAF(2),VFR(6),o[1],0,0,0), C1,4); \
    GAPB(o[0]=__builtin_amdgcn_mfma_f32_32x32x16_bf16(PAF(3),VFR(3),o[0],0,0,0), C1,8); \
    GAPB(o[1]=__builtin_amdgcn_mfma_f32_32x32x16_bf16(PAF(3),VFR(7),o[1],0,0,0), C1,12); \
    }while(0)
  int t=1;
  #undef CMASK
  #define CMASK(P0,P1,t) do{}while(0)
  for(;t+5<NT;t+=2){
    STEP(pB0,pB1,pA0,pA1,t,true,true,true);     WAIT_BAR(2); RESC(); ROT();
    STEP(pA0,pA1,pB0,pB1,t+1,true,true,true);   WAIT_BAR(2); RESC(); ROT();
  }
  #undef CMASK
  #define CMASK(P0,P1,t) do{ if(MASK){int jb_=(t)-(NT-4); if(jb_>=0)cmask(P0,P1,jb_,qrel,hi);} }while(0)
  #define ENDW(tt) do{ if((tt)+3<NT){WAIT_BAR(2);} else if((tt)+2<NT){WAIT_BAR(1);} else {WAIT_BAR(0);} }while(0)
  for(;t+1<NT;t+=2){
    STEP(pB0,pB1,pA0,pA1,t,(t+3<NT),(t+1<NT),(t+1<NT));       ENDW(t);   RESC(); ROT();
    STEP(pA0,pA1,pB0,pB1,t+1,(t+4<NT),(t+2<NT),(t+2<NT));     ENDW(t+1); RESC(); ROT();
  }
  STEP(pB0,pB1,pA0,pA1,NT-1,false,false,false); RESC();
  const bf16*Gw=Gh+(long)(q0+wid*QBLK)*PG;
  u32x4 gt[4];
  #pragma unroll
  for(int i=0;i<4;++i)gt[i]=*(const u32x4*)(Gw+(long)(i*8+(lane>>3))*PG+(lane&7)*8);
  { float sacc=pB0[0]+pB0[1]; _Pragma("unroll") for(int r=2;r<16;++r)sacc+=pB0[r]; _Pragma("unroll") for(int r=0;r<16;++r)sacc+=pB1[r]; l_reg+=sacc;
    pw0=(u32x4){PKW(pB0,0),PKW(pB0,2),PKW(pB0,4),PKW(pB0,6)};pw1=(u32x4){PKW(pB0,8),PKW(pB0,10),PKW(pB0,12),PKW(pB0,14)};pw2=(u32x4){PKW(pB1,0),PKW(pB1,2),PKW(pB1,4),PKW(pB1,6)};pw3=(u32x4){PKW(pB1,8),PKW(pB1,10),PKW(pB1,12),PKW(pB1,14)};
    SBAR(); pv(o,vb0+sl_cur,PAF(0),PAF(1),PAF(2),PAF(3)); }
  #undef PKW
  #undef PAF
  #undef VFR
  #undef PIN
  #undef MX3
  #undef GAPA
  #undef GAPB
  #undef EX
  #undef VRD
  #undef KRD
  #undef STEP
  #undef ENDW
  if(tid==0) nxt=__hip_atomic_fetch_add(qctr,1u,__ATOMIC_RELAXED,__HIP_MEMORY_SCOPE_AGENT);
  {auto rr=__builtin_amdgcn_permlane32_swap(__float_as_uint(l_reg),__float_as_uint(l_reg),false,false);l_reg=__uint_as_float(rr[0])+__uint_as_float(rr[1]);}
  if(hi==0)wsf[32+r32]=l_reg;asm volatile("s_waitcnt lgkmcnt(0)":::"memory");
  float rli[16];
  #pragma unroll
  for(int r=0;r<16;++r)rli[r]=__builtin_amdgcn_rcpf(wsf[32+crow(r,hi)]);
  bf16*Ow=Oh+(long)(q0+wid*QBLK)*PO;
  { bf16*stg=(bf16*)(shm+LDS_OST)+wid*2048;
    #pragma unroll
    for(int r=0;r<16;++r){const int orow=crow(r,hi);
      #pragma unroll
      for(int d0=0;d0<2;++d0)stg[orow*64+d0*32+r32]=__float2bfloat16(o[d0][r]*rli[r]);}
    asm volatile("s_waitcnt lgkmcnt(0)":::"memory");
    #pragma unroll
    for(int i=0;i<4;++i){const int row=i*8+(lane>>3),ch=lane&7; const u32x4 v=*(const u32x4*)(stg+row*64+ch*8); u32x4 w;
      #pragma unroll
      for(int e=0;e<4;++e){ const float a0=__uint_as_float(v[e]<<16)*__uint_as_float(gt[i][e]<<16), a1=__uint_as_float(v[e]&0xffff0000u)*__uint_as_float(gt[i][e]&0xffff0000u); w[e]=cvtpk_s(a0,a1); }
      ATTN_STORE16(Ow+(long)row*PO+ch*8,w);} }
  asm volatile("s_waitcnt lgkmcnt(0)\n\ts_barrier":::"memory");
  #undef DMA_K
  #undef DMA_V
  #undef CMASK
  #undef START
  #undef RESC
  #undef ADDB
  #undef ROT
}
constexpr int ATTN_LDS_BYTES=LDS_BYTES;
#undef SBAR
#undef WAIT_BAR
}

constexpr int NWAVES = 8;
#ifndef MK_N_LAUNCHES
#define MK_N_LAUNCHES 1
#endif
#ifndef PROBE_DUP
#define PROBE_DUP -1
#endif
#ifndef PROBE_T
#define PROBE_T -1
#endif
#ifndef PROBE_T2
#define PROBE_T2 (PROBE_T + 1)
#endif
#define STAMPW(k, w) do { if (PROBE_T >= 0 && blockIdx.x == 0 && tid == 64 * (w)) ((volatile LAS unsigned long long*)(lds + 153600 + 7424))[k] = __builtin_amdgcn_s_memrealtime(); } while (0)
#define STAMP(k) do { if (PROBE_T >= 0 && blockIdx.x == 0 && tid == 0) ((volatile LAS unsigned long long*)(lds + 153600 + 7424))[k] = __builtin_amdgcn_s_memrealtime(); } while (0)
#define NREP(k) ((PROBE_DUP == (k)) ? 2 : 1)
constexpr int PER_PHASE = 5;
constexpr int N_LAUNCHES = MK_N_LAUNCHES;

constexpr int M = 16384, D = 1024;
constexpr int IN_COLS = 3222, NP = 3072;
constexpr int MEM_LEN = 256;
constexpr float EPS = 1e-6f;
constexpr float LOG2E = 1.4426950408889634f;
constexpr size_t MiB = 1u << 20;
constexpr size_t WS_CTL = 0, CTL_ZERO_BYTES = 192 * 1024;
constexpr size_t WS_ZERO = 188 * 1024;
constexpr size_t WS_WIN = 2 * MiB;
constexpr size_t WS_WOUTF = 9 * MiB;
constexpr size_t WS_WSF = 11 * MiB;
constexpr size_t WS_MK = 12 * MiB + 512 * 1024, WS_MV = WS_MK + 128 * 1024;
constexpr size_t WS_X = 13 * MiB;
constexpr size_t WS_XN = 16 * MiB;
constexpr size_t WS_FQ = 48 * MiB, WS_FK = 60 * MiB, WS_FV = 72 * MiB, WS_FG = 84 * MiB;
constexpr size_t WS_MQ = 96 * MiB, WS_MG = 104 * MiB;
constexpr size_t WS_GQ = 112 * MiB, WS_GK = 118 * MiB;
constexpr size_t WS_GV = 124 * MiB, WS_GG = 136 * MiB;
constexpr size_t WS_GLR = 148 * MiB;
constexpr size_t WS_FFG = 149 * MiB;
constexpr size_t WS_CFL = 149 * MiB + 512 * 1024;
constexpr size_t WS_CHK = 149 * MiB + 512 * 1024 + 6 * 16384 * 4 + 8192;
constexpr size_t WS_TOT = 149 * MiB + 512 * 1024 + 6 * 16384 * 4;
constexpr size_t WS_KVT = 150 * MiB;
constexpr size_t WS_DEC = 168 * MiB;
constexpr size_t WS_ST = 169 * MiB;
constexpr size_t WS_MIX = 192 * MiB;
constexpr size_t WS_GB = 224 * MiB;
constexpr size_t WS_END = 240 * MiB;
static_assert(WS_GLR + (size_t)M * 16 * 4 == WS_FFG, "g_lr | f_fg adjacency (EpiRoute mode 3)");
constexpr int CW_TMO = 0, CW_CODE = 1;
constexpr int CW_Q3 = 64;
constexpr int CW_PANEL1 = 40960;
constexpr int CW_NMAX = 128;
constexpr float ACP_THRESH = 50.f;
constexpr int CW_BAR = 4096;
constexpr int CW_SEAM = 16384;
constexpr int CW_P0W = CW_SEAM + 64 * 64;
static_assert((CW_PANEL1 + 64 * 64) * 4 <= (int)WS_ZERO && (CW_SEAM + 2 * 64 * 64) * 4 <= (int)CTL_ZERO_BYTES, "CTL words inside the memset region");
constexpr int RING_OFF = 0, RING_BYTES = 151552;
constexpr int LDSCTL_OFF = RING_BYTES, MISC_OFF = LDSCTL_OFF + 320;
constexpr int OFFT_OFF = 153600, OFFT_ROW = 257;
constexpr int LDS_BYTES = 153600 + 8 * 1024;
static_assert(MISC_OFF + 128 <= OFFT_OFF && LDS_BYTES <= 163840 && attn_body::ATTN_LDS_BYTES <= RING_BYTES && pg8::STAGE_BYTES <= RING_BYTES, "LDS map");

#define GAS __attribute__((address_space(1)))
#define LAS __attribute__((address_space(3)))
typedef unsigned short bf16;
typedef unsigned v4u __attribute__((ext_vector_type(4)));
typedef float f32x4 __attribute__((ext_vector_type(4)));
typedef short bf16x8 __attribute__((ext_vector_type(8)));
typedef GAS unsigned gu32;
typedef GAS unsigned long long gu64;
#define RLX_AGENT __ATOMIC_RELAXED, __HIP_MEMORY_SCOPE_AGENT
#define LDS_WAIT() asm volatile("s_waitcnt lgkmcnt(0)" ::: "memory")
#define VM_WAIT() asm volatile("s_waitcnt vmcnt(0)" ::: "memory")
__device__ __forceinline__ unsigned long long rt() { return __builtin_amdgcn_s_memrealtime(); }
__device__ __forceinline__ unsigned f2bf(float f) { unsigned u = __builtin_bit_cast(unsigned, f); return (u + 0x7fffu + ((u >> 16) & 1u)) >> 16; }
__device__ __forceinline__ unsigned pk2(float lo, float hi) { return f2bf(lo) | (f2bf(hi) << 16); }

#define XB_TMO      128
#define XB_XCNT(j)  (256  + 64 * (j))
#define XB_XSUB(j)  (1280 + 64 * (j))
#define XB_XGEN(j)  (2304 + 64 * (j))
#define XB_TOP      3328
#define XB_TOPGEN   3392
#define XCD_BAR_WORDS 3456
#define XB_SPIN_CAP (1u << 18)

__device__ __forceinline__ unsigned xb_ld(unsigned* p)              { return __hip_atomic_load(p, __ATOMIC_RELAXED, __HIP_MEMORY_SCOPE_AGENT); }
__device__ __forceinline__ unsigned xb_add(unsigned* p, unsigned v) { return __hip_atomic_fetch_add(p, v, __ATOMIC_RELAXED, __HIP_MEMORY_SCOPE_AGENT); }
__device__ __forceinline__ unsigned xb_xcc_id() { return (unsigned)__builtin_amdgcn_s_getreg((3 << 11) | 20) & 0xFu; }
#define XB_SPIN(cond, bar) do { unsigned _sp = 0; while (cond) { __builtin_amdgcn_s_sleep(1); \
    if ((++_sp & 255u) == 0u) { if (xb_ld(&(bar)[XB_TMO])) break; if (_sp > XB_SPIN_CAP) { atomicAdd(&(bar)[XB_TMO], 1u); break; } } } } while (0)

struct XcdBarrier {
    unsigned* bar; unsigned x;
    volatile LAS unsigned* st;
};

__device__ __forceinline__ XcdBarrier xcd_barrier_post(unsigned* bar, volatile LAS unsigned* st) {
    XcdBarrier b; b.bar = bar; b.x = xb_xcc_id(); b.st = st;
    if (threadIdx.x == 0) (void)xb_add(&bar[XB_XCNT(b.x)], 1u);
    return b;
}
__device__ __forceinline__ void xcd_barrier_complete(unsigned* bar, unsigned x, unsigned& nloc, unsigned& nx) {
    const unsigned G = gridDim.x * gridDim.y * gridDim.z;
    unsigned sum, cnt, mine, sp = 0u;
    for (;;) {
        sum = 0u; cnt = 0u; mine = 0u;
#pragma unroll
        for (unsigned j = 0; j < 16; ++j) { const unsigned c = xb_ld(&bar[XB_XCNT(j)]); sum += c; cnt += (c > 0u) ? 1u : 0u; mine = (j == x) ? c : mine; }
        if (sum == G) break;
        __builtin_amdgcn_s_sleep(1);
        if ((++sp & 255u) == 0u) { if (xb_ld(&bar[XB_TMO])) break; if (sp > XB_SPIN_CAP) { atomicAdd(&bar[XB_TMO], 1u); break; } }
    }
    nloc = mine > 0u ? mine : 1u; nx = cnt > 0u ? cnt : 1u;
}

__device__ __forceinline__ void xcd_barrier(const XcdBarrier& b) {
    asm volatile("s_waitcnt vmcnt(0)" ::: "memory");
    __syncthreads();
    if (threadIdx.x == 0) {
        unsigned* bar = b.bar;
        __builtin_amdgcn_s_waitcnt(0);
        unsigned nloc = b.st[0], nx = b.st[1];
        if (nloc == 0u) { xcd_barrier_complete(bar, b.x, nloc, nx); b.st[0] = nloc; b.st[1] = nx; }
        const unsigned old = xb_add(&bar[XB_XSUB(b.x)], 1u);
        const unsigned gen = old / nloc;
        if (old + 1u == (gen + 1u) * nloc) {
            __builtin_amdgcn_fence(__ATOMIC_RELEASE, "agent");
            asm volatile("s_waitcnt vmcnt(0)" ::: "memory");
            const unsigned og = xb_add(&bar[XB_TOP], 1u);
            const unsigned tg = og / nx;
            if (og + 1u == (tg + 1u) * nx) xb_add(&bar[XB_TOPGEN], 1u);
            else XB_SPIN(xb_ld(&bar[XB_TOPGEN]) == tg, bar);
            __builtin_amdgcn_fence(__ATOMIC_ACQUIRE, "agent");
            xb_add(&bar[XB_XGEN(b.x)], 1u);
            asm volatile("s_waitcnt vmcnt(0)" ::: "memory");
        } else {
            XB_SPIN(xb_ld(&bar[XB_XGEN(b.x)]) == gen, bar);
            __builtin_amdgcn_fence(__ATOMIC_ACQUIRE, "agent");
            asm volatile("s_waitcnt vmcnt(0)" ::: "memory");
        }
    }
    __syncthreads();
}
__device__ __forceinline__ void xcd_barrier_arrive(const XcdBarrier& b) {
    asm volatile("s_waitcnt vmcnt(0)" ::: "memory");
    __syncthreads();
    if (threadIdx.x == 0) {
        unsigned* bar = b.bar;
        __builtin_amdgcn_s_waitcnt(0);
        unsigned nloc = b.st[0], nx = b.st[1];
        if (nloc == 0u) { xcd_barrier_complete(bar, b.x, nloc, nx); b.st[0] = nloc; b.st[1] = nx; }
        const unsigned old = xb_add(&bar[XB_XSUB(b.x)], 1u);
        const unsigned gen = old / nloc;
        if (old + 1u == (gen + 1u) * nloc) {
            xb_add(&bar[XB_XGEN(b.x)], 1u);
            __builtin_amdgcn_fence(__ATOMIC_RELEASE, "agent");
            asm volatile("s_waitcnt vmcnt(0)" ::: "memory");
            const unsigned og = xb_add(&bar[XB_TOP], 1u);
            const unsigned tg = og / nx;
            if (og + 1u == (tg + 1u) * nx) xb_add(&bar[XB_TOPGEN], 1u);
        }
        b.st[2] = gen + 1u;
    }
}
__device__ __forceinline__ void xcd_barrier_wait(const XcdBarrier& b) {
    if (threadIdx.x == 0) {
        unsigned* bar = b.bar; const unsigned tgt = b.st[2];
        XB_SPIN(xb_ld(&bar[XB_TOPGEN]) < tgt, bar);
        __builtin_amdgcn_fence(__ATOMIC_ACQUIRE, "agent");
        asm volatile("s_waitcnt vmcnt(0)" ::: "memory");
    }
    asm volatile("" ::: "memory"); __builtin_amdgcn_s_barrier(); asm volatile("" ::: "memory");
}
__device__ __forceinline__ void xcd_barrier_open() {
    asm volatile("s_waitcnt vmcnt(0)" ::: "memory");
    __syncthreads();
}
__device__ __forceinline__ void xcd_barrier_close(const XcdBarrier& b) {
    if (threadIdx.x == 0) {
        unsigned* bar = b.bar;
        __builtin_amdgcn_s_waitcnt(0);
        unsigned nloc = b.st[0], nx = b.st[1];
        if (nloc == 0u) { xcd_barrier_complete(bar, b.x, nloc, nx); b.st[0] = nloc; b.st[1] = nx; }
        const unsigned old = xb_add(&bar[XB_XSUB(b.x)], 1u);
        const unsigned gen = old / nloc;
        if (old + 1u == (gen + 1u) * nloc) {
            __builtin_amdgcn_fence(__ATOMIC_RELEASE, "agent");
            asm volatile("s_waitcnt vmcnt(0)" ::: "memory");
            const unsigned og = xb_add(&bar[XB_TOP], 1u);
            const unsigned tg = og / nx;
            if (og + 1u == (tg + 1u) * nx) xb_add(&bar[XB_TOPGEN], 1u);
            else XB_SPIN(xb_ld(&bar[XB_TOPGEN]) == tg, bar);
            __builtin_amdgcn_fence(__ATOMIC_ACQUIRE, "agent");
            xb_add(&bar[XB_XGEN(b.x)], 1u);
            asm volatile("s_waitcnt vmcnt(0)" ::: "memory");
        } else {
            XB_SPIN(xb_ld(&bar[XB_XGEN(b.x)]) == gen, bar);
            __builtin_amdgcn_fence(__ATOMIC_ACQUIRE, "agent");
            asm volatile("s_waitcnt vmcnt(0)" ::: "memory");
        }
    }
    asm volatile("" ::: "memory"); __builtin_amdgcn_s_barrier(); asm volatile("" ::: "memory");
}


__device__ __forceinline__ pg8::Route pg8::EpiRoute::route(int g32) const {
    Route R; R.mode = 0; R.col = 0; R.pitch = 384; size_t off;
    if (g32 < 12) { off = WS_FQ; R.col = g32 * 32; R.mode = 1; }
    else if (g32 < 24) { off = WS_FK; R.col = (g32 - 12) * 32; }
    else if (g32 < 36) { off = WS_FV; R.col = (g32 - 24) * 32; }
    else if (g32 < 48) { off = WS_FG; R.col = (g32 - 36) * 32; R.mode = 2; }
    else if (g32 < 56) { off = WS_MQ; R.col = (g32 - 48) * 32; R.pitch = 256; R.mode = 1; }
    else if (g32 < 64) { off = WS_MG; R.col = (g32 - 56) * 32; R.pitch = 256; R.mode = 2; }
    else if (g32 < 70) { off = WS_GQ; R.col = (g32 - 64) * 32; R.pitch = 192; }
    else if (g32 < 76) { off = WS_GK; R.col = (g32 - 70) * 32; R.pitch = 192; }
    else if (g32 < 88) { off = WS_GV; R.col = (g32 - 76) * 32; }
    else { off = WS_GG; R.col = (g32 - 88) * 32; R.mode = 2; }
    R.base = (bf16_t*)(ws + off); return R;
}

template <typename T> __device__ __forceinline__ T* launder_ptr(T* p) { unsigned lo = (unsigned)(uintptr_t)p, hi = (unsigned)((uintptr_t)p >> 32); asm volatile("" : "+v"(lo), "+v"(hi));
    lo = __builtin_amdgcn_readfirstlane(lo); hi = __builtin_amdgcn_readfirstlane(hi); return (T*)(((unsigned long long)hi << 32) | lo); }
template <int CTRL> __device__ __forceinline__ float dppf(float x) { return __builtin_bit_cast(float, __builtin_amdgcn_mov_dpp(__builtin_bit_cast(int, x), CTRL, 0xf, 0xf, true)); }
__device__ __forceinline__ float half_sum(float v) {
    v += dppf<0xB1>(v); v += dppf<0x4E>(v); v += dppf<0x141>(v); v += dppf<0x140>(v);
    auto s = __builtin_amdgcn_permlane16_swap(__float_as_uint(v), __float_as_uint(v), false, false);
    return __uint_as_float(s[0]) + __uint_as_float(s[1]);
}
__device__ __forceinline__ float wave_sum(float v) {
#pragma unroll
    for (int o = 1; o < 64; o <<= 1) v += __shfl_xor(v, o);
    return v;
}
__device__ __forceinline__ void p0_transpose_item(const float* W, int K, int N, bf16* WT, int n0, int nv, int drow0, int k0, LAS float* scr, int lane) {
    float tv[32];
#pragma unroll
    for (int i = 0; i < 32; ++i) { const int kk = 2 * i + (lane >> 5), nn = lane & 31; tv[i] = __builtin_nontemporal_load(W + (size_t)(k0 + kk) * N + n0 + (nn < nv ? nn : 0)); }
#pragma unroll
    for (int i = 0; i < 32; ++i) { const int kk = 2 * i + (lane >> 5), nn = lane & 31; scr[kk * 33 + nn] = nn < nv ? tv[i] : 0.f; }
    LDS_WAIT(); asm volatile("" ::: "memory");
    const int c = lane & 7;
#pragma unroll
    for (int j = 0; j < 4; ++j) { const int n = (lane >> 3) + 8 * j; const LAS float* s = scr + (8 * c) * 33 + n;
        v4u o; o.x = pk2(s[0 * 33], s[1 * 33]); o.y = pk2(s[2 * 33], s[3 * 33]); o.z = pk2(s[4 * 33], s[5 * 33]); o.w = pk2(s[6 * 33], s[7 * 33]);
        if (n < nv) asm volatile("global_store_dwordx4 %0, %1, off sc0 sc1\n\ts_nop 1" :: "v"(WT + (size_t)(drow0 + n) * K + k0 + 8 * c), "v"(o) : "memory"); }
    LDS_WAIT(); asm volatile("" ::: "memory");
}
__device__ __forceinline__ void rms_row_to_bf16(const float* xrow, const float* g, bf16* orow, int lane) {
    const GAS f32x4* xr = (const GAS f32x4*)xrow + lane; const GAS f32x4* gr = (const GAS f32x4*)g + lane;
    f32x4 v[4]; float s = 0.f;
#pragma unroll
    for (int j = 0; j < 4; ++j) { v[j] = xr[64 * j]; s += (v[j].x * v[j].x + v[j].y * v[j].y) + (v[j].z * v[j].z + v[j].w * v[j].w); }
    const float rstd = 1.f / sqrtf(wave_sum(s) * (1.f / D) + EPS);
    GAS unsigned long long* o8 = (GAS unsigned long long*)orow + lane;
#pragma unroll
    for (int j = 0; j < 4; ++j) { const f32x4 gg = gr[64 * j]; o8[64 * j] = (unsigned long long)pk2(v[j].x * rstd * gg.x, v[j].y * rstd * gg.y) | ((unsigned long long)pk2(v[j].z * rstd * gg.z, v[j].w * rstd * gg.w) << 32); }
}
__device__ __forceinline__ void p0_mem_kv(LAS unsigned char* lds, int b, int tid, int wave, int lane, const float* mem, const float* g, const float* w, unsigned char* ws) {
    const int rg = b >> 3, cg = b & 7, c = tid & 63, col = 64 * cg + c;
    LAS float* ML = (LAS float*)lds;
    LAS float* red = ML + 8 * 1024; LAS float* sq = red + 8 * 8 * 64;
    const float* wp = w + (size_t)(128 * wave) * 512 + col;
    float wall[128];
#pragma unroll
    for (int k = 0; k < 128; ++k) wall[k] = wp[(size_t)k * 512];
    { float ss = 0.f;
#pragma unroll
      for (int i = 0; i < 4; ++i) { const f32x4 m = *(const GAS f32x4*)(mem + (size_t)(8 * rg + wave) * D + 256 * i + 4 * lane); const f32x4 gg = *(const GAS f32x4*)(g + 256 * i + 4 * lane);
          ss += (m.x * m.x + m.y * m.y) + (m.z * m.z + m.w * m.w); *(LAS f32x4*)(ML + wave * 1024 + 256 * i + 4 * lane) = m * gg; }
      ss = wave_sum(ss); if (lane == 0) sq[wave] = ss; }
    __syncthreads();
    float acc[8];
#pragma unroll
    for (int r = 0; r < 8; ++r) acc[r] = 0.f;
#pragma unroll
    for (int k4 = 0; k4 < 32; ++k4) { float wv[4];
#pragma unroll
        for (int j = 0; j < 4; ++j) wv[j] = wall[4 * k4 + j];
#pragma unroll
        for (int r = 0; r < 8; ++r) { const f32x4 m = *(const LAS f32x4*)(ML + r * 1024 + 128 * wave + 4 * k4); acc[r] += (m.x * wv[0] + m.y * wv[1]) + (m.z * wv[2] + m.w * wv[3]); } }
#pragma unroll
    for (int r = 0; r < 8; ++r) red[(wave * 8 + r) * 64 + c] = acc[r];
    __syncthreads();
    { const int r = tid >> 6; float a = 0.f;
#pragma unroll
      for (int wv = 0; wv < 8; ++wv) a += red[(wv * 8 + r) * 64 + c];
      const float o = a / sqrtf(sq[r] * (1.f / D) + EPS);
      bf16* dst = (bf16*)(ws + (col < 256 ? WS_MK : WS_MV)) + (size_t)(8 * rg + r) * 256 + (col & 255);
      *dst = (bf16)f2bf(o); }
    __syncthreads();
}
struct MemKvPre { float wb[2][32]; f32x4 m[2][4]; };
constexpr int MKV_SCR = 8704;
constexpr int MKV_ML = 8 * MKV_SCR, MKV_PITCH = 1028, MKV_SQ = MKV_ML + 16 * MKV_PITCH * 4;
static_assert(MKV_SQ + 64 + 32 <= RING_BYTES && 8 * 2 * 4 * 64 * 4 <= MKV_ML, "memory K|V LDS map");
__device__ __forceinline__ void p0_mkv_issue(MemKvPre& P, int b, int wave, int lane, const float* mem, const float* w) {
    const int rg = b >> 4, cg = b & 15, kq = lane >> 4, n16 = lane & 15;
    const float* wp = w + (size_t)(128 * wave + 32 * kq) * 512 + 32 * cg + n16;
#pragma unroll
    for (int ct = 0; ct < 2; ++ct)
#pragma unroll
        for (int s = 0; s < 32; ++s) P.wb[ct][s] = wp[(size_t)s * 512 + 16 * ct];
#pragma unroll
    for (int rr = 0; rr < 2; ++rr)
#pragma unroll
        for (int i = 0; i < 4; ++i) P.m[rr][i] = *(const GAS f32x4*)(mem + (size_t)(16 * rg + 2 * wave + rr) * D + 256 * i + 4 * lane);
}
__device__ __forceinline__ void p0_mkv_stage(MemKvPre& P, LAS unsigned char* lds, int wave, int lane, const float* g) {
    LAS float* ML = (LAS float*)(lds + MKV_ML); LAS float* sq = (LAS float*)(lds + MKV_SQ);
#pragma unroll
    for (int rr = 0; rr < 2; ++rr) { float ss = 0.f;
#pragma unroll
        for (int i = 0; i < 4; ++i) { const f32x4 m = P.m[rr][i]; const f32x4 gg = *(const GAS f32x4*)(g + 256 * i + 4 * lane);
            ss += (m.x * m.x + m.y * m.y) + (m.z * m.z + m.w * m.w); *(LAS f32x4*)(ML + (2 * wave + rr) * MKV_PITCH + 256 * i + 4 * lane) = m * gg; }
        ss = wave_sum(ss); if (lane == 0) sq[2 * wave + rr] = ss; }
}
__device__ __forceinline__ void p0_mkv_mfma(MemKvPre& P, LAS unsigned char* lds, int wave, int lane) {
    const int kq = lane >> 4, m16 = lane & 15;
    LAS float* ML = (LAS float*)(lds + MKV_ML); LAS float* sq = (LAS float*)(lds + MKV_SQ); LAS float* red = (LAS float*)lds;
    LDS_WAIT(); __builtin_amdgcn_s_barrier(); asm volatile("" ::: "memory");
    f32x4 acc0 = {0.f, 0.f, 0.f, 0.f}, acc1 = {0.f, 0.f, 0.f, 0.f};
    const LAS float* ap = ML + m16 * MKV_PITCH + 128 * wave + 32 * kq;
#pragma unroll
    for (int s4 = 0; s4 < 8; ++s4) { const f32x4 a = *(const LAS f32x4*)(ap + 4 * s4);
#pragma unroll
        for (int j = 0; j < 4; ++j) { acc0 = __builtin_amdgcn_mfma_f32_16x16x4f32(a[j], P.wb[0][4 * s4 + j], acc0, 0, 0, 0); acc1 = __builtin_amdgcn_mfma_f32_16x16x4f32(a[j], P.wb[1][4 * s4 + j], acc1, 0, 0, 0); } }
#pragma unroll
    for (int r = 0; r < 4; ++r) { red[((wave * 2 + 0) * 4 + r) * 64 + lane] = acc0[r]; red[((wave * 2 + 1) * 4 + r) * 64 + lane] = acc1[r]; }
}
__device__ __forceinline__ void p0_mkv_reduce(LAS unsigned char* lds, int b, int tid, unsigned char* ws) {
    const int rg = b >> 4, cg = b & 15; LAS float* sq = (LAS float*)(lds + MKV_SQ); LAS float* red = (LAS float*)lds;
    { const int ct = tid >> 8, rr = (tid >> 6) & 3, ln = tid & 63; float a = 0.f;
#pragma unroll
      for (int wv = 0; wv < 8; ++wv) a += red[((wv * 2 + ct) * 4 + rr) * 64 + ln];
      const int row = 4 * (ln >> 4) + rr, col = 32 * cg + 16 * ct + (ln & 15);
      const float o = a / sqrtf(sq[row] * (1.f / D) + EPS);
      bf16* dst = (bf16*)(ws + (col < 256 ? WS_MK : WS_MV)) + (size_t)(16 * rg + row) * 256 + (col & 255);
      *dst = (bf16)f2bf(o); }
    __syncthreads();
}
__device__ __forceinline__ void p0_prologue(LAS unsigned char* lds, int vcu, int G, int tid, int wave, int lane, const float* x, const float* mem, const float* norm_g, const float* w_in, const float* mem_norm_g,
                                            const float* w_mem_kv, const float* w_out, unsigned char* ws, gu32* ctl) {
    LAS float* scr = (LAS float*)(lds + RING_OFF + wave * MKV_SCR);
    MemKvPre mk; p0_mkv_issue(mk, vcu, wave, lane, mem, w_mem_kv);
    const int gw = vcu * 8 + wave, NGW = G * 8;
    constexpr int NB_IN = 96, I_IN = NB_IN * 16, I_OUT = 32 * 16, I_SK = 5 * 16, NITEMS = I_IN + I_OUT + I_SK;
    int nwi = 0;
    if (NGW == 2048 && gw >= I_IN) {
        const int j = gw - I_IN, nt = j >> 4, kq = j & 15; nwi = 1;
        float t[4][8], sk[8];
#pragma unroll
        for (int u = 0; u < 4; ++u) { const float* src = w_out + (size_t)(16 * (4 * kq + u) + 8 * (lane >> 5)) * D + 32 * nt + (lane & 31);
#pragma unroll
            for (int jj = 0; jj < 8; ++jj) t[u][jj] = __builtin_nontemporal_load(src + jj * D); }
        const bool has = j < 320; const int sct = j >> 6, sks = j & 63, r32 = lane & 31;
        int col = -1; if (sct < 4) col = 784 + 256 + 32 * sct + r32; else if (r32 < 16) col = 768 + r32; else if (r32 < 22) col = 2320 + (r32 - 16);
        if (has) { const float* src = w_in + (size_t)(16 * sks + 8 * (lane >> 5)) * IN_COLS + (col < 0 ? 0 : col); nwi = 2;
#pragma unroll
            for (int jj = 0; jj < 8; ++jj) sk[jj] = src[jj * IN_COLS]; }
#pragma unroll
        for (int u = 0; u < 4; ++u) { v4u o; o.x = pk2(t[u][0], t[u][1]); o.y = pk2(t[u][2], t[u][3]); o.z = pk2(t[u][4], t[u][5]); o.w = pk2(t[u][6], t[u][7]);
            asm volatile("global_store_dwordx4 %0, %1, off sc0 sc1\n\ts_nop 1" :: "v"((GAS v4u*)(ws + WS_WOUTF) + (size_t)(nt * 64 + 4 * kq + u) * 64 + lane), "v"(o) : "memory"); }
        if (has) { v4u o; o.x = pk2(sk[0], sk[1]); o.y = pk2(sk[2], sk[3]); o.z = pk2(sk[4], sk[5]); o.w = pk2(sk[6], sk[7]);
            if (col < 0) o = (v4u){0u, 0u, 0u, 0u};
            asm volatile("global_store_dwordx4 %0, %1, off sc0 sc1\n\ts_nop 1" :: "v"((GAS v4u*)(ws + WS_WSF) + (size_t)(sct * 64 + sks) * 64 + lane), "v"(o) : "memory"); }
    } else
    for (int it = gw; it < (NGW == 2048 ? I_IN : NITEMS); it += NGW) {
        STAMPW(40 + nwi, 4); ++nwi;
        if (it < I_IN) {
            const int nb = it >> 4, kb = it & 15; int src, width, dst, b = nb;
            if (b < 6) { src = 0; width = 192; dst = 2048; }
            else if ((b -= 6) < 6) { src = 192; width = 192; dst = 2240; }
            else if ((b -= 6) < 12) { src = 384; width = 384; dst = 2432; }
            else if ((b -= 12) < 8) { src = 784; width = 256; dst = 2816; }
            else if ((b -= 8) < 12) { src = 1168; width = 384; dst = 0; }
            else if ((b -= 12) < 12) { src = 1552; width = 384; dst = 384; }
            else if ((b -= 12) < 12) { src = 1936; width = 384; dst = 768; }
            else if ((b -= 12) < 12) { src = 2326; width = 384; dst = 1152; }
            else if ((b -= 12) < 8) { src = 2710; width = 256; dst = 1536; }
            else { b -= 8; src = 2966; width = 256; dst = 1792; }
            const int nv = (width - 32 * b) < 32 ? (width - 32 * b) : 32;
            p0_transpose_item(w_in, D, IN_COLS, (bf16*)(ws + WS_WIN), src + 32 * b, nv, dst + 32 * b, 64 * kb, scr, lane);
        } else if (it < I_IN + I_OUT) { const int r = it - I_IN, nt = r >> 4, kq = r & 15;
#pragma unroll
            for (int u = 0; u < 4; ++u) { const int ks = 4 * kq + u; const float* src = w_out + (size_t)(16 * ks + 8 * (lane >> 5)) * D + 32 * nt + (lane & 31);
                float t8[8];
#pragma unroll
                for (int j = 0; j < 8; ++j) t8[j] = __builtin_nontemporal_load(src + j * D);
                v4u o; o.x = pk2(t8[0], t8[1]); o.y = pk2(t8[2], t8[3]); o.z = pk2(t8[4], t8[5]); o.w = pk2(t8[6], t8[7]);
                asm volatile("global_store_dwordx4 %0, %1, off sc0 sc1\n\ts_nop 1" :: "v"((GAS v4u*)(ws + WS_WOUTF) + (size_t)(nt * 64 + ks) * 64 + lane), "v"(o) : "memory"); }
        } else { const int r = it - I_IN - I_OUT, ct = r >> 4, kq = r & 15; const int r32 = lane & 31;
            int col = -1; if (ct < 4) col = 784 + 256 + 32 * ct + r32; else if (r32 < 16) col = 768 + r32; else if (r32 < 22) col = 2320 + (r32 - 16);
#pragma unroll
            for (int u = 0; u < 4; ++u) { const int ks = 4 * kq + u; const float* src = w_in + (size_t)(16 * ks + 8 * (lane >> 5)) * IN_COLS + (col < 0 ? 0 : col);
                v4u o; o.x = pk2(src[0 * IN_COLS], src[1 * IN_COLS]); o.y = pk2(src[2 * IN_COLS], src[3 * IN_COLS]); o.z = pk2(src[4 * IN_COLS], src[5 * IN_COLS]); o.w = pk2(src[6 * IN_COLS], src[7 * IN_COLS]);
                if (col < 0) o = (v4u){0u, 0u, 0u, 0u};
                asm volatile("global_store_dwordx4 %0, %1, off sc0 sc1\n\ts_nop 1" :: "v"((GAS v4u*)(ws + WS_WSF) + (size_t)(ct * 64 + ks) * 64 + lane), "v"(o) : "memory"); } }
    }
    STAMPW(27, 4);
    p0_mkv_stage(mk, lds, wave, lane, mem_norm_g);
    {
      f32x4 gg[4];
#pragma unroll
      for (int j = 0; j < 4; ++j) gg[j] = ((const GAS f32x4*)norm_g)[64 * j + lane];
      int nxb = 0;
      for (int m0 = 8 * gw; m0 < 8 * gw + 8; m0 += 4) { f32x4 v[4][4]; float ss[4]; STAMP(44 + nxb); ++nxb;
#pragma unroll
          for (int q = 0; q < 4; ++q) { const int m = m0 + q; const GAS f32x4* xr = (const GAS f32x4*)(x + (size_t)(m < M ? m : 0) * D) + lane;
#pragma unroll
              for (int j = 0; j < 4; ++j) v[q][j] = __builtin_nontemporal_load(xr + 64 * j); }
#pragma unroll
          for (int q = 0; q < 4; ++q) { float a = 0.f;
#pragma unroll
              for (int j = 0; j < 4; ++j) a += (v[q][j].x * v[q][j].x + v[q][j].y * v[q][j].y) + (v[q][j].z * v[q][j].z + v[q][j].w * v[q][j].w);
              ss[q] = a; }
#pragma unroll
          for (int q = 0; q < 4; ++q) { float a = half_sum(ss[q]); auto t = __builtin_amdgcn_permlane32_swap(__float_as_uint(a), __float_as_uint(a), false, false); ss[q] = __uint_as_float(t[0]) + __uint_as_float(t[1]); }
#pragma unroll
          for (int q = 0; q < 4; ++q) { const int m = m0 + q; if (m < M) { const float rstd = 1.f / sqrtf(ss[q] * (1.f / D) + EPS);
              GAS unsigned long long* o8 = (GAS unsigned long long*)((bf16*)(ws + WS_XN) + (size_t)m * D) + lane;
#pragma unroll
              for (int j = 0; j < 4; ++j) { const unsigned long long w8 = (unsigned long long)pk2(v[q][j].x * rstd * gg[j].x, v[q][j].y * rstd * gg[j].y) | ((unsigned long long)pk2(v[q][j].z * rstd * gg[j].z, v[q][j].w * rstd * gg[j].w) << 32);
                  asm volatile("global_store_dwordx2 %0, %1, off sc0 sc1\n\ts_nop 1" :: "v"(o8 + 64 * j), "v"(w8) : "memory"); } } } } }
    STAMP(21);
    p0_mkv_mfma(mk, lds, wave, lane);
    asm volatile("s_waitcnt vmcnt(0)" ::: "memory");
    if (lane == 0) ((LAS unsigned*)(lds + MKV_SQ + 64))[wave] = (unsigned)nwi;
    __syncthreads();
    if (tid == 0) { unsigned c = 0u;
#pragma unroll
        for (int w8 = 0; w8 < 8; ++w8) c += ((LAS unsigned*)(lds + MKV_SQ + 64))[w8];
        __hip_atomic_fetch_add(ctl + CW_P0W + 64 * (vcu & 15), c, RLX_AGENT); __hip_atomic_fetch_add(ctl + CW_SEAM + 64 * (vcu >> 2), 1u, RLX_AGENT); }
    p0_mkv_reduce(lds, vcu, tid, ws);
    for (int b = vcu + G; b < 256; b += G) { MemKvPre q; p0_mkv_issue(q, b, wave, lane, mem, w_mem_kv); p0_mkv_stage(q, lds, wave, lane, mem_norm_g); p0_mkv_mfma(q, lds, wave, lane); __syncthreads(); p0_mkv_reduce(lds, b, tid, ws); }
}
__device__ __forceinline__ void nan_rows_f32(int vcu, int G, int wave, int lane, float* out) {
    const int gw = vcu * NWAVES + wave, NGW = G * NWAVES; const float q = __builtin_nanf("");
    for (int m = gw; m < M; m += NGW) { GAS f32x4* o = (GAS f32x4*)(out + (size_t)m * D) + lane;
#pragma unroll
        for (int j = 0; j < 4; ++j) o[64 * j] = (f32x4){q, q, q, q}; }
}
struct PanelOrder {
    int c; unsigned* cnt;
    __device__ __forceinline__ bool next(int i, pg8::Unit& u) const { if (i >= 3) return false; u.pm = c >> 2; u.pn = 3 * (c & 3) + i; return true; }
    __device__ __forceinline__ void a_ready(const pg8::Unit&) const {}
    __device__ __forceinline__ void done(const pg8::Unit& u) const { if (u.pn % 3 != 2) return;
        asm volatile("s_waitcnt vmcnt(0)" ::: "memory"); if ((threadIdx.x & 63) == 0) __hip_atomic_fetch_add(cnt, 3u, __ATOMIC_RELAXED, __HIP_MEMORY_SCOPE_AGENT); }
};
__device__ __forceinline__ void glds16(const void* gsrc, unsigned lds_dst) { unsigned keep;
    asm volatile("s_mov_b32 %0, m0\n\ts_mov_b32 m0, %2\n\ts_nop 0\n\tglobal_load_lds_dwordx4 %1, off\n\ts_mov_b32 m0, %0" : "=&s"(keep) : "v"(gsrc), "s"(lds_dst) : "memory"); }
__device__ __forceinline__ float log_sigmoid(float z) { return fminf(z, 0.f) - log1pf(__expf(-fabsf(z))); }
__device__ __forceinline__ float log_sigmoid_fast(float z) { const float t = __builtin_amdgcn_exp2f(-LOG2E * fabsf(z)); return fminf(z, 0.f) - 0.6931471805599453f * __builtin_amdgcn_logf(1.f + t); }
__device__ __forceinline__ float bf_lo(unsigned u) { return __uint_as_float(u << 16); }
__device__ __forceinline__ float bf_hi(unsigned u) { return __uint_as_float(u & 0xffff0000u); }
__device__ __forceinline__ void gla_cum_decay(float (&b)[24], const float* glr_row, const LAS float* w_up, const LAS float* b_alpha, int w, int lane) {
    f32x4 g4[4];
#pragma unroll
    for (int i = 0; i < 4; ++i) g4[i] = *(const f32x4*)(glr_row + 4 * i);
#pragma unroll
    for (int jj = 0; jj < 24; ++jj) { const int j = 24 * w + jj; float z = b_alpha[j];
#pragma unroll
        for (int r = 0; r < 16; ++r) z += g4[r >> 2][r & 3] * w_up[r * 192 + j];
        float v = log_sigmoid(z) * (1.f / 16.f);
#pragma unroll
        for (int d = 1; d < 64; d <<= 1) { const float o = __shfl_up(v, d); if (lane >= d) v += o; }
        b[jj] = v; }
}
constexpr int GL_VT = 0, GL_VT_PITCH = 72, GL_VT_BYTES = 384 * GL_VT_PITCH * 2;
constexpr int GL_KT = GL_VT_BYTES, GL_KT_PITCH = 72, GL_KT_BYTES = 192 * GL_KT_PITCH * 2;
constexpr int GL_QD = GL_VT_BYTES, GL_QD_PITCH = 200, GL_QD_BYTES = 64 * GL_QD_PITCH * 2;
constexpr int GL_KD = GL_QD + GL_QD_BYTES;
constexpr int GL_AT = GL_QD, GL_AT_PITCH = 72, GL_AT_WAVE = 32 * GL_AT_PITCH * 2;
constexpr int GL_W = 112 * 1024, GL_BA = GL_W + 16 * 192 * 4;
static_assert(GL_KD + GL_QD_BYTES <= GL_W && GL_KT + GL_KT_BYTES <= GL_W && GL_BA + 192 * 4 <= RING_BYTES && GL_AT + 8 * GL_AT_WAVE <= GL_KD + GL_QD_BYTES + 65536 && GL_AT + 8 * GL_AT_WAVE <= RING_BYTES, "GLA LDS map");
__device__ __forceinline__ void gla_stage_vt(LAS unsigned char* lds, const bf16* GV, int t0, int tid, const float* w_up, const float* b_alpha) {
    for (int i = tid; i < 16 * 192 / 4; i += 512) ((LAS f32x4*)(lds + GL_W))[i] = ((const GAS f32x4*)w_up)[i];
    if (tid < 48) ((LAS f32x4*)(lds + GL_BA))[tid] = ((const GAS f32x4*)b_alpha)[tid];
#pragma unroll
    for (int i = 0; i < 6; ++i) { const int q = tid + 512 * i, c = q & 63, cc = q >> 6;
        const v4u d = *(const GAS v4u*)(GV + (size_t)(t0 + c) * 384 + 8 * cc);
        LAS unsigned short* p = (LAS unsigned short*)(lds + GL_VT) + (8 * cc) * GL_VT_PITCH + c;
        p[0 * GL_VT_PITCH] = (unsigned short)(d.x & 0xffffu); p[1 * GL_VT_PITCH] = (unsigned short)(d.x >> 16); p[2 * GL_VT_PITCH] = (unsigned short)(d.y & 0xffffu); p[3 * GL_VT_PITCH] = (unsigned short)(d.y >> 16);
        p[4 * GL_VT_PITCH] = (unsigned short)(d.z & 0xffffu); p[5 * GL_VT_PITCH] = (unsigned short)(d.z >> 16); p[6 * GL_VT_PITCH] = (unsigned short)(d.w & 0xffffu); p[7 * GL_VT_PITCH] = (unsigned short)(d.w >> 16); }
}
constexpr int P2_VT = 0, P2_KT = GL_VT_BYTES, P2_BL = P2_KT + GL_KT_BYTES, P2_BL_PITCH = 193;
constexpr int P2_GLR = 133 * 1024, P2_LF = P2_GLR + 4096, P2_NRM = P2_LF + 1536;
static_assert(P2_BL + 64 * P2_BL_PITCH * 4 <= P2_GLR && P2_NRM + 64 <= RING_BYTES, "P2 LDS map");
__device__ __forceinline__ void p2_prefetch_a(LAS unsigned char* lds, int n, int wave, int lane, unsigned char* ws) {
    const unsigned lds0 = (unsigned)(uintptr_t)(lds); const bf16* xn = (const bf16*)(ws + WS_XN) + (size_t)(64 * n) * 1024;
#pragma unroll
    for (int i = 0; i < 16; ++i) { const int p = 16 * wave + i, row = p >> 1, half = p & 1; const int kc = 64 * half + (lane ^ (row & 15));
        glds16(xn + (size_t)row * 1024 + 8 * kc, (unsigned)__builtin_amdgcn_readfirstlane(lds0 + row * 2048 + half * 1024)); }
}
__device__ __forceinline__ void p2_chunk_item(LAS unsigned char* lds, int n, int tid, int wave, int lane, unsigned char* ws, gu32* ctl, const float* w_up, const float* b_alpha, const float* b_forget) {
    typedef float f32x16 __attribute__((ext_vector_type(16)));
    asm volatile("" : "+v"(tid), "+v"(lane), "+s"(wave));
    const int t0 = 64 * n, r32 = lane & 31, hi = lane >> 5;
    STAMP(15);
    if (tid < 12) ((LAS unsigned*)(lds + P2_NRM))[tid] = 0u;
    if (tid >= 12 && tid < 18) ((LAS unsigned*)(lds + P2_NRM))[tid] = 0xffffffffu;
    v4u vreg[6];
#pragma unroll
    for (int i = 0; i < 6; ++i) { const int q = tid + 512 * i, c = q & 63, cc = q >> 6; vreg[i] = *(const GAS v4u*)((const bf16*)(ws + WS_GV) + (size_t)(t0 + c) * 384 + 8 * cc); }
    v4u kk[3];
#pragma unroll
    for (int i = 0; i < 3; ++i) kk[i] = *(const GAS v4u*)((const bf16*)(ws + WS_GK) + (size_t)(t0 + lane) * 192 + 24 * wave + 8 * i);
    v4u qq[3];
#pragma unroll
    for (int i = 0; i < 3; ++i) qq[i] = *(const GAS v4u*)((const bf16*)(ws + WS_GQ) + (size_t)(t0 + lane) * 192 + 24 * wave + 8 * i);
    float wb[8]; float ba = 0.f;
    if (wave < 6) { ba = b_alpha[32 * wave + r32];
#pragma unroll
        for (int sk = 0; sk < 8; ++sk) wb[sk] = w_up[(2 * sk + hi) * 192 + 32 * wave + r32]; }
    LAS float* GLRL = (LAS float*)(lds + P2_GLR); LAS float* LF = (LAS float*)(lds + P2_LF);
    if (wave < 5) {
        f32x16 c[2] = {f32x16{}, f32x16{}};
        const GAS bf16x8* bp = (const GAS bf16x8*)(ws + WS_WSF) + (size_t)(wave * 64) * 64 + lane;
        bf16x8 bq[16];
        const int rot = 2 * (int)((blockIdx.x >> 3) & 31);
#pragma unroll
        for (int u = 0; u < 16; ++u) bq[u] = bp[((rot + u) & 63) * 64];
        asm volatile("s_waitcnt vmcnt(0)" ::: "memory"); __syncthreads();
        STAMP(16);
        const int sw = r32 & 15;
#pragma unroll 1
        for (int ks0 = 0; ks0 < 64; ks0 += 16) {
#pragma unroll
            for (int u = 0; u < 16; ++u) { const int ks = (ks0 + u + rot) & 63; const int off = r32 * 2048 + (((2 * ks + hi) ^ sw) * 16);
                const bf16x8 a0 = *(const LAS bf16x8*)(lds + off), a1 = *(const LAS bf16x8*)(lds + off + 32 * 2048);
                c[0] = __builtin_amdgcn_mfma_f32_32x32x16_bf16(a0, bq[u], c[0], 0, 0, 0); c[1] = __builtin_amdgcn_mfma_f32_32x32x16_bf16(a1, bq[u], c[1], 0, 0, 0);
                bq[u] = bp[((ks + 16) & 63) * 64]; } }
        STAMP(22);
        if (wave < 4) {
#pragma unroll
            for (int rt = 0; rt < 2; ++rt)
#pragma unroll
                for (int r = 0; r < 16; ++r) { const float v = c[rt][r]; const int row = 32 * rt + (r & 3) + 8 * (r >> 2) + 4 * hi;
                    ((bf16*)(ws + WS_GG))[(size_t)(t0 + row) * 384 + 256 + 32 * wave + r32] = (bf16)f2bf(v * __builtin_amdgcn_rcpf(1.f + __builtin_amdgcn_exp2f(-LOG2E * v))); }
            STAMP(23);
        } else {
            const float bf = r32 >= 16 && r32 < 22 ? b_forget[r32 - 16] : 0.f;
#pragma unroll
            for (int rt = 0; rt < 2; ++rt)
#pragma unroll
                for (int r = 0; r < 16; ++r) { const float v = c[rt][r]; const int row = 32 * rt + (r & 3) + 8 * (r >> 2) + 4 * hi;
                    if (r32 < 16) GLRL[row * 16 + r32] = v;
                    else if (r32 < 22) LF[(r32 - 16) * 64 + row] = LOG2E * log_sigmoid_fast(v + bf); }
        }
    } else {
        asm volatile("s_waitcnt vmcnt(0)" ::: "memory"); __syncthreads();
        const int t = tid - 320, rp4 = t / 48, pc = t % 48, h = pc >> 3;
        float mq = 0.f, mk = 0.f, ms = 3.0e38f;
#pragma unroll 4
        for (int pass = 0; pass < 16; ++pass) { const size_t row = (size_t)(t0 + 4 * pass + rp4);
            const v4u a = *(const GAS v4u*)((const bf16*)(ws + WS_FQ) + row * 384 + 8 * pc), b = *(const GAS v4u*)((const bf16*)(ws + WS_FK) + row * 384 + 8 * pc);
            float sq = 0.f, sk = 0.f, sd = 0.f;
#pragma unroll
            for (int e = 0; e < 4; ++e) { const float ql = bf_lo(a[e]), qh = bf_hi(a[e]), kl = bf_lo(b[e]), kh = bf_hi(b[e]); sq += ql * ql + qh * qh; sk += kl * kl + kh * kh; sd += ql * kl + qh * kh; }
            sd += dppf<0xB1>(sd); sd += dppf<0x4E>(sd); sd += dppf<0x141>(sd); ms = fminf(ms, sd);
            sq += dppf<0xB1>(sq); sq += dppf<0x4E>(sq); sq += dppf<0x141>(sq);
            sk += dppf<0xB1>(sk); sk += dppf<0x4E>(sk); sk += dppf<0x141>(sk);
            mq = fmaxf(mq, sq); mk = fmaxf(mk, sk); }
        if ((t & 7) == 0) { __hip_atomic_fetch_max((LAS unsigned*)(lds + P2_NRM) + h, __float_as_uint(mq), __ATOMIC_RELAXED, __HIP_MEMORY_SCOPE_WORKGROUP);
                            __hip_atomic_fetch_max((LAS unsigned*)(lds + P2_NRM) + 6 + h, __float_as_uint(mk), __ATOMIC_RELAXED, __HIP_MEMORY_SCOPE_WORKGROUP);
                            const unsigned ub = __float_as_uint(ms), uo = ub ^ ((ub >> 31) ? 0xffffffffu : 0x80000000u);
                            __hip_atomic_fetch_min((LAS unsigned*)(lds + P2_NRM) + 12 + h, uo, __ATOMIC_RELAXED, __HIP_MEMORY_SCOPE_WORKGROUP); }
    }
    __syncthreads();
    STAMP(17);
    if (tid < 12) __hip_atomic_fetch_max((unsigned*)(ctl + CW_NMAX + tid), ((LAS unsigned*)(lds + P2_NRM))[tid], RLX_AGENT);
    if (tid < 6) { float* chk = (float*)(ws + WS_CHK) + n * 12; chk[tid] = __uint_as_float(((LAS unsigned*)(lds + P2_NRM))[tid]);
        const unsigned uo = ((LAS unsigned*)(lds + P2_NRM))[12 + tid]; chk[6 + tid] = __uint_as_float(uo ^ ((uo >> 31) ? 0x80000000u : 0xffffffffu)); }
#pragma unroll
    for (int i = 0; i < 6; ++i) { const int q = tid + 512 * i, c = q & 63, cc = q >> 6; const v4u d = vreg[i];
        LAS unsigned short* p = (LAS unsigned short*)(lds + P2_VT) + (8 * cc) * GL_VT_PITCH + c;
        p[0 * GL_VT_PITCH] = (unsigned short)(d.x & 0xffffu); p[1 * GL_VT_PITCH] = (unsigned short)(d.x >> 16); p[2 * GL_VT_PITCH] = (unsigned short)(d.y & 0xffffu); p[3 * GL_VT_PITCH] = (unsigned short)(d.y >> 16);
        p[4 * GL_VT_PITCH] = (unsigned short)(d.z & 0xffffu); p[5 * GL_VT_PITCH] = (unsigned short)(d.z >> 16); p[6 * GL_VT_PITCH] = (unsigned short)(d.w & 0xffffu); p[7 * GL_VT_PITCH] = (unsigned short)(d.w >> 16); }
    STAMP(28);
    LAS float* BL = (LAS float*)(lds + P2_BL);
    if (wave < 6) {
        f32x16 z0 = f32x16{}, z1 = f32x16{};
#pragma unroll
        for (int sk = 0; sk < 8; ++sk) { const float a0 = GLRL[r32 * 16 + 2 * sk + hi], a1 = GLRL[(32 + r32) * 16 + 2 * sk + hi];
            z0 = __builtin_amdgcn_mfma_f32_32x32x2f32(a0, wb[sk], z0, 0, 0, 0); z1 = __builtin_amdgcn_mfma_f32_32x32x2f32(a1, wb[sk], z1, 0, 0, 0); }
#pragma unroll
        for (int r = 0; r < 16; ++r) { z0[r] = log_sigmoid_fast(z0[r] + ba) * (1.f / 16.f); z1[r] = log_sigmoid_fast(z1[r] + ba) * (1.f / 16.f); }
        bf16x8 xh0[2], xl0[2], xh1[2], xl1[2], lt[2], ones;
#pragma unroll
        for (int e = 0; e < 8; ++e) ones[e] = (short)0x3F80;
#pragma unroll
        for (int sk = 0; sk < 2; ++sk) { v4u h0, l0, h1, l1;
#pragma unroll
            for (int e = 0; e < 4; ++e) { const float a = z0[8 * sk + 2 * e], b = z0[8 * sk + 2 * e + 1], c = z1[8 * sk + 2 * e], d = z1[8 * sk + 2 * e + 1];
                const unsigned pa = pk2(a, b), pc = pk2(c, d); h0[e] = pa; h1[e] = pc;
                l0[e] = pk2(a - bf_lo(pa), b - bf_hi(pa)); l1[e] = pk2(c - bf_lo(pc), d - bf_hi(pc)); }
            xh0[sk] = __builtin_bit_cast(bf16x8, h0); xl0[sk] = __builtin_bit_cast(bf16x8, l0); xh1[sk] = __builtin_bit_cast(bf16x8, h1); xl1[sk] = __builtin_bit_cast(bf16x8, l1);
#pragma unroll
            for (int e = 0; e < 8; ++e) { const int k = 16 * sk + 8 * (e >> 2) + 4 * hi + (e & 3); lt[sk][e] = (k <= r32) ? (short)0x3F80 : (short)0; } }
        f32x16 y0 = f32x16{}, y1 = f32x16{};
#pragma unroll
        for (int sk = 0; sk < 2; ++sk) {
            y0 = __builtin_amdgcn_mfma_f32_32x32x16_bf16(lt[sk], xh0[sk], y0, 0, 0, 0); y0 = __builtin_amdgcn_mfma_f32_32x32x16_bf16(lt[sk], xl0[sk], y0, 0, 0, 0);
            y1 = __builtin_amdgcn_mfma_f32_32x32x16_bf16(ones, xh0[sk], y1, 0, 0, 0); y1 = __builtin_amdgcn_mfma_f32_32x32x16_bf16(ones, xl0[sk], y1, 0, 0, 0);
            y1 = __builtin_amdgcn_mfma_f32_32x32x16_bf16(lt[sk], xh1[sk], y1, 0, 0, 0); y1 = __builtin_amdgcn_mfma_f32_32x32x16_bf16(lt[sk], xl1[sk], y1, 0, 0, 0); }
#pragma unroll
        for (int r = 0; r < 16; ++r) { const int row = (r & 3) + 8 * (r >> 2) + 4 * hi; BL[row * P2_BL_PITCH + 32 * wave + r32] = y0[r]; BL[(32 + row) * P2_BL_PITCH + 32 * wave + r32] = y1[r]; }
        STAMP(29); }
    else if (wave == 6 || wave == 7) {
#pragma unroll
        for (int hh = 0; hh < 3; ++hh) { const int h = 3 * (wave - 6) + hh; float v = LF[h * 64 + lane];
#pragma unroll
            for (int d = 1; d < 64; d <<= 1) { const float o = __shfl_up(v, d); if (lane >= d) v += o; }
            ((float*)(ws + WS_CFL))[(size_t)h * M + t0 + lane] = v; if (lane == 63) ((float*)(ws + WS_TOT))[h * 256 + n] = v; } }
    __syncthreads();
    STAMP(18);
    { LAS unsigned short* kt = (LAS unsigned short*)(lds + P2_KT); float* dec = (float*)(ws + WS_DEC) + (size_t)n * 192; float b[24];
#pragma unroll
      for (int jj = 0; jj < 24; ++jj) { const int j = 24 * wave + jj; const float bl = BL[63 * P2_BL_PITCH + j];
          const float bv = BL[lane * P2_BL_PITCH + j]; b[jj] = bv;
          const unsigned u = kk[jj >> 3][(jj & 7) >> 1]; const float kv = (jj & 1) ? bf_hi(u) : bf_lo(u);
          kt[j * GL_KT_PITCH + lane] = (unsigned short)f2bf(kv * __expf(bl - bv));
          if (lane == 63) dec[j] = __expf(bl); }
      const float qs = 0.14433756729740643f;
      bf16* gq = (bf16*)(ws + WS_GQ) + (size_t)(t0 + lane) * 192 + 24 * wave; bf16* gk = (bf16*)(ws + WS_GK) + (size_t)(t0 + lane) * 192 + 24 * wave;
#pragma unroll
      for (int i = 0; i < 3; ++i) { v4u oq, ok;
#pragma unroll
          for (int e = 0; e < 4; ++e) { const float b0 = b[8 * i + 2 * e], b1 = b[8 * i + 2 * e + 1];
              oq[e] = pk2(bf_lo(qq[i][e]) * qs * __expf(b0), bf_hi(qq[i][e]) * qs * __expf(b1)); ok[e] = pk2(bf_lo(kk[i][e]) * __expf(-b0), bf_hi(kk[i][e]) * __expf(-b1)); }
          *(v4u*)(gq + 8 * i) = oq; *(v4u*)(gk + 8 * i) = ok; } }
    __syncthreads();
    STAMP(19);
    { const int r16 = lane & 15, q4 = lane >> 4;
      float* kvt = (float*)(ws + WS_KVT) + (size_t)n * 18432;
      for (int ti = wave; ti < 72; ti += 8) { const int h = ti / 18, rem = ti % 18, vt = rem / 3, kt3 = rem % 3;
          pg8::f32x4 acc = {0.f, 0.f, 0.f, 0.f};
#pragma unroll
          for (int ks = 0; ks < 2; ++ks) {
              const bf16x8 a = *(const LAS bf16x8*)(lds + P2_VT + ((h * 96 + vt * 16 + r16) * GL_VT_PITCH + ks * 32 + 8 * q4) * 2);
              const bf16x8 bb = *(const LAS bf16x8*)(lds + P2_KT + ((h * 48 + kt3 * 16 + r16) * GL_KT_PITCH + ks * 32 + 8 * q4) * 2);
              acc = __builtin_amdgcn_mfma_f32_16x16x32_bf16(a, bb, acc, 0, 0, 0); }
#pragma unroll
          for (int r = 0; r < 4; ++r) kvt[(size_t)(h * 96 + vt * 16 + q4 * 4 + r) * 48 + kt3 * 16 + r16] = acc[r]; } }
    __syncthreads();
}
__device__ __forceinline__ void gla_scan_item(int item, int tid, unsigned char* ws) {
    const int e = item * 512 + tid, h = e / 4608, k = e % 48;
    const float* kvt = (const float*)(ws + WS_KVT) + e; const float* dec = (const float*)(ws + WS_DEC) + h * 48 + k; bf16* st = (bf16*)(ws + WS_ST) + e;
    float S = 0.f;
    for (int n0 = 0; n0 < 256; n0 += 64) { float kv[64], dc[64];
#pragma unroll
        for (int i = 0; i < 64; ++i) { kv[i] = kvt[(size_t)(n0 + i) * 18432]; dc[i] = dec[(size_t)(n0 + i) * 192]; }
#pragma unroll
        for (int i = 0; i < 64; ++i) { st[(size_t)(n0 + i) * 18432] = (bf16)f2bf(S); S = dc[i] * S + kv[i]; } }
}
constexpr int FO_AMG = 0;
constexpr int FO_VT = 49152;
constexpr int FO_QD = 98304, FO_KD = FO_QD + 24576;
constexpr int FO_AT = FO_QD;
constexpr int FO_AR1 = 49152;
constexpr int FO_AR2 = FO_AR1 + 65536;
constexpr int FO_TR = 0, FO_TR_WAVE = 32 * 528;
constexpr int FO_RED = 8 * FO_TR_WAVE, FO_RS = FO_RED + 2048;
static_assert(FO_AR2 + 16384 <= RING_BYTES && FO_KD + 24576 <= RING_BYTES && FO_RS + 256 <= RING_BYTES, "fused out-projection LDS map");
typedef float fo_f32x16 __attribute__((ext_vector_type(16)));
struct FoPre { v4u vd[6]; float gn[3]; fo_f32x16 xa[2][4]; fo_f32x16 o[3]; pg8::bf16x8 qa[3]; };
__device__ __forceinline__ void fo_prefetch(FoPre& P, LAS unsigned char* lds, int n, int tid, int wave, int lane, unsigned char* ws, const float* gng, const float* x, bool with_x) {
    asm volatile("" : "+v"(tid), "+v"(lane), "+s"(wave)); ws = launder_ptr(ws);
    const int t0 = 64 * n; const int r32 = lane & 31;
    { const unsigned lds0 = (unsigned)(uintptr_t)(lds); const bf16* gsrc = (const bf16*)(ws + WS_GG) + (size_t)t0 * 384;
      if (lane < 48) {
#pragma unroll
          for (int i = 0; i < 8; ++i) { const int row = 8 * wave + i; glds16(gsrc + (size_t)row * 384 + 8 * (lane ^ (row & 15)), (unsigned)__builtin_amdgcn_readfirstlane(lds0 + FO_AMG + row * 768)); } } }
#pragma unroll
    for (int vt = 0; vt < 3; ++vt) P.gn[vt] = gng[32 * vt + r32];
#pragma unroll
    for (int i = 0; i < 6; ++i) { const int q = tid + 512 * i, c = q & 63, cc = q >> 6; P.vd[i] = *(const GAS v4u*)((const bf16*)(ws + WS_GV) + (size_t)(t0 + c) * 384 + 8 * cc); }
    { const unsigned lds0 = (unsigned)(uintptr_t)(lds);
#pragma unroll
      for (int i = 0; i < 3; ++i) { const int p = wave + 8 * i, off = 1024 * p + 16 * lane, row = off / 384, pos = (off - 384 * row) >> 4, c = (pos & ~7) | ((pos & 7) ^ ((row >> 1) & 7));
          glds16((const bf16*)(ws + WS_GQ) + (size_t)(t0 + row) * 192 + 8 * c, (unsigned)__builtin_amdgcn_readfirstlane(lds0 + FO_QD + 1024 * p));
          glds16((const bf16*)(ws + WS_GK) + (size_t)(t0 + row) * 192 + 8 * c, (unsigned)__builtin_amdgcn_readfirstlane(lds0 + FO_KD + 1024 * p)); } }
    if (with_x) { const int hi = lane >> 5;
#pragma unroll
        for (int ct = 0; ct < 4; ++ct)
#pragma unroll
            for (int rt = 0; rt < 2; ++rt)
#pragma unroll
                for (int r = 0; r < 16; ++r) P.xa[rt][ct][r] = __builtin_nontemporal_load(x + (size_t)(t0 + 32 * rt + (r & 3) + 8 * (r >> 2) + 4 * hi) * 1024 + 128 * wave + 32 * ct + r32); }
#pragma unroll
    for (int i = 0; i < 6; ++i) { const int q = tid + 512 * i, c = q & 63, cc = q >> 6;
        const v4u d = P.vd[i];
        LAS unsigned char* p = lds + FO_VT + (c & 7) * 2; const int kc = c >> 3;
#pragma unroll
        for (int e = 0; e < 8; ++e) { const int v = 8 * cc + e; const unsigned w = d[e >> 1]; const unsigned short val = (e & 1) ? (unsigned short)(w >> 16) : (unsigned short)(w & 0xffffu);
            *(LAS unsigned short*)(p + v * 128 + ((kc ^ ((v >> 1) & 7)) * 16)) = val; } }
    { typedef float f32x16 __attribute__((ext_vector_type(16)));
      const int hi = lane >> 5, h = wave >> 1, rh = wave & 1;
      asm volatile("s_waitcnt vmcnt(63) lgkmcnt(0)" ::: "memory"); __builtin_amdgcn_s_barrier(); asm volatile("" ::: "memory");
      f32x16 at[2] = {f32x16{}, f32x16{}}, o[3] = {f32x16{}, f32x16{}, f32x16{}};
      pg8::bf16x8 qa[3];
      { const int row = 32 * rh + r32, sw = (row >> 1) & 7;
#pragma unroll
        for (int ks = 0; ks < 3; ++ks) { const int ch = 6 * h + 2 * ks + hi; qa[ks] = *(const LAS pg8::bf16x8*)(lds + FO_QD + row * 384 + ((ch & ~7) | ((ch & 7) ^ sw)) * 16); } }
#pragma unroll
      for (int st = 0; st < 2; ++st) if (st <= rh) { const int row = 32 * st + r32, sw = (row >> 1) & 7;
#pragma unroll
          for (int ks = 0; ks < 3; ++ks) { const int ch = 6 * h + 2 * ks + hi; const pg8::bf16x8 kb = *(const LAS pg8::bf16x8*)(lds + FO_KD + row * 384 + ((ch & ~7) | ((ch & 7) ^ sw)) * 16);
              at[st] = __builtin_amdgcn_mfma_f32_32x32x16_bf16(qa[ks], kb, at[st], 0, 0, 0); } }
      LDS_WAIT(); __builtin_amdgcn_s_barrier(); asm volatile("" ::: "memory");
      LAS unsigned char* atw = lds + FO_AT + wave * 4096;
#pragma unroll
      for (int st = 0; st < 2; ++st) if (st <= rh) {
#pragma unroll
          for (int r = 0; r < 16; ++r) { const int cl = (r & 3) + 8 * (r >> 2) + 4 * hi, c = 32 * rh + cl, s = 32 * st + r32;
              *(LAS unsigned short*)(atw + cl * 128 + (((s >> 3) ^ ((cl >> 1) & 7)) * 16) + (s & 7) * 2) = (unsigned short)f2bf(s <= c ? at[st][r] : 0.f); } }
      LDS_WAIT(); asm volatile("" ::: "memory");
#pragma unroll
      for (int ks = 0; ks < 4; ++ks) if (ks < 2 * rh + 2) { const pg8::bf16x8 aa = *(const LAS pg8::bf16x8*)(atw + r32 * 128 + (((2 * ks + hi) ^ ((r32 >> 1) & 7)) * 16));
#pragma unroll
          for (int vt = 0; vt < 3; ++vt) { const int v = h * 96 + 32 * vt + r32; const pg8::bf16x8 vb = *(const LAS pg8::bf16x8*)(lds + FO_VT + v * 128 + (((2 * ks + hi) ^ ((v >> 1) & 7)) * 16));
              o[vt] = __builtin_amdgcn_mfma_f32_32x32x16_bf16(aa, vb, o[vt], 0, 0, 0); } }
#pragma unroll
      for (int vt = 0; vt < 3; ++vt) { P.o[vt] = o[vt]; P.qa[vt] = qa[vt]; } }
}
__device__ __forceinline__ void fused_out_item(FoPre& P, bool w0_late_x, LAS unsigned char* lds, int n, int tid, int wave, int lane, unsigned char* ws, const float* x, const float* gng, const float* fng, float* out) {
    typedef float f32x16 __attribute__((ext_vector_type(16)));
    asm volatile("" : "+v"(tid), "+v"(lane), "+s"(wave)); ws = launder_ptr(ws);
    const int t0 = 64 * n; const int r32 = lane & 31, hi = lane >> 5;
    f32x16 acc[2][4];
    const bool latex = w0_late_x && wave == 0;
#pragma unroll
    for (int rt = 0; rt < 2; ++rt)
#pragma unroll
        for (int ct = 0; ct < 4; ++ct) acc[rt][ct] = P.xa[rt][ct];
    STAMP(10);
    for (int rpa = 0; rpa < NREP(40); ++rpa) {
    bf16x8 sb[3][3];
    { const bf16* stn = (const bf16*)(ws + WS_ST) + (size_t)n * 18432 + (size_t)(wave >> 1) * 4608;
#pragma unroll
      for (int vt = 0; vt < 3; ++vt)
#pragma unroll
          for (int ks = 0; ks < 3; ++ks) sb[vt][ks] = *(const GAS bf16x8*)(stn + (32 * vt + r32) * 48 + 16 * ks + 8 * hi); }
    float gn[3];
#pragma unroll
    for (int vt = 0; vt < 3; ++vt) gn[vt] = P.gn[vt];
    STAMP(25);
#define XLOAD(RT, CT) do { int r32l = r32, hil = hi; asm volatile("" : "+v"(r32l), "+v"(hil)); __builtin_amdgcn_sched_barrier(0); \
        _Pragma("unroll") for (int r = 0; r < 16; ++r) acc[RT][CT][r] = __builtin_nontemporal_load(x + (size_t)(t0 + 32 * (RT) + (r & 3) + 8 * (r >> 2) + 4 * hil) * 1024 + 128 * wave + 32 * (CT) + r32l); \
        __builtin_amdgcn_sched_barrier(0); } while (0)
    const int h = wave >> 1, rh = wave & 1;
    {
      f32x16 o[3];
#pragma unroll
      for (int vt = 0; vt < 3; ++vt) o[vt] = P.o[vt];
#pragma unroll
      for (int vt = 0; vt < 3; ++vt)
#pragma unroll
          for (int ks = 0; ks < 3; ++ks) o[vt] = __builtin_amdgcn_mfma_f32_32x32x16_bf16(P.qa[ks], sb[vt][ks], o[vt], 0, 0, 0);
      STAMP(26);
#pragma unroll
      for (int r = 0; r < 16; ++r) { const float ss = half_sum(o[0][r] * o[0][r] + o[1][r] * o[1][r] + o[2][r] * o[2][r]);
          const float rstd = 1.f / sqrtf(ss * (1.f / 96.f) + EPS);
          const int rl = 32 * rh + (r & 3) + 8 * (r >> 2) + 4 * hi;
#pragma unroll
          for (int vt = 0; vt < 3; ++vt) { const int col = h * 96 + 32 * vt + r32; LAS unsigned short* ap = (LAS unsigned short*)(lds + FO_AMG + rl * 768 + (((col >> 3) ^ (rl & 15)) * 16) + (col & 7) * 2);
              const float g = __uint_as_float((unsigned)(*ap) << 16); *ap = (unsigned short)f2bf(o[vt][r] * rstd * gn[vt] * g); } }
    }
    LDS_WAIT(); __builtin_amdgcn_s_barrier(); asm volatile("" ::: "memory");
    }
    STAMP(11);
    const GAS bf16x8* wf = (const GAS bf16x8*)(ws + WS_WOUTF) + (size_t)(4 * wave) * 64 * 64 + lane;
    bf16x8 bq[4][4];
    for (int rpb = 0; rpb < NREP(41); ++rpb) {
#pragma unroll
    for (int u = 0; u < 4; ++u)
#pragma unroll
        for (int ct = 0; ct < 4; ++ct) bq[u][ct] = wf[(ct * 64 + u) * 64];
    const int sw15 = r32 & 15;
    const unsigned lds0 = (unsigned)(uintptr_t)(lds); const bf16* mix = (const bf16*)(ws + WS_MIX) + (size_t)t0 * 1024;
    STAMP(24);
#pragma unroll 1
    for (int ks0 = 0; ks0 < 64; ks0 += 4) {
        if (ks0 < 16) {
#pragma unroll
            for (int e = 0; e < 2; ++e) { const int row = 8 * wave + (ks0 >> 1) + e; const int kc = lane ^ (row & 15);
                glds16(mix + (size_t)row * 1024 + 384 + 8 * kc, (unsigned)__builtin_amdgcn_readfirstlane(lds0 + FO_AR1 + row * 1024)); }
        } else if (ks0 == 16) {
#pragma unroll
            for (int e = 0; e < 2; ++e) { const int q = 2 * wave + e, row = 4 * q + (lane >> 4); const int kc = (lane & 15) ^ (row & 15);
                glds16(mix + (size_t)row * 1024 + 896 + 8 * kc, (unsigned)__builtin_amdgcn_readfirstlane(lds0 + FO_AR2 + q * 1024)); }
        } else if (ks0 == 24) {
            asm volatile("s_waitcnt vmcnt(16)" ::: "memory"); __builtin_amdgcn_s_barrier(); asm volatile("" ::: "memory"); }
#pragma unroll
        for (int u = 0; u < 4; ++u) { const int ks = ks0 + u, kc = 2 * ks + hi;
            int a_off;
            if (ks0 < 24) a_off = FO_AMG + r32 * 768 + ((kc ^ sw15) * 16);
            else if (ks0 < 56) a_off = FO_AR1 + r32 * 1024 + (((kc - 48) ^ sw15) * 16);
            else a_off = FO_AR2 + r32 * 256 + (((kc - 112) ^ sw15) * 16);
            const int rstep = ks0 < 24 ? 32 * 768 : (ks0 < 56 ? 32 * 1024 : 32 * 256);
            const bf16x8 a0 = *(const LAS bf16x8*)(lds + a_off), a1 = *(const LAS bf16x8*)(lds + a_off + rstep);
#pragma unroll
            for (int ct = 0; ct < 4; ++ct) { acc[0][ct] = __builtin_amdgcn_mfma_f32_32x32x16_bf16(a0, bq[u][ct], acc[0][ct], 0, 0, 0); acc[1][ct] = __builtin_amdgcn_mfma_f32_32x32x16_bf16(a1, bq[u][ct], acc[1][ct], 0, 0, 0); }
#pragma unroll
            for (int ct = 0; ct < 4; ++ct) bq[u][ct] = wf[(ct * 64 + ((ks + 4) & 63)) * 64];
        }
    }
    }
    STAMP(12);
    __syncthreads();
    LAS float* tr = (LAS float*)(lds + FO_TR + wave * FO_TR_WAVE);
    LAS float* red = (LAS float*)(lds + FO_RED);
    f32x4 v[2][16];
    const int c4 = lane & 31, rsel = lane >> 5;
#pragma unroll
    for (int rt = 0; rt < 2; ++rt) {
#pragma unroll
        for (int ct = 0; ct < 4; ++ct)
#pragma unroll
            for (int r = 0; r < 16; ++r) tr[((r & 3) + 8 * (r >> 2) + 4 * hi) * 132 + 32 * ct + r32] = acc[rt][ct][r];
        LDS_WAIT(); asm volatile("" ::: "memory");
#pragma unroll
        for (int i = 0; i < 16; ++i) { const int rl = 2 * i + rsel;
            const f32x4 t = *(const LAS f32x4*)(tr + rl * 132 + 4 * c4); v[rt][i] = t;
            const float ss = half_sum((t[0] * t[0] + t[1] * t[1]) + (t[2] * t[2] + t[3] * t[3]));
            if (c4 == 0) red[(32 * rt + rl) * 8 + wave] = ss; }
        LDS_WAIT(); asm volatile("" ::: "memory");
    }
    STAMP(13);
    __syncthreads();
    if (tid < 64) { float q = 0.f;
#pragma unroll
        for (int w = 0; w < 8; ++w) q += red[tid * 8 + w];
        ((LAS float*)(lds + FO_RS))[tid] = 1.0f / sqrtf(q * (1.0f / 1024.0f) + EPS); }
    __syncthreads();
    const f32x4 gv = *(const GAS f32x4*)(fng + 128 * wave + 4 * c4);
#pragma unroll
    for (int rt = 0; rt < 2; ++rt)
#pragma unroll
        for (int i = 0; i < 16; ++i) { const int rl = 32 * rt + 2 * i + rsel; const float rs = ((const LAS float*)(lds + FO_RS))[rl];
            __builtin_nontemporal_store(v[rt][i] * rs * gv, (GAS f32x4*)(out + (size_t)(t0 + rl) * 1024 + 128 * wave + 4 * c4)); }
    __syncthreads();
}


struct Args { const float* in[12]; float* out; unsigned char* ws; int ph_lo, ph_hi, li, pad; };
__global__ void __launch_bounds__(NWAVES * 64, 2) hymba_fwd(Args args) {
    extern __shared__ __attribute__((aligned(16))) unsigned char lds_raw[];
    LAS unsigned char* lds = (LAS unsigned char*)lds_raw;
    volatile LAS unsigned* MISC = (volatile LAS unsigned*)(lds + MISC_OFF);
    const int tid = threadIdx.x, lane = tid & 63, wave = __builtin_amdgcn_readfirstlane(tid >> 6);
    const int G = gridDim.x; const int bx = blockIdx.x; const int vcu = (G % 8 == 0) ? (bx % 8) * (G / 8) + bx / 8 : bx;
    unsigned char* ws = args.ws; gu32* ctl = (gu32*)(ws + WS_CTL);
    const float* x = args.in[0]; const float* mem = args.in[1]; const float* norm_g = args.in[2]; const float* w_in = args.in[3]; const float* w_up = args.in[4]; const float* b_alpha = args.in[5];
    const float* b_forget = args.in[6]; const float* gla_norm_g = args.in[7]; const float* mem_norm_g = args.in[8]; const float* w_mem_kv = args.in[9]; const float* w_out = args.in[10]; const float* final_norm_g = args.in[11];
    for (int u = tid; u < (LDS_BYTES - LDSCTL_OFF) / 4; u += NWAVES * 64) ((LAS unsigned*)(lds + LDSCTL_OFF))[u] = 0u;
    __syncthreads();
    XcdBarrier bar; bar.bar = (unsigned*)(ctl + CW_BAR); bar.x = 0; bar.st = nullptr;
    if (N_LAUNCHES != PER_PHASE) bar = xcd_barrier_post((unsigned*)(ctl + CW_BAR), MISC + 8);
#define GRID_BAR(seam) do { if (N_LAUNCHES == PER_PHASE) { if (tid == 0) __hip_atomic_store(ctl + CW_TMO, 0xBADBA0u | (unsigned)(seam), RLX_AGENT); } else { xcd_barrier(bar); } } while (0)
    const int lo = args.ph_lo, hi = args.ph_hi;
#define IN(k) (lo <= (k) && (k) < hi)
#define BOTH(k) (IN(k) && IN((k) + 1))

    STAMP(0);
    if (IN(0)) { for (int rp = 0; rp < NREP(0); ++rp) p0_prologue(lds, vcu, G, tid, wave, lane, x, mem, norm_g, w_in, mem_norm_g, w_mem_kv, w_out, ws, ctl); STAMP(1);
        if (BOTH(0)) { if (N_LAUNCHES == PER_PHASE || G != 256) GRID_BAR(0);
            else {
                if (tid == 0) { unsigned sp = 0u;
                    for (;;) { unsigned c = 0u;
#pragma unroll
                        for (int j = 0; j < 16; ++j) c += __hip_atomic_load(ctl + CW_P0W + 64 * j, RLX_AGENT);
                        if (c >= 2368u && __hip_atomic_load(ctl + CW_SEAM + 64 * (vcu >> 2), RLX_AGENT) >= 4u) break;
                        __builtin_amdgcn_s_sleep(4); if (++sp > (1u << 20)) { __hip_atomic_store(ctl + CW_TMO, 1u, RLX_AGENT); break; } }
                    __builtin_amdgcn_fence(__ATOMIC_ACQUIRE, "agent"); asm volatile("s_waitcnt vmcnt(0)" ::: "memory"); }
                __syncthreads(); } }
        STAMP(2); }

    if (PROBE_DUP == 9) { for (int rb = 0; rb < 4; ++rb) GRID_BAR(9); }
    if (IN(1)) {
        for (int rp = 0; rp < NREP(1); ++rp) {
        { pg8::Gemm g{(const pg8::bf16_t*)(ws + WS_XN), (const pg8::bf16_t*)(ws + WS_WIN), M, NP, D}; PanelOrder S{vcu, (unsigned*)(ctl + CW_PANEL1 + 64 * (vcu >> 2))};
          pg8::EpiRoute E{ws, attn_body::C2};
          pg8::gemm_phase<pg8::EpiRoute, PanelOrder, true, true>(lds + RING_OFF, g, S, E); }
        }
        STAMP(3);
        if (IN(2) && vcu < 256) p2_prefetch_a(lds + RING_OFF, vcu, wave, lane, ws);
        if (tid == 0) { unsigned sp = 0u; while (__hip_atomic_load(ctl + CW_PANEL1 + 64 * (vcu >> 2), RLX_AGENT) < 96u) { __builtin_amdgcn_s_sleep(4); if (++sp > (1u << 22)) { __hip_atomic_store(ctl + CW_TMO, 1u, RLX_AGENT); break; } }
            __builtin_amdgcn_fence(__ATOMIC_ACQUIRE, "agent"); asm volatile("s_waitcnt vmcnt(0)" ::: "memory"); }
        __syncthreads();
        STAMP(4);
    }

    if (IN(2)) {
        for (int rp = 0; rp < NREP(2); ++rp) {
        for (int n = vcu; n < 256; n += G) { if (n != vcu || !IN(1)) p2_prefetch_a(lds, n, wave, lane, ws); p2_chunk_item(lds, n, tid, wave, lane, ws, ctl, w_up, b_alpha, b_forget); }
        }
        STAMP(5); if (BOTH(2)) GRID_BAR(2); STAMP(6);
    }

    FoPre fop; bool fo_pre = false;
    if (IN(3)) {
        {
          LAS float* offt = (LAS float*)(lds + OFFT_OFF);
          float v[6];
          if (tid < 256) {
#pragma unroll
              for (int h = 0; h < 6; ++h) v[h] = ((const float*)(ws + WS_TOT))[h * 256 + tid];
#pragma unroll
              for (int d = 1; d < 64; d <<= 1) {
#pragma unroll
                  for (int h = 0; h < 6; ++h) { const float o = __shfl_up(v[h], d); if (lane >= d) v[h] += o; } }
              if (lane == 63) {
#pragma unroll
                  for (int h = 0; h < 6; ++h) ((LAS float*)(lds + RING_OFF))[h * 4 + wave] = v[h]; } }
          __syncthreads();
          if (tid < 256) {
#pragma unroll
              for (int h = 0; h < 6; ++h) { float add = 0.f; for (int w = 0; w < wave; ++w) add += ((LAS float*)(lds + RING_OFF))[h * 4 + w]; offt[h * OFFT_ROW + tid + 1] = v[h] + add; }
              offt[6 * OFFT_ROW + tid] = 0.f; if (tid < 7) offt[tid * OFFT_ROW + (tid == 6 ? 256 : 0)] = 0.f; }
          __syncthreads(); }
        int nit = 0;
        unsigned nxt = 0u; bool have_nxt = false;
        for (int rp = 0; rp < NREP(3); ++rp)
        for (;;) {
            if (nit < 3) STAMP(30 + 3 * nit);
            __syncthreads();
            if (tid == 0) { MISC[16] = have_nxt ? nxt + (G == 256 ? 256u : 0u) : (nit == 0 && G == 256 ? (unsigned)vcu : (G == 256 ? 256u : 0u) + __hip_atomic_fetch_add(ctl + CW_Q3 + 32 * rp, 1u, RLX_AGENT)); MISC[17] = 0xffffu; }
            have_nxt = false;
            __syncthreads();
            int it = (int)MISC[16];
            if (it >= 36 + 384 + 256) break;
            if (it >= 384 && it < 420) { gla_scan_item(it - 384, tid, ws); continue; }
            int q0, NT, qoff, pitch; size_t oq, ok, ov, og; int ocol; const float* cfl; float cref; const LAS float* offp;
            if (it < 384) { const int i = it, qb = 63 - i / 6, h = i % 6; q0 = 256 * qb; NT = 4 * qb + 4; qoff = 0; pitch = 384;
                oq = WS_FQ + h * 128; ok = WS_FK + h * 128; ov = WS_FV + h * 128; og = WS_FG + h * 128; ocol = 384 + h * 64; cfl = (const float*)(ws + WS_CFL) + (size_t)h * M;
                const LAS float* offt = (const LAS float*)(lds + OFFT_OFF) + h * OFFT_ROW;
                cref = cfl[q0] + offt[4 * qb];
                float q2 = 0.f, smin = 3.0e38f;
#pragma unroll
                for (int c = 0; c < 4; ++c) { const float* chk = (const float*)(ws + WS_CHK) + (4 * qb + c) * 12; q2 = fmaxf(q2, chk[h]); smin = fminf(smin, chk[6 + h]); }
                const float b2 = sqrtf(q2 * __uint_as_float(ctl[CW_NMAX + 6 + h])) - smin + 1.0f;
                int cand = NT - 4; if (tid < NT - 4 && b2 + cref - offt[tid + 1] >= -ACP_THRESH) cand = tid;
#pragma unroll
                for (int o = 1; o < 64; o <<= 1) { const int t = __shfl_xor(cand, o); cand = t < cand ? t : cand; }
                if (lane == 0) __hip_atomic_fetch_min((LAS unsigned*)(lds + MISC_OFF) + 17, (unsigned)cand, __ATOMIC_RELAXED, __HIP_MEMORY_SCOPE_WORKGROUP);
                __syncthreads();
                const int t_lo = (int)MISC[17] & ~1;
                NT -= t_lo; ok += (size_t)t_lo * 64 * 384 * 2; ov += (size_t)t_lo * 64 * 384 * 2; cfl += t_lo * 64; offp = offt + t_lo; }
            else { const int i = it - 36 - 384, qb = i >> 2, h = i & 3; q0 = 256 * qb; NT = 4; qoff = 1 << 24; pitch = 256;
                oq = WS_MQ + h * 128; ok = WS_MK + h * 128; ov = WS_MV + h * 128; og = WS_MG + h * 128; ocol = 768 + h * 64; cfl = (const float*)(ws + WS_ZERO); cref = 0.f; offp = (const LAS float*)(lds + OFFT_OFF) + 6 * OFFT_ROW; }
            if (nit < 3) STAMP(31 + 3 * nit);
            if (PROBE_T >= 0 && blockIdx.x == 0 && tid == 0 && nit < 3) ((volatile LAS unsigned*)(lds + 153600 + 7424 + 320))[nit] = (unsigned)it * 1000u + (unsigned)NT;
            attn_body::attn_unit<8, 1024, true, true>(q0, NT, qoff, pitch, pitch, pitch, (const attn_body::bf16*)(ws + oq), (const attn_body::bf16*)(ws + ok), (const attn_body::bf16*)(ws + ov),
                (const attn_body::bf16*)(ws + og), (attn_body::bf16*)(ws + WS_MIX) + ocol, cfl, offp, cref, (unsigned*)(ctl + CW_Q3), nxt, (char*)lds_raw + RING_OFF);
            have_nxt = true;
            if (nit < 3) STAMP(32 + 3 * nit);
            ++nit;
        }
        STAMP(7);
        if (BOTH(3)) { if (N_LAUNCHES == PER_PHASE) GRID_BAR(3);
            else { xcd_barrier_arrive(bar);
                   fo_prefetch(fop, lds, vcu, tid, wave, lane, ws, gla_norm_g, x, true);
                   xcd_barrier_wait(bar);
                   fo_pre = true; } }
        STAMP(8);
    }

    if (IN(4)) {
#ifdef P4_STAGGER_TICKS
        if (vcu & 1) { const unsigned long long t0 = __builtin_amdgcn_s_memrealtime(); while (__builtin_amdgcn_s_memrealtime() - t0 < P4_STAGGER_TICKS) __builtin_amdgcn_s_sleep(8); }
#endif
        for (int rp = 0; rp < NREP(4); ++rp)
        { if (!fo_pre) fo_prefetch(fop, lds, vcu, tid, wave, lane, ws, gla_norm_g, x, true);
          fused_out_item(fop, false, lds, vcu, tid, wave, lane, ws, x, gla_norm_g, final_norm_g, args.out); }
        for (int n = vcu + G; n < 256; n += G) { FoPre q; fo_prefetch(q, lds, n, tid, wave, lane, ws, gla_norm_g, x, true); fused_out_item(q, false, lds, n, tid, wave, lane, ws, x, gla_norm_g, final_norm_g, args.out); }
    }
    STAMP(9);
    if (PROBE_T >= 0) { GRID_BAR(9); STAMP(39); }
    if (PROBE_T >= 0 && blockIdx.x == 0 && tid == 0) { volatile LAS unsigned long long* ts = (volatile LAS unsigned long long*)(lds + 153600 + 7424);
#ifdef PROBE_V
        const unsigned long long d = 800ull * (((volatile LAS unsigned*)(lds + 153600 + 7424 + 320))[PROBE_V] % 1000u);
#else
        const unsigned long long d = 8ull * (ts[PROBE_T2] - ts[PROBE_T]);
#endif
        const unsigned long long t0 = __builtin_amdgcn_s_memrealtime();
        while (__builtin_amdgcn_s_memrealtime() - t0 < d) __builtin_amdgcn_s_sleep(8); }
#undef IN
#undef BOTH
}

extern "C" void kernel_launch(void* const* d_in, const int* in_sizes, int n_in, void* d_out, int out_size, void* d_ws, size_t ws_size, hipStream_t stream) {
    static int grid = 0;
    if (grid == 0) {
        if (n_in != 12 || in_sizes[0] != M * D || out_size != M * D || ws_size < WS_END) { fprintf(stderr, "kernel_launch: unexpected shapes (n_in %d, in0 %d, out %d, ws %zu); nothing launched\n", n_in, n_in > 0 ? in_sizes[0] : -1, out_size, ws_size); grid = -1; return; }
        int dev = 0, cus = 0, per_cu = 0;
        if (hipGetDevice(&dev) != hipSuccess || hipDeviceGetAttribute(&cus, hipDeviceAttributeMultiprocessorCount, dev) != hipSuccess) { fprintf(stderr, "kernel_launch: device query failed\n"); grid = -1; return; }
        if (hipFuncSetAttribute((const void*)hymba_fwd, hipFuncAttributeMaxDynamicSharedMemorySize, LDS_BYTES) != hipSuccess) { fprintf(stderr, "kernel_launch: hipFuncSetAttribute failed\n"); grid = -1; return; }
        if (hipOccupancyMaxActiveBlocksPerMultiprocessor(&per_cu, (const void*)hymba_fwd, NWAVES * 64, LDS_BYTES) != hipSuccess || per_cu < 1) { fprintf(stderr, "kernel_launch: occupancy query reports %d workgroups per CU; nothing launched\n", per_cu); (void)hipGetLastError(); grid = -1; return; }
        grid = cus;
        if (grid != 256) fprintf(stderr, "kernel_launch: launching %d workgroups; the fused final phase needs exactly 256\n", grid);
    }
    if (grid < 0) return;
    if (hipMemsetAsync((char*)d_ws + WS_CTL, 0, CTL_ZERO_BYTES, stream) != hipSuccess) { fprintf(stderr, "kernel_launch: hipMemsetAsync failed\n"); return; }
    Args a{};
    for (int i = 0; i < 12; ++i) a.in[i] = (const float*)d_in[i];
    a.out = (float*)d_out; a.ws = (unsigned char*)d_ws;
    for (int li = 0; li < N_LAUNCHES; ++li) {
        a.ph_lo = (N_LAUNCHES == PER_PHASE) ? li : 0; a.ph_hi = (N_LAUNCHES == PER_PHASE) ? li + 1 : PER_PHASE; a.li = li;
        hipLaunchKernelGGL(hymba_fwd, dim3(grid), dim3(NWAVES * 64), LDS_BYTES, stream, a);
        const hipError_t le = hipPeekAtLastError();
        if (le != hipSuccess) { fprintf(stderr, "kernel_launch: launch %d failed: %s\n", li, hipGetErrorName(le)); break; }
    }
}
```
